# Optimizing an MI355X kernel written in HIP

```python
import jax, jax.numpy as jnp
from jax import lax
import numpy as np

D_MODEL = 2048
BATCH = 1
SEQ = 16384
DEPTH = 2
DEC_BATCH = 8
DEC_SEQ = 32
PAST_LEN = 2048

CHUNK = 64
NORM_EPS = 1e-6
D_POOL = D_MODEL // 2
POOL_WINDOWS = (2, 4, 8, 16)
N_POOL_GROUPS = len(POOL_WINDOWS)
POOL_GC = D_POOL // N_POOL_GROUPS
POOL_HIST = max(POOL_WINDOWS) - 1
D_RWKV = D_MODEL - D_POOL
RWKV_HEAD = 64
RWKV_HEADS = D_RWKV // RWKV_HEAD
DECAY_LORA = 64
ICLR_LORA = 64
GATE_LORA = 128
D_SHIFT = 3 * D_RWKV + DECAY_LORA + ICLR_LORA + GATE_LORA
D_IN0 = D_POOL + D_SHIFT
SHIFT_SPLITS = (D_RWKV, 2 * D_RWKV, 3 * D_RWKV, 3 * D_RWKV + DECAY_LORA, 3 * D_RWKV + DECAY_LORA + ICLR_LORA)
LNX_EPS = 64e-5
ATT_HEADS = 16
ATT_HEAD_DIM = D_MODEL // ATT_HEADS
N_PREV_CHUNKS = 8
PREV_ROWS = N_PREV_CHUNKS * CHUNK
BAND = PREV_ROWS + CHUNK
REL_CLIP = 2 * CHUNK
D_FF = 4 * D_MODEL

kernel_name = 'chunk_stream_pool_rwkv7_bandattn'


def rmsnorm(x, g):
    xf = x.astype(jnp.float32)
    y = xf * lax.rsqrt(jnp.mean(xf * xf, axis=-1, keepdims=True) + NORM_EPS)
    return (y * g.astype(jnp.float32)).astype(x.dtype)


def pool_mix(u, hist, pos0, w_pool, pool_scale):
    T = u.shape[1]
    full = jnp.concatenate([hist.astype(u.dtype), u], axis=1)
    cs = jnp.pad(jnp.cumsum(full.astype(jnp.float32), axis=1), ((0, 0), (1, 0), (0, 0)))
    pos = (pos0 + jnp.arange(T)).astype(jnp.float32)
    end = POOL_HIST + 1
    outs = []
    for gi, win in enumerate(POOL_WINDOWS):
        sl = slice(gi * POOL_GC, (gi + 1) * POOL_GC)
        wsum = cs[:, end:end + T, sl] - cs[:, end - win:end - win + T, sl]
        cnt = jnp.minimum(jnp.float32(win), pos + 1.0)
        d = wsum / cnt[None, :, None] - u[..., sl].astype(jnp.float32)
        outs.append(jnp.einsum('btc,cd->btd', d.astype(u.dtype), w_pool[gi]))
    out = jnp.concatenate(outs, axis=-1) * pool_scale
    return out, full[:, -POOL_HIST:]


def wkv7_scan(S0, r, decay, k, v, a, b):
    def step(S, xs):
        r_t, w_t, k_t, v_t, a_t, b_t = xs
        sa = jnp.einsum('bhvk,bhk->bhv', S, a_t)
        S = S * w_t[:, :, None, :] + sa[..., None] * b_t[:, :, None, :] + v_t[..., None] * k_t[:, :, None, :]
        return S, jnp.einsum('bhvk,bhk->bhv', S, r_t)
    xs = tuple(jnp.moveaxis(t.astype(jnp.float32), 1, 0) for t in (r, decay, k, v, a, b))
    S, ys = lax.scan(step, S0.astype(jnp.float32), xs)
    return jnp.moveaxis(ys, 0, 1), S


def pool_rwkv_mixer(h, pool_hist, shift_prev, wkv0, pos0, P):
    B, T, _ = h.shape
    f32 = jnp.float32
    heads = lambda t: t.reshape(B, T, RWKV_HEADS, RWKV_HEAD)
    p = jnp.einsum('btd,de->bte', h, P['w_in0'])
    u, z = p[..., :D_POOL], p[..., D_POOL:]
    pool_out, pool_new = pool_mix(u, pool_hist, pos0, P['w_pool'], P['pool_scale'])
    z_prev = jnp.concatenate([shift_prev[:, None, :].astype(z.dtype), z[:, :-1]], axis=1)
    zs = z + (z_prev - z) * P['mu_shift']
    r, k, v, xw, xa, xg = jnp.split(zs, SHIFT_SPLITS, axis=-1)
    w_log = -jax.nn.softplus(-(P['w0_decay'] + jnp.tanh(xw) @ P['w2_decay']).astype(f32)) - 0.5
    decay = jnp.exp(-jnp.exp(w_log))
    a = jax.nn.sigmoid((P['a0_iclr'] + xa @ P['a2_iclr']).astype(f32))
    g = jax.nn.sigmoid(xg) @ P['g2_gate']
    kk = heads((k * P['k_k']).astype(f32))
    kk = kk / jnp.maximum(jnp.sqrt(jnp.sum(kk * kk, axis=-1, keepdims=True)), 1e-12)
    k_mod = k.astype(f32) * (1.0 + (a - 1.0) * P['k_a'].astype(f32))
    r_h, k_h, v_h = heads(r.astype(f32)), heads(k_mod), heads(v.astype(f32))
    y, S = wkv7_scan(wkv0, r_h, heads(decay), k_h, v_h, -kk, kk * heads(a))
    mu = jnp.mean(y, axis=-1, keepdims=True)
    var = jnp.mean(jnp.square(y - mu), axis=-1, keepdims=True)
    yn = ((y - mu) * lax.rsqrt(var + LNX_EPS)).reshape(B, T, D_RWKV) * P['lnx_w'] + P['lnx_b']
    bonus = jnp.sum(r_h * k_h * P['r_k'].astype(f32), axis=-1, keepdims=True) * v_h
    y = (yn + bonus.reshape(B, T, D_RWKV)) * g.astype(f32)
    mixed = jnp.concatenate([pool_out, y.astype(h.dtype)], axis=-1)
    return mixed @ P['w_out0'], (pool_new, z[:, -1], S)


def band_attend(q, k, v, q_pos, k_pos, rel_bias):
    s = jnp.einsum('bqhd,bkhd->bhqk', q, k).astype(jnp.float32) * (ATT_HEAD_DIM ** -0.5)
    rel = jnp.clip(q_pos[:, None] - k_pos[None, :], -REL_CLIP, REL_CLIP) + REL_CLIP
    bias = jnp.take(rel_bias.astype(jnp.float32), rel, axis=1)
    qc = q_pos // CHUNK
    kc = k_pos // CHUNK
    ok = (k_pos[None, :] >= 0) & (kc[None, :] <= qc[:, None]) & (kc[None, :] >= qc[:, None] - N_PREV_CHUNKS)
    s = jnp.where(ok, s + bias, -1e30)
    p = jax.nn.softmax(s, axis=-1)
    return jnp.einsum('bhqk,bkhd->bqhd', p.astype(v.dtype), v)


def band_attn_prompt(q, k, v, rel_bias):
    B, T = q.shape[0], q.shape[1]
    n_chunks = T // CHUNK
    pad = ((0, 0), (PREV_ROWS, 0), (0, 0), (0, 0))
    k_pad, v_pad = jnp.pad(k, pad), jnp.pad(v, pad)

    def one_chunk(ci):
        start = ci * CHUNK
        qb = lax.dynamic_slice_in_dim(q, start, CHUNK, axis=1)
        kb = lax.dynamic_slice_in_dim(k_pad, start, BAND, axis=1)
        vb = lax.dynamic_slice_in_dim(v_pad, start, BAND, axis=1)
        q_pos = start + jnp.arange(CHUNK)
        k_pos = start - PREV_ROWS + jnp.arange(BAND)
        return band_attend(qb, kb, vb, q_pos, k_pos, rel_bias)

    o = lax.map(one_chunk, jnp.arange(n_chunks))
    return jnp.moveaxis(o, 0, 1).reshape(B, T, ATT_HEADS, ATT_HEAD_DIM)


def band_attn_sample(q, k, v, cache_k, cache_v, rel_bias):
    T, R = q.shape[1], cache_k.shape[1]
    kb = jnp.concatenate([cache_k.astype(k.dtype), k], axis=1)
    vb = jnp.concatenate([cache_v.astype(v.dtype), v], axis=1)
    k_pos = PAST_LEN - R + jnp.arange(R + T)
    q_pos = PAST_LEN + jnp.arange(T)
    return band_attend(q, kb, vb, q_pos, k_pos, rel_bias)


def band_attn_mixer(h, cache_k, cache_v, P):
    B, T, _ = h.shape
    qkv = (h @ P['w_qkv1']).reshape(B, T, 3, ATT_HEADS, ATT_HEAD_DIM)
    q, k, v = qkv[:, :, 0], qkv[:, :, 1], qkv[:, :, 2]
    if cache_k is None:
        o = band_attn_prompt(q, k, v, P['rel_bias'])
        keep = min(PREV_ROWS, T)
        new = (k[:, T - keep:], v[:, T - keep:])
    else:
        o = band_attn_sample(q, k, v, cache_k, cache_v, P['rel_bias'])
        new = (k, v)
    return o.reshape(B, T, D_MODEL) @ P['w_out1'], new


def run_group(x, c, pool_hist, shift_prev, wkv0, cache_k, cache_v, pos0, P):
    for layer in range(DEPTH):
        mod = jnp.einsum('bd,de->be', jax.nn.silu(c), P['w_ada'][layer]) + P['b_ada'][layer]
        sh1, sc1, gt1, sh2, sc2, gt2 = jnp.split(mod[:, None, :], 6, axis=-1)
        gn = P['g_norm'][layer]
        h = rmsnorm(x, gn[0]) * (1.0 + sc1) + sh1
        if layer % 2 == 0:
            o, (pool_new, shift_new, wkv_new) = pool_rwkv_mixer(h, pool_hist, shift_prev, wkv0, pos0, P)
        else:
            o, (k_new, v_new) = band_attn_mixer(h, cache_k, cache_v, P)
        x = x + gt1 * rmsnorm(o, gn[1])
        h = rmsnorm(x, gn[2]) * (1.0 + sc2) + sh2
        f = jnp.square(jax.nn.relu(h @ P['w_ff1'][layer])) @ P['w_ff2'][layer]
        x = x + gt2 * rmsnorm(f, gn[3])
    return x, pool_new, shift_new, wkv_new, k_new, v_new


def setup_inputs(seed: int = 0) -> dict:
    key = jax.random.key(seed)
    ks = iter(jax.random.split(key, 48))
    f32 = jnp.float32
    nrm = lambda shape, scale: jax.random.normal(next(ks), shape, f32) * scale
    D = D_MODEL
    att_rows = min(PREV_ROWS, PAST_LEN)
    return {
        'x_prompt': nrm((BATCH, SEQ, D), 1.0),
        'x_sample': nrm((DEC_BATCH, DEC_SEQ, D), 1.0),
        'c_prompt': nrm((BATCH, D), 1.0),
        'c_sample': nrm((DEC_BATCH, D), 1.0),
        'state_l0_pool': nrm((DEC_BATCH, POOL_HIST, D_POOL), 1.0),
        'state_l0_shift': nrm((DEC_BATCH, D_SHIFT), 1.0),
        'state_l0_wkv': nrm((DEC_BATCH, RWKV_HEADS, RWKV_HEAD, RWKV_HEAD), 0.5),
        'cache_l1_k': nrm((DEC_BATCH, att_rows, ATT_HEADS, ATT_HEAD_DIM), 1.0),
        'cache_l1_v': nrm((DEC_BATCH, att_rows, ATT_HEADS, ATT_HEAD_DIM), 1.0),
        'w_ada': nrm((DEPTH, D, 6 * D), 0.5 * D ** -0.5),
        'b_ada': nrm((DEPTH, 6 * D), 0.02),
        'g_norm': 1.0 + nrm((DEPTH, 4, D), 0.05),
        'w_in0': nrm((D, D_IN0), D ** -0.5),
        'w_pool': nrm((N_POOL_GROUPS, POOL_GC, POOL_GC), POOL_GC ** -0.5),
        'pool_scale': 1.0 + nrm((D_POOL,), 0.1),
        'mu_shift': jax.random.uniform(next(ks), (D_SHIFT,), f32),
        'w0_decay': jax.random.uniform(next(ks), (D_RWKV,), f32, -6.0, -1.0),
        'w2_decay': nrm((DECAY_LORA, D_RWKV), 0.5 * DECAY_LORA ** -0.5),
        'a0_iclr': nrm((D_RWKV,), 0.5),
        'a2_iclr': nrm((ICLR_LORA, D_RWKV), ICLR_LORA ** -0.5),
        'g2_gate': nrm((GATE_LORA, D_RWKV), GATE_LORA ** -0.5),
        'k_k': 0.85 + nrm((D_RWKV,), 0.05),
        'k_a': 1.0 + nrm((D_RWKV,), 0.05),
        'r_k': nrm((RWKV_HEADS, RWKV_HEAD), 0.1),
        'lnx_w': 1.0 + nrm((D_RWKV,), 0.05),
        'lnx_b': nrm((D_RWKV,), 0.02),
        'w_out0': nrm((D, D), D ** -0.5),
        'w_qkv1': nrm((D, 3 * D), D ** -0.5),
        'rel_bias': nrm((ATT_HEADS, 2 * REL_CLIP + 1), 0.5),
        'w_out1': nrm((D, D), D ** -0.5),
        'w_ff1': nrm((DEPTH, D, D_FF), D ** -0.5),
        'w_ff2': nrm((DEPTH, D_FF, D), D_FF ** -0.5),
    }


def reference(x_prompt, x_sample, c_prompt, c_sample, state_l0_pool, state_l0_shift, state_l0_wkv,
              cache_l1_k, cache_l1_v, w_ada, b_ada, g_norm, w_in0, w_pool, pool_scale, mu_shift,
              w0_decay, w2_decay, a0_iclr, a2_iclr, g2_gate, k_k, k_a, r_k, lnx_w, lnx_b, w_out0,
              w_qkv1, rel_bias, w_out1, w_ff1, w_ff2):
    P = {'w_ada': w_ada, 'b_ada': b_ada, 'g_norm': g_norm, 'w_in0': w_in0, 'w_pool': w_pool,
         'pool_scale': pool_scale, 'mu_shift': mu_shift, 'w0_decay': w0_decay, 'w2_decay': w2_decay,
         'a0_iclr': a0_iclr, 'a2_iclr': a2_iclr, 'g2_gate': g2_gate, 'k_k': k_k, 'k_a': k_a,
         'r_k': r_k, 'lnx_w': lnx_w, 'lnx_b': lnx_b, 'w_out0': w_out0, 'w_qkv1': w_qkv1,
         'rel_bias': rel_bias, 'w_out1': w_out1, 'w_ff1': w_ff1, 'w_ff2': w_ff2}
    B = x_prompt.shape[0]
    y_prompt, pool_p, shift_p, wkv_p, k_p, v_p = run_group(
        x_prompt, c_prompt,
        jnp.zeros((B, POOL_HIST, D_POOL), x_prompt.dtype),
        jnp.zeros((B, D_SHIFT), x_prompt.dtype),
        jnp.zeros((B, RWKV_HEADS, RWKV_HEAD, RWKV_HEAD), jnp.float32),
        None, None, 0, P)
    y_sample, pool_s, shift_s, wkv_s, k_s, v_s = run_group(
        x_sample, c_sample, state_l0_pool, state_l0_shift, state_l0_wkv,
        cache_l1_k, cache_l1_v, PAST_LEN, P)
    return (y_prompt, y_sample,
            pool_p.astype(state_l0_pool.dtype), pool_s.astype(state_l0_pool.dtype),
            shift_p.astype(state_l0_shift.dtype), shift_s.astype(state_l0_shift.dtype),
            wkv_p.astype(state_l0_wkv.dtype), wkv_s.astype(state_l0_wkv.dtype),
            k_p.astype(cache_l1_k.dtype), v_p.astype(cache_l1_v.dtype),
            k_s.astype(cache_l1_k.dtype), v_s.astype(cache_l1_v.dtype))
```

```cpp
#include <hip/hip_runtime.h>
#include <hip/hip_cooperative_groups.h>
#include <cstdio>
#include <cstdint>
namespace cg = cooperative_groups;

#define LAS __attribute__((address_space(3)))
typedef unsigned short bf16_t;
typedef short bf16x8 __attribute__((ext_vector_type(8)));
typedef short bf16x4 __attribute__((ext_vector_type(4)));
typedef float f32x4 __attribute__((ext_vector_type(4)));
typedef float f32x2 __attribute__((ext_vector_type(2)));
typedef unsigned u32x4 __attribute__((ext_vector_type(4)));
typedef unsigned u32x2 __attribute__((ext_vector_type(2)));

constexpr int TP = 16384, TS = 256, TA = TP + TS;
constexpr int D = 2048, DFF = 8192, DIN0 = 4352, DPOOL = 1024, DSHIFT = 3328;
constexpr int NWAVE = 8, NTHR = 512;
constexpr int CHK = 128, NCHK = TP / CHK;
constexpr size_t O_Y = 0, O_POOLP = 34078720, O_POOLS = 34094080, O_SHIFTP = 34216960, O_SHIFTS = 34220288,
                 O_WKVP = 34246912, O_WKVS = 34312448, O_KP = 34836736, O_VP = 35885312, O_KS = 36933888, O_VS = 37458176;
constexpr size_t W_IN0T = 0, W_OUT0T = 17825792, W_QKVT = 26214400, W_OUT1T = 51380224, W_FF1T = 59768832, W_FF2T = 93323264,
                 W_POOLT = 126877696, W_LORAT = 127401984, W_MOD = 128974848, W_MODPART = 129859584,
                 W_HA = 144015360, W_MIX = 212172800, W_O = 280330240, W_R = 348487680, WS_END = 697794560;
constexpr size_t W_AL = W_HA;
constexpr size_t W_SST = W_HA;
constexpr size_t W_PC = W_O, W_UC = W_O + 33554432;
constexpr size_t W_P = W_R, W_L = W_R + 144834560;
constexpr size_t W_F1 = W_R;
constexpr size_t W_QK = W_R, W_VT = W_R + 136314880, W_KS = W_R + 204472320, W_VST = W_R + 223346688;
constexpr int KSPLIT = 16;
constexpr size_t W_BAR = WS_END, WS_TOTAL = WS_END + 16384;
constexpr size_t W_OACC = W_R + 272629760, WS_END2 = WS_END;

struct Args {
    const float* in[32];
    float* out;
    unsigned char* ws;
    int ph_lo, ph_hi;
};
struct DArgs {
    LAS const unsigned long long* tab; int ph_lo, ph_hi;
    __device__ __forceinline__ unsigned long long ld(int i) const { const unsigned long long v = tab[i];
        const unsigned lo = __builtin_amdgcn_readfirstlane((unsigned)v), hi = __builtin_amdgcn_readfirstlane((unsigned)(v >> 32)); return ((unsigned long long)hi << 32) | lo; }
    __device__ __forceinline__ const float* in(int i) const { return (const float*)(const __attribute__((address_space(1))) float*)ld(i); }
    __device__ __forceinline__ float* outp() const { return (float*)(__attribute__((address_space(1))) float*)ld(32); }
    __device__ __forceinline__ unsigned char* wsp() const { return (unsigned char*)(__attribute__((address_space(1))) unsigned char*)ld(33); }
};
enum { I_XP = 0, I_XS, I_CP, I_CS, I_SPOOL, I_SSHIFT, I_SWKV, I_CK, I_CV, I_WADA, I_BADA, I_GNORM, I_WIN0, I_WPOOL, I_PSCALE, I_MU,
       I_W0, I_W2, I_A0, I_A2, I_G2, I_KK, I_KA, I_RK, I_LNW, I_LNB, I_WOUT0, I_WQKV, I_RELB, I_WOUT1, I_WFF1, I_WFF2 };

__device__ __forceinline__ float bf2f(bf16_t b) { return __uint_as_float(((unsigned)b) << 16); }
__device__ __forceinline__ float bflo(unsigned w) { return __uint_as_float(w << 16); }
__device__ __forceinline__ float bfhi(unsigned w) { return __uint_as_float(w & 0xffff0000u); }
__device__ __forceinline__ unsigned pk2(float lo, float hi) { unsigned r; asm("v_cvt_pk_bf16_f32 %0, %1, %2" : "=v"(r) : "v"(lo), "v"(hi)); return r; }
__device__ __forceinline__ bf16_t f2bf(float f) { return (bf16_t)(pk2(f, 0.f) & 0xffffu); }
__device__ __forceinline__ float rl(float v, int l) { return __int_as_float(__builtin_amdgcn_readlane(__float_as_int(v), l)); }
template <int CTRL> __device__ __forceinline__ float dppf(float v) { return __int_as_float(__builtin_amdgcn_update_dpp(0, __float_as_int(v), CTRL, 0xf, 0xf, false)); }
__device__ __forceinline__ float wave_sum(float v) {
    v += dppf<0xB1>(v); v += dppf<0x4E>(v); v += dppf<0x141>(v); v += dppf<0x140>(v);
    return (rl(v, 0) + rl(v, 16)) + (rl(v, 32) + rl(v, 48));
}
__device__ __forceinline__ float sigmoidf_(float x) { return __builtin_amdgcn_rcpf(1.f + __expf(-x)); }
__device__ __forceinline__ int entry_of(int row) { return row < TP ? 0 : 1 + ((row - TP) >> 5); }

namespace pg8 {
constexpr int BM = 256, BK = 64, HALF = 128, HTB = HALF * BK * 2, STAGE_BYTES = 8 * HTB, NXCD = 8, WGM = 8;
__device__ __forceinline__ int lds_byte(int r, int c) { const int st = (r >> 4) * 2 + (c >> 5), rr = r & 15, cc = c & 31, ob = rr * 64 + cc * 2; return st * 1024 + (ob ^ (((ob >> 9) & 1) << 5)); }
__device__ __forceinline__ void stage_rc(int b, int& R, int& C) { const int st = b / 1024, sb = b % 1024, swz = sb ^ (((sb >> 9) & 1) << 5); R = (st >> 1) * 16 + swz / 64; C = (st & 1) * 32 + (swz % 64) / 2; }
__device__ __forceinline__ int perm32(int rho) { const int n = rho >> 4, i = rho & 15; return 8 * (i >> 2) + 4 * n + (i & 3); }

struct Unit { const char* a; const char* b; int pm, pn, g, nt, sl; };
struct GDesc { const char* A; const char* B; int nM, nN; long a_pn_off; };
struct Sched {
    GDesc g0, g1; int n0, n1, G, c; long tstepA, tstepB; int nt0, S1, nt1, pm1; long ksb;
    __device__ __forceinline__ void decode(const GDesc& g, int L, Unit& u, int gi) const {
        const int nwg = g.nM * g.nN; int wgid = L;
        { const int q = nwg / NXCD, r = nwg % NXCD, xcd = wgid % NXCD, off = wgid / NXCD; wgid = (xcd < r ? xcd * (q + 1) : r * (q + 1) + (xcd - r) * q) + off; }
        const int nig = WGM * g.nN, gid = wgid / nig, fm = gid * WGM, gsz = (g.nM - fm) < WGM ? (g.nM - fm) : WGM;
        u.pm = fm + ((wgid % nig) % gsz); u.pn = (wgid % nig) / gsz; u.g = gi;
        u.a = g.A + (long)u.pm * tstepA + (long)u.pn * g.a_pn_off; u.b = g.B + (long)u.pn * tstepB;
    }
    __device__ __forceinline__ bool next(int i, Unit& u) const {
        const long L = (long)i * G + c;
        if (L < n0) { decode(g0, (int)L, u, 0); u.nt = nt0; return true; }
        if (L < n0 + n1) {
            if (S1 == 0) { decode(g1, (int)(L - n0), u, 1); u.nt = nt0; }
            else { const int q = (int)(L - n0), sl = q / g1.nN, pn = q % g1.nN; u.pm = pm1; u.pn = pn; u.g = 1; u.nt = nt1; u.sl = sl;
                u.a = g1.A + (long)pm1 * tstepA + (long)sl * ksb; u.b = g1.B + (long)pn * tstepB + (long)sl * ksb; }
            return true; }
        return false;
    }
};

template <int ACT> struct EpiBf16 {
    bf16_t* O; int ldc; const float* cs;
    __device__ __forceinline__ void operator()(const f32x4 (&acc)[2][2][4][2], const Unit& u, int wr, int wc, int fr, int fq) const {
        const int row0 = u.pm * BM + wr * 64 + fr, col0 = u.pn * BM + wc * 32 + 8 * fq;
        f32x4 sv[2][2];
        if (ACT == 2) {
#pragma unroll
            for (int bj = 0; bj < 2; ++bj)
#pragma unroll
                for (int n = 0; n < 2; ++n) sv[bj][n] = *(const f32x4*)(cs + col0 + bj * HALF + 4 * n);
        }
#pragma unroll
        for (int ai = 0; ai < 2; ++ai)
#pragma unroll
            for (int m = 0; m < 4; ++m) { bf16_t* rowp = O + (size_t)(row0 + ai * HALF + m * 16) * ldc + col0;
#pragma unroll
                for (int bj = 0; bj < 2; ++bj) { f32x4 v0 = acc[ai][bj][m][0], v1 = acc[ai][bj][m][1];
                    if (ACT == 1) {
#pragma unroll
                        for (int j = 0; j < 4; ++j) { const float a0 = fmaxf(v0[j], 0.f), a1 = fmaxf(v1[j], 0.f); v0[j] = a0 * a0; v1[j] = a1 * a1; } }
                    if (ACT == 2) { v0 = v0 * sv[bj][0]; v1 = v1 * sv[bj][1]; }
                    u32x4 w; w.x = pk2(v0[0], v0[1]); w.y = pk2(v0[2], v0[3]); w.z = pk2(v1[0], v1[1]); w.w = pk2(v1[2], v1[3]);
                    *(u32x4*)(rowp + bj * HALF) = w; } }
    }
};
struct EpiF32 {
    float* C; int ldc;
    __device__ __forceinline__ void operator()(const f32x4 (&acc)[2][2][4][2], const Unit& u, int wr, int wc, int fr, int fq) const {
        const int row0 = u.pm * BM + wr * 64 + fr, col0 = u.pn * BM + wc * 32 + 8 * fq;
#pragma unroll
        for (int ai = 0; ai < 2; ++ai)
#pragma unroll
            for (int m = 0; m < 4; ++m) { float* rowp = C + (size_t)(row0 + ai * HALF + m * 16) * ldc + col0;
#pragma unroll
                for (int bj = 0; bj < 2; ++bj)
#pragma unroll
                    for (int n = 0; n < 2; ++n) *(f32x4*)(rowp + bj * HALF + 4 * n) = acc[ai][bj][m][n]; }
    }
};
struct EpiPartF32 {
    float* C; int ldc;
    __device__ __forceinline__ void operator()(const f32x4 (&acc)[2][2][4][2], const Unit& u, int wr, int wc, int fr, int fq) const {
        const int row0 = wr * 64 + fr, col0 = u.pn * BM + wc * 32 + 8 * fq;
        float* base = C + (size_t)u.sl * 256 * ldc;
#pragma unroll
        for (int ai = 0; ai < 2; ++ai)
#pragma unroll
            for (int m = 0; m < 4; ++m) { float* rowp = base + (size_t)(row0 + ai * HALF + m * 16) * ldc + col0;
#pragma unroll
                for (int bj = 0; bj < 2; ++bj)
#pragma unroll
                    for (int n = 0; n < 2; ++n) *(f32x4*)(rowp + bj * HALF + 4 * n) = acc[ai][bj][m][n]; }
    }
};
template <class E0, class E1> struct Epi2 {
    E0 e0; E1 e1;
    __device__ __forceinline__ void operator()(const f32x4 (&acc)[2][2][4][2], const Unit& u, int wr, int wc, int fr, int fq) const {
        if (u.g == 0) e0(acc, u, wr, wc, fr, fq); else e1(acc, u, wr, wc, fr, fq);
    }
};

template <class Epi>
__device__ __forceinline__ void gemm_phase(LAS unsigned char* lds, const int K, const int lda, const int ldb, const Sched& S, const Epi& E) {
    const int tid = threadIdx.x, wid = __builtin_amdgcn_readfirstlane(tid >> 6), lane = tid & 63, wr = wid >> 2, wc = wid & 3, fr = lane & 15, fq = lane >> 4;
    unsigned voffA[2], voffB[2];
#pragma unroll
    for (int i = 0; i < 2; ++i) { int R, C; stage_rc(tid * 16 + i * 8192, R, C); const int Rb = (R & ~31) + perm32(R & 31);
        voffA[i] = (unsigned)(R * lda + C) * 2u; voffB[i] = (unsigned)(Rb * ldb + C) * 2u; }
    const size_t kstep = (size_t)(BK * 2);
    const size_t hstepA = (size_t)HALF * lda * 2, hstepB = (size_t)HALF * ldb * 2;
    const unsigned ldsw = (unsigned)wid * 1024u;
    const int aoff = lds_byte(wr * 64 + fr, fq * 8), boff = lds_byte(wc * 32 + fr, fq * 8);
#define PG8_SA(b, h) (((b) * 2 + (h)) * HTB)
#define PG8_SB(b, h) ((4 + (b) * 2 + (h)) * HTB)
#define PG8_STAGE(bufoff, gbase, voff) do { _Pragma("unroll") for (int _i = 0; _i < 2; ++_i) \
        __builtin_amdgcn_global_load_lds((const unsigned*)((const char*)(gbase) + (voff)[_i]), (LAS unsigned*)(lds + (bufoff) + ldsw + _i * 8192), 16, 0, 0); } while (0)
#define PG8_LDA(dst, b, h) do { _Pragma("unroll") for (int m = 0; m < 4; ++m) _Pragma("unroll") for (int k = 0; k < 2; ++k) dst[m][k] = *(const LAS bf16x8*)(lds + PG8_SA(b, h) + aoff + m * 2048 + k * 1024); } while (0)
#define PG8_LDB(dst, b, h) do { _Pragma("unroll") for (int n = 0; n < 2; ++n) _Pragma("unroll") for (int k = 0; k < 2; ++k) dst[n][k] = *(const LAS bf16x8*)(lds + PG8_SB(b, h) + boff + n * 2048 + k * 1024); } while (0)
#define PG8_MMA(ai, bj, At, Bt) do { __builtin_amdgcn_s_setprio(1); _Pragma("unroll") for (int m = 0; m < 4; ++m) _Pragma("unroll") for (int n = 0; n < 2; ++n) _Pragma("unroll") for (int k = 0; k < 2; ++k) \
        acc[ai][bj][m][n] = __builtin_amdgcn_mfma_f32_16x16x32_bf16(Bt[n][k], At[m][k], acc[ai][bj][m][n], 0, 0, 0); __builtin_amdgcn_s_setprio(0); } while (0)
#define PG8_WAIT_V(n) asm volatile("s_waitcnt vmcnt(" #n ")" ::: "memory")
#define PG8_WAIT_L(n) asm volatile("s_waitcnt lgkmcnt(" #n ")" ::: "memory")
#define PG8_BAR __builtin_amdgcn_s_barrier()
#define PG8_SCHED __builtin_amdgcn_sched_barrier(0)
    Unit cur, nxt; int ui = 0;
    if (!S.next(0, cur)) return;
    f32x4 acc[2][2][4][2];
#pragma unroll
    for (int a = 0; a < 2; ++a)
#pragma unroll
        for (int b = 0; b < 2; ++b)
#pragma unroll
            for (int m = 0; m < 4; ++m)
#pragma unroll
                for (int n = 0; n < 2; ++n) acc[a][b][m][n] = (f32x4){0.f, 0.f, 0.f, 0.f};
    bf16x8 At[4][2], B0[2][2], B1[2][2];
    const char* cA = cur.a; const char* cB = cur.b;
    PG8_STAGE(PG8_SB(0, 0), cB, voffB); PG8_STAGE(PG8_SB(0, 1), cB + hstepB, voffB); PG8_STAGE(PG8_SA(0, 0), cA, voffA); PG8_STAGE(PG8_SA(0, 1), cA + hstepA, voffA);
    if (wr == 1) PG8_BAR;
    PG8_WAIT_V(2); PG8_BAR;
    PG8_STAGE(PG8_SB(1, 0), cB + kstep, voffB); PG8_STAGE(PG8_SA(1, 0), cA + kstep, voffA); PG8_STAGE(PG8_SB(1, 1), cB + hstepB + kstep, voffB);
    PG8_WAIT_V(6); PG8_BAR;
    for (;;) {
        const bool has_next = S.next(ui + 1, nxt);
        const char* nA = has_next ? nxt.a : cA; const char* nB = has_next ? nxt.b : cB;
        const int nt = cur.nt;
#pragma unroll 1
        for (int t = 0; t < nt; t += 2) {
            const bool last = (t == nt - 2);
            const char* a1 = cA + (size_t)(t + 1) * kstep;
            const char* a2 = last ? nA : cA + (size_t)(t + 2) * kstep; const char* b2 = last ? nB : cB + (size_t)(t + 2) * kstep;
            const char* a3 = a2 + kstep; const char* b3 = b2 + kstep;
            PG8_LDB(B0, 0, 0); PG8_LDB(B1, 0, 1); PG8_SCHED; PG8_LDA(At, 0, 0); PG8_STAGE(PG8_SA(1, 1), a1 + hstepA, voffA);
            PG8_WAIT_V(8); PG8_WAIT_L(0); PG8_BAR; PG8_MMA(0, 0, At, B0); PG8_MMA(0, 1, At, B1); PG8_BAR; PG8_SCHED;
            PG8_LDA(At, 0, 1); PG8_STAGE(PG8_SB(0, 0), b2, voffB); PG8_STAGE(PG8_SB(0, 1), b2 + hstepB, voffB); PG8_STAGE(PG8_SA(0, 0), a2, voffA);
            PG8_WAIT_V(8); PG8_WAIT_L(0); PG8_BAR; PG8_MMA(1, 0, At, B0); PG8_MMA(1, 1, At, B1); PG8_BAR; PG8_SCHED;
            PG8_LDB(B0, 1, 0); PG8_LDB(B1, 1, 1); PG8_SCHED; PG8_LDA(At, 1, 0); PG8_STAGE(PG8_SA(0, 1), a2 + hstepA, voffA);
            PG8_WAIT_V(8); PG8_WAIT_L(0); PG8_BAR; PG8_MMA(0, 0, At, B0); PG8_MMA(0, 1, At, B1); PG8_BAR; PG8_SCHED;
            PG8_LDA(At, 1, 1); PG8_STAGE(PG8_SB(1, 0), b3, voffB); PG8_STAGE(PG8_SB(1, 1), b3 + hstepB, voffB); PG8_STAGE(PG8_SA(1, 0), a3, voffA);
            PG8_WAIT_V(8); PG8_WAIT_L(0); PG8_BAR; PG8_MMA(1, 0, At, B0); PG8_MMA(1, 1, At, B1); PG8_BAR; PG8_SCHED;
        }
        if (wr == 0) PG8_BAR;
        E(acc, cur, wr, wc, fr, fq);
        if (!has_next) break;
#pragma unroll
        for (int a = 0; a < 2; ++a)
#pragma unroll
            for (int b = 0; b < 2; ++b)
#pragma unroll
                for (int m = 0; m < 4; ++m)
#pragma unroll
                    for (int n = 0; n < 2; ++n) acc[a][b][m][n] = (f32x4){0.f, 0.f, 0.f, 0.f};
        cur = nxt; cA = nA; cB = nB; ++ui;
        if (wr == 1) PG8_BAR;
    }
    PG8_WAIT_V(0);
    PG8_BAR;
#undef PG8_SA
#undef PG8_SB
#undef PG8_STAGE
#undef PG8_LDA
#undef PG8_LDB
#undef PG8_MMA
#undef PG8_WAIT_V
#undef PG8_WAIT_L
#undef PG8_BAR
#undef PG8_SCHED
}
}

template <class Epi>
__device__ __forceinline__ void run_gemm(LAS unsigned char* lds, int K, int lda, int ldb, const void* A0, const void* B0, int nM0, int nN0, long apn0,
                                         const void* A1, const void* B1, int nM1, int nN1, const Epi& E, int S1 = 0, int pm1 = 0) {
    pg8::Sched S;
    S.nt0 = K / 64; S.S1 = S1; S.pm1 = pm1; S.nt1 = S1 ? K / 64 / S1 : 0; S.ksb = S1 ? (long)(K / S1) * 2 : 0;
    S.g0.A = (const char*)A0; S.g0.B = (const char*)B0; S.g0.nM = nM0; S.g0.nN = nN0; S.g0.a_pn_off = apn0;
    S.g1.A = (const char*)A1; S.g1.B = (const char*)B1; S.g1.nM = nM1; S.g1.nN = nN1; S.g1.a_pn_off = 0;
    S.n0 = nM0 * nN0; S.n1 = S1 ? S1 * nN1 : nM1 * nN1; S.G = gridDim.x; S.c = blockIdx.x;
    S.tstepA = (long)256 * lda * 2; S.tstepB = (long)256 * ldb * 2;
    pg8::gemm_phase<Epi>(lds, K, lda, ldb, S, E);
    __syncthreads();
}

__device__ __forceinline__ void transpose_item(const float* W, int ldw, bf16_t* WT, int ldo, LAS float* scr, int k0, int n0, int lane, const float* rs = nullptr) {
#pragma unroll 8
    for (int i = 0; i < 32; ++i) { const int kk = 2 * i + (lane >> 5); scr[kk * 33 + (lane & 31)] = W[(size_t)(k0 + kk) * ldw + n0 + (lane & 31)]; }
    asm volatile("s_waitcnt lgkmcnt(0)" ::: "memory");
    const int c = lane & 7;
#pragma unroll
    for (int j = 0; j < 4; ++j) { const int n = (lane >> 3) + 8 * j; const LAS float* s = scr + (8 * c) * 33 + n; const float m = rs ? rs[n0 + n] : 1.f;
        u32x4 o; o.x = pk2(s[0 * 33] * m, s[1 * 33] * m); o.y = pk2(s[2 * 33] * m, s[3 * 33] * m); o.z = pk2(s[4 * 33] * m, s[5 * 33] * m); o.w = pk2(s[6 * 33] * m, s[7 * 33] * m);
        *(u32x4*)(WT + (size_t)(n0 + n) * ldo + k0 + 8 * c) = o; }
    asm volatile("s_waitcnt lgkmcnt(0)" ::: "memory");
}
__device__ __forceinline__ void transpose_matrix(const float* W, int K, int N, bf16_t* WT, int ldo, LAS float* scr, int gw, int ngw, int lane, const float* rs = nullptr) {
    const int nblk = N / 32, nitems = (K / 64) * nblk;
    for (int it = gw; it < nitems; it += ngw) { const int kb = it / nblk, nb = it % nblk; transpose_item(W, N, WT, ldo, scr, kb * 64, nb * 32, lane, rs); }
}

__device__ __forceinline__ void phase_mod_partial(const DArgs& a, LAS unsigned char* lds) {
    LAS float* sil = (LAS float*)lds;
    for (int i = threadIdx.x; i < 9 * D; i += NTHR) { const int e = i / D, d = i % D; const float c = e == 0 ? a.in(I_CP)[d] : a.in(I_CS)[(e - 1) * D + d]; sil[i] = c / (1.f + __expf(-c)); }
    __syncthreads();
    const int wave = threadIdx.x >> 6, lane = threadIdx.x & 63, gw = blockIdx.x * NWAVE + wave, ngw = gridDim.x * NWAVE;
    float* part = (float*)(a.wsp() + W_MODPART);
    constexpr int NT = 6 * D / 256;
    constexpr int KR = D / KSPLIT;
    for (int it = gw; it < 2 * NT * KSPLIT; it += ngw) {
        const int ks = it % KSPLIT, nt = (it / KSPLIT) % NT, l = it / (KSPLIT * NT);
        const float* w = a.in(I_WADA) + (size_t)l * D * 6 * D + (size_t)(ks * KR) * 6 * D + nt * 256 + lane * 4;
        f32x4 acc[9];
#pragma unroll
        for (int e = 0; e < 9; ++e) acc[e] = (f32x4){0.f, 0.f, 0.f, 0.f};
#pragma unroll 4
        for (int d = 0; d < KR; ++d) {
            const f32x4 wv = *(const f32x4*)(w + (size_t)d * 6 * D);
#pragma unroll
            for (int e = 0; e < 9; ++e) { const float s = sil[e * D + ks * KR + d]; acc[e] += wv * s; }
        }
#pragma unroll
        for (int e = 0; e < 9; ++e) *(f32x4*)(part + ((size_t)(ks * 9 + e) * 2 + l) * 6 * D + nt * 256 + lane * 4) = acc[e];
    }
    __syncthreads();
}
enum { CV_OUT0 = 0, CV_QKV, CV_OUT1, CV_FF1_0, CV_FF2_0, CV_FF1_1, CV_FF2_1 };
__device__ __forceinline__ void convert_sub(const DArgs& a, LAS unsigned char* lds, int which, int c0) {
    if ((int)blockIdx.x < c0) return;
    const int wave = threadIdx.x >> 6, lane = threadIdx.x & 63, gw = ((int)blockIdx.x - c0) * NWAVE + wave, ngw = ((int)gridDim.x - c0) * NWAVE;
    LAS float* scr = (LAS float*)(lds + wave * 8448);
    unsigned char* w = a.wsp();
    switch (which) {
    case CV_OUT0: transpose_matrix(a.in(I_WOUT0), D, D, (bf16_t*)(w + W_OUT0T), D, scr, gw, ngw, lane); break;
    case CV_QKV: transpose_matrix(a.in(I_WQKV), D, 3 * D, (bf16_t*)(w + W_QKVT), D, scr, gw, ngw, lane); break;
    case CV_OUT1: transpose_matrix(a.in(I_WOUT1), D, D, (bf16_t*)(w + W_OUT1T), D, scr, gw, ngw, lane); break;
    case CV_FF1_0: transpose_matrix(a.in(I_WFF1), D, DFF, (bf16_t*)(w + W_FF1T), D, scr, gw, ngw, lane); break;
    case CV_FF2_0: transpose_matrix(a.in(I_WFF2), DFF, D, (bf16_t*)(w + W_FF2T), DFF, scr, gw, ngw, lane); break;
    case CV_FF1_1: transpose_matrix(a.in(I_WFF1) + (size_t)D * DFF, D, DFF, (bf16_t*)(w + W_FF1T), D, scr, gw, ngw, lane); break;
    default: transpose_matrix(a.in(I_WFF2) + (size_t)DFF * D, DFF, D, (bf16_t*)(w + W_FF2T), DFF, scr, gw, ngw, lane); break;
    }
}
__device__ __forceinline__ void phase_convert(const DArgs& a, LAS unsigned char* lds) {
    const int wave = threadIdx.x >> 6, lane = threadIdx.x & 63, gw = blockIdx.x * NWAVE + wave, ngw = gridDim.x * NWAVE;
    LAS float* scr = (LAS float*)(lds + wave * 8448);
    transpose_matrix(a.in(I_WIN0), D, DIN0, (bf16_t*)(a.wsp() + W_IN0T), D, scr, gw, ngw, lane);
    for (int g = 0; g < 4; ++g) transpose_matrix(a.in(I_WPOOL) + (size_t)g * 65536, 256, 256, (bf16_t*)(a.wsp() + W_POOLT) + (size_t)g * 65536, 256, scr, gw, ngw, lane, a.in(I_PSCALE) + g * 256);
    bf16_t* lt = (bf16_t*)(a.wsp() + W_LORAT);
    for (int i = blockIdx.x * NTHR + threadIdx.x; i < 3072 * 256; i += gridDim.x * NTHR) {
        const int row = i >> 8, k = i & 255, part = row >> 10, n = row & 1023; float v = 0.f;
        if (part == 0) { if (k < 64) v = a.in(I_W2)[k * 1024 + n]; }
        else if (part == 1) { if (k >= 64 && k < 128) v = a.in(I_A2)[(k - 64) * 1024 + n]; }
        else { if (k >= 128) v = a.in(I_G2)[(k - 128) * 1024 + n]; }
        lt[i] = f2bf(v);
    }
}
__device__ __forceinline__ void phase_mod_final(const DArgs& a) {
    const float* part = (const float*)(a.wsp() + W_MODPART); float* mod = (float*)(a.wsp() + W_MOD);
    for (int i = blockIdx.x * NTHR + threadIdx.x; i < 9 * 2 * 6 * D; i += gridDim.x * NTHR) {
        const int n = i % (6 * D), l = (i / (6 * D)) & 1;
        float s = a.in(I_BADA)[l * 6 * D + n];
#pragma unroll
        for (int ks = 0; ks < KSPLIT; ++ks) s += part[(size_t)ks * 9 * 2 * 6 * D + i];
        mod[i] = s;
    }
}
__device__ __forceinline__ void zero_oacc(const DArgs& a) {
    f32x4* p = (f32x4*)(a.wsp() + W_OACC);
    for (int i = blockIdx.x * NTHR + threadIdx.x; i < TS * D / 4; i += gridDim.x * NTHR) p[i] = (f32x4){0.f, 0.f, 0.f, 0.f};
}
template <bool XIN_INPUT, bool HAS_O, bool HAS_H>
__device__ __forceinline__ void phase_rowwise(const DArgs& a, const float* g_o, int l_gt, int gt_which, const float* g_h, int l_h, int sc_which, int sh_which, int nsl = 0) {
    const int wave = threadIdx.x >> 6, lane = threadIdx.x & 63, gw = blockIdx.x * NWAVE + wave, ngw = gridDim.x * NWAVE;
    const float* mod = (const float*)(a.wsp() + W_MOD);
    float* X = a.outp() + O_Y; const bf16_t* o = (const bf16_t*)(a.wsp() + W_O); bf16_t* hA = (bf16_t*)(a.wsp() + W_HA); const float* oacc = (const float*)(a.wsp() + W_OACC);
    for (int row = gw; row < TA; row += ngw) {
        const int e = entry_of(row);
        const float* xin = XIN_INPUT ? (row < TP ? a.in(I_XP) + (size_t)row * D : a.in(I_XS) + (size_t)(row - TP) * D) : X + (size_t)row * D;
        f32x4 x[8];
#pragma unroll
        for (int j = 0; j < 8; ++j) x[j] = *(const f32x4*)(xin + 4 * (lane + 64 * j));
        if (HAS_O) {
            f32x4 ov[8]; float ss = 0.f;
            if (row < TP) {
#pragma unroll
                for (int j = 0; j < 8; ++j) { const u32x2 w = *(const u32x2*)(o + (size_t)row * D + 4 * (lane + 64 * j)); ov[j] = (f32x4){bflo(w.x), bfhi(w.x), bflo(w.y), bfhi(w.y)}; }
            } else {
#pragma unroll
                for (int j = 0; j < 8; ++j) ov[j] = (f32x4){0.f, 0.f, 0.f, 0.f};
#pragma unroll 2
                for (int sl = 0; sl < nsl; ++sl) {
#pragma unroll
                    for (int j = 0; j < 8; ++j) ov[j] += *(const f32x4*)(oacc + ((size_t)sl * TS + (row - TP)) * D + 4 * (lane + 64 * j));
                }
            }
#pragma unroll
            for (int j = 0; j < 8; ++j) ss += (ov[j].x * ov[j].x + ov[j].y * ov[j].y) + (ov[j].z * ov[j].z + ov[j].w * ov[j].w);
            const float rstd = rsqrtf(wave_sum(ss) * (1.f / D) + 1e-6f);
            const float* gt = mod + (size_t)(e * 2 + l_gt) * 6 * D + gt_which * D;
#pragma unroll
            for (int j = 0; j < 8; ++j) { const int c = 4 * (lane + 64 * j); const f32x4 g = *(const f32x4*)(gt + c), go = *(const f32x4*)(g_o + c);
                x[j] += g * (ov[j] * rstd * go); *(f32x4*)(X + (size_t)row * D + c) = x[j]; }
        }
        if (HAS_H) {
            float ss = 0.f;
#pragma unroll
            for (int j = 0; j < 8; ++j) ss += (x[j].x * x[j].x + x[j].y * x[j].y) + (x[j].z * x[j].z + x[j].w * x[j].w);
            const float rstd = rsqrtf(wave_sum(ss) * (1.f / D) + 1e-6f);
            const float* sc = mod + (size_t)(e * 2 + l_h) * 6 * D + sc_which * D; const float* sh = mod + (size_t)(e * 2 + l_h) * 6 * D + sh_which * D;
#pragma unroll
            for (int j = 0; j < 8; ++j) { const int c = 4 * (lane + 64 * j); const f32x4 g = *(const f32x4*)(g_h + c), s1 = *(const f32x4*)(sc + c), s0 = *(const f32x4*)(sh + c);
                const f32x4 h = x[j] * rstd * g * (s1 + 1.f) + s0; u32x2 w; w.x = pk2(h.x, h.y); w.y = pk2(h.z, h.w);
                *(u32x2*)(hA + (size_t)row * D + c) = w; }
        }
    }
}
__device__ __forceinline__ void ld8bf(const bf16_t* p, float (&v)[8]) { const u32x4 w = *(const u32x4*)p; v[0] = bflo(w.x); v[1] = bfhi(w.x); v[2] = bflo(w.y); v[3] = bfhi(w.y); v[4] = bflo(w.z); v[5] = bfhi(w.z); v[6] = bflo(w.w); v[7] = bfhi(w.w); }
__device__ __forceinline__ void ld8f(const float* p, float (&v)[8]) { const f32x4 a = *(const f32x4*)p, b = *(const f32x4*)(p + 4); v[0] = a.x; v[1] = a.y; v[2] = a.z; v[3] = a.w; v[4] = b.x; v[5] = b.y; v[6] = b.z; v[7] = b.w; }
__device__ __forceinline__ void st8bf(bf16_t* p, const float (&v)[8]) { u32x4 w; w.x = pk2(v[0], v[1]); w.y = pk2(v[2], v[3]); w.z = pk2(v[4], v[5]); w.w = pk2(v[6], v[7]); *(u32x4*)p = w; }
template <int WIN> __device__ __forceinline__ void pool_sum(const bf16_t* p, float (&s)[8], float (&u)[8]) {
    u32x4 w[WIN];
#pragma unroll
    for (int sf = 0; sf < WIN; ++sf) w[sf] = *(const u32x4*)(p - (size_t)sf * DIN0);
    u[0] = bflo(w[0].x); u[1] = bfhi(w[0].x); u[2] = bflo(w[0].y); u[3] = bfhi(w[0].y); u[4] = bflo(w[0].z); u[5] = bfhi(w[0].z); u[6] = bflo(w[0].w); u[7] = bfhi(w[0].w);
#pragma unroll
    for (int i = 0; i < 8; ++i) s[i] = u[i];
#pragma unroll
    for (int sf = 1; sf < WIN; ++sf) { s[0] += bflo(w[sf].x); s[1] += bfhi(w[sf].x); s[2] += bflo(w[sf].y); s[3] += bfhi(w[sf].y); s[4] += bflo(w[sf].z); s[5] += bfhi(w[sf].z); s[6] += bflo(w[sf].w); s[7] += bfhi(w[sf].w); }
}
__device__ __forceinline__ void phase_prep(const DArgs& a) {
    const bf16_t* P = (const bf16_t*)(a.wsp() + W_P); bf16_t* AL = (bf16_t*)(a.wsp() + W_AL);
    const int gt = blockIdx.x * NTHR + threadIdx.x, ngt = gridDim.x * NTHR;
    for (int idx = gt; idx < TA * 160; idx += ngt) {
        const int row = idx / 160, it = idx % 160; const bool prompt = row < TP; const int t = prompt ? row : ((row - TP) & 31), b = prompt ? 0 : ((row - TP) >> 5);
        if (it < 128) {
            const int c0 = it * 8, gi = c0 >> 8, win = 2 << gi;
            float s[8], u[8], v[8];
            if (t >= win - 1) {
                const bf16_t* p = P + (size_t)row * DIN0 + c0;
                if (gi == 0) pool_sum<2>(p, s, u); else if (gi == 1) pool_sum<4>(p, s, u); else if (gi == 2) pool_sum<8>(p, s, u); else pool_sum<16>(p, s, u);
                const float inv = 1.f / (float)win;
#pragma unroll
                for (int i = 0; i < 8; ++i) s[i] = s[i] * inv - u[i];
            } else {
#pragma unroll
                for (int i = 0; i < 8; ++i) s[i] = 0.f;
                for (int sf = 0; sf < win; ++sf) { const int tt = t - sf;
                    if (tt >= 0) { ld8bf(P + (size_t)(row - sf) * DIN0 + c0, v);
#pragma unroll
                        for (int i = 0; i < 8; ++i) s[i] += v[i]; }
                    else if (!prompt) { ld8f(a.in(I_SPOOL) + ((size_t)b * 15 + (15 + tt)) * DPOOL + c0, v);
#pragma unroll
                        for (int i = 0; i < 8; ++i) s[i] += v[i]; } }
                const float cnt = prompt ? (float)min(win, t + 1) : (float)win, inv = 1.f / cnt;
                ld8bf(P + (size_t)row * DIN0 + c0, u);
#pragma unroll
                for (int i = 0; i < 8; ++i) s[i] = s[i] * inv - u[i];
            }
            st8bf(AL + (size_t)row * 1280 + c0, s);
        } else {
            const int q0 = (it - 128) * 8, e0 = 3072 + q0;
            float z[8], zp[8], mu[8];
            ld8bf(P + (size_t)row * DIN0 + DPOOL + e0, z);
            if (t > 0) ld8bf(P + (size_t)(row - 1) * DIN0 + DPOOL + e0, zp);
            else if (!prompt) ld8f(a.in(I_SSHIFT) + (size_t)b * DSHIFT + e0, zp);
            else {
#pragma unroll
                for (int i = 0; i < 8; ++i) zp[i] = 0.f; }
            ld8f(a.in(I_MU) + e0, mu);
#pragma unroll
            for (int i = 0; i < 8; ++i) { const float zs = z[i] + (zp[i] - z[i]) * mu[i];
                z[i] = q0 < 64 ? 1.f - 2.f / (1.f + __expf(2.f * zs)) : (q0 < 128 ? zs : sigmoidf_(zs)); }
            st8bf(AL + (size_t)row * 1280 + 1024 + q0, z);
        }
    }
    for (int i = gt; i < 15 * DPOOL; i += ngt) a.outp()[O_POOLP + i] = bf2f(P[(size_t)(TP - 15 + i / DPOOL) * DIN0 + (i % DPOOL)]);
    for (int i = gt; i < 8 * 15 * DPOOL; i += ngt) { const int b = i / (15 * DPOOL), r = (i / DPOOL) % 15, c = i % DPOOL; a.outp()[O_POOLS + i] = bf2f(P[(size_t)(TP + b * 32 + 17 + r) * DIN0 + c]); }
    for (int i = gt; i < DSHIFT; i += ngt) a.outp()[O_SHIFTP + i] = bf2f(P[(size_t)(TP - 1) * DIN0 + DPOOL + i]);
    for (int i = gt; i < 8 * DSHIFT; i += ngt) { const int b = i / DSHIFT, e = i % DSHIFT; a.outp()[O_SHIFTS + i] = bf2f(P[(size_t)(TP + b * 32 + 31) * DIN0 + DPOOL + e]); }
}

struct ScanConst { float mu_r, mu_k, mu_v, w0, a0, kkc, kac, rk, lnw, lnb; };
struct ScanRaw { bf16_t zr, zk, zv; float lw, la, lg; };
template <bool NEEDG> __device__ __forceinline__ ScanRaw scan_load(const bf16_t* P, const float* L, int row, int c) {
    ScanRaw r; const bf16_t* p = P + (size_t)row * DIN0 + DPOOL + c; r.zr = p[0]; r.zk = p[1024]; r.zv = p[2048];
    const float* l = L + (size_t)row * 3072 + c; r.lw = l[0]; r.la = l[1024]; r.lg = NEEDG ? l[2048] : 0.f; return r;
}
template <int MODE>
__device__ __forceinline__ void scan_item(const DArgs& a, LAS float* W  , int row0, int nsteps, int h, int lane, bool first_is_start, const float* shift_prev  ,
                                          const float* S_init  , float* S_final  , float* Uout, float* Pout) {
    const bf16_t* P = (const bf16_t*)(a.wsp() + W_P); const float* L = (const float*)(a.wsp() + W_L); bf16_t* mix = (bf16_t*)(a.wsp() + W_MIX);
    const int c = h * 64 + lane, ib = lane >> 4, il = lane & 15;
    ScanConst k; k.mu_r = a.in(I_MU)[c]; k.mu_k = a.in(I_MU)[1024 + c]; k.mu_v = a.in(I_MU)[2048 + c]; k.w0 = a.in(I_W0)[c]; k.a0 = a.in(I_A0)[c];
    k.kkc = a.in(I_KK)[c]; k.kac = a.in(I_KA)[c]; k.rk = a.in(I_RK)[c]; k.lnw = a.in(I_LNW)[c]; k.lnb = a.in(I_LNB)[c];
    float zr_p, zk_p, zv_p;
    if (!first_is_start) { const bf16_t* p = P + (size_t)(row0 - 1) * DIN0 + DPOOL + c; zr_p = bf2f(p[0]); zk_p = bf2f(p[1024]); zv_p = bf2f(p[2048]); }
    else if (shift_prev) { zr_p = shift_prev[c]; zk_p = shift_prev[1024 + c]; zv_p = shift_prev[2048 + c]; }
    else { zr_p = 0.f; zk_p = 0.f; zv_p = 0.f; }
    f32x2 S[4][8];
    if constexpr (MODE == 1) {
#pragma unroll
        for (int q = 0; q < 4; ++q)
#pragma unroll
            for (int m = 0; m < 4; ++m) { const f32x4 v = *(const f32x4*)(S_init + (il + 16 * q) * 64 + 16 * ib + 4 * m); S[q][2 * m] = (f32x2){v.x, v.y}; S[q][2 * m + 1] = (f32x2){v.z, v.w}; }
    } else {
#pragma unroll
        for (int q = 0; q < 4; ++q)
#pragma unroll
            for (int p = 0; p < 8; ++p) S[q][p] = MODE == 2 ? (f32x2){(q == ib && 2 * p == il) ? 1.f : 0.f, (q == ib && 2 * p + 1 == il) ? 1.f : 0.f} : (f32x2){0.f, 0.f};
    }
#define LDV(dst_, vec_) { _Pragma("unroll") for (int m = 0; m < 4; ++m) { const f32x4 t_ = *(const LAS f32x4*)(W + (vec_) * 64 + 16 * ib + 4 * m); dst_[2 * m] = (f32x2){t_.x, t_.y}; dst_[2 * m + 1] = (f32x2){t_.z, t_.w}; } }
#define XSUM(x_) { const u32x2 s16_ = __builtin_amdgcn_permlane16_swap(__float_as_uint(x_), __float_as_uint(x_), false, false); x_ = __uint_as_float(s16_.x) + __uint_as_float(s16_.y); \
                   const u32x2 s32_ = __builtin_amdgcn_permlane32_swap(__float_as_uint(x_), __float_as_uint(x_), false, false); x_ = __uint_as_float(s32_.x) + __uint_as_float(s32_.y); }
    struct Prep { float an, dec, bn, kmod, r, v, lg, bin; };
    auto prep = [&](const ScanRaw& rw) -> Prep {
        Prep o; const float zr = bf2f(rw.zr), zk = bf2f(rw.zk), zv = bf2f(rw.zv);
        const float r = zr + (zr_p - zr) * k.mu_r, kx = zk + (zk_p - zk) * k.mu_k; o.v = zv + (zv_p - zv) * k.mu_v;
        zr_p = zr; zk_p = zk; zv_p = zv;
        o.dec = __expf(-0.60653066f * sigmoidf_(k.w0 + rw.lw));
        const float ai = sigmoidf_(k.a0 + rw.la);
        const float kkr = kx * k.kkc, ssq = wave_sum(kkr * kkr), kk = kkr * rsqrtf(fmaxf(ssq, 1e-24f));
        o.kmod = kx * (1.f + (ai - 1.f) * k.kac); o.an = -kk; o.bn = kk * ai; o.r = r; o.lg = rw.lg; o.bin = r * o.kmod * k.rk; return o; };
    auto post = [&](float y, float bin, float v, float lg, int row, bool doit) {
        const float mean = wave_sum(y) * (1.f / 64.f), dy = y - mean, var = wave_sum(dy * dy) * (1.f / 64.f);
        const float yn = dy * rsqrtf(var + 64e-5f) * k.lnw + k.lnb;
        const float bonus = wave_sum(bin) * v;
        if (doit) mix[(size_t)row * D + 1024 + c] = f2bf((yn + bonus) * lg); };
    ScanRaw raw1 = scan_load<MODE == 1>(P, L, row0 + (nsteps > 1 ? 1 : 0), c);
    Prep pv = prep(scan_load<MODE == 1>(P, L, row0, c));
    float yp = 0.f, binp = 0.f, vp = 0.f, lgp = 0.f;
    for (int t = 0; t < nsteps; ++t) {
        const int row = row0 + t;
        const ScanRaw raw2 = scan_load<MODE == 1>(P, L, row0 + (t + 2 < nsteps ? t + 2 : nsteps - 1), c);
        W[lane] = pv.an; W[64 + lane] = pv.dec; W[128 + lane] = pv.bn; if constexpr (MODE != 2) { W[192 + lane] = pv.kmod; W[320 + lane] = pv.v; } if constexpr (MODE == 1) W[256 + lane] = pv.r;
        const Prep pn = prep(raw1);
        constexpr int NS = 2, PW = 8 / NS;
        float sa[4];
#pragma unroll
        for (int q = 0; q < 4; ++q) sa[q] = 0.f;
#pragma unroll
        for (int hf = 0; hf < NS; ++hf) {
            f32x2 av[PW];
#pragma unroll
            for (int m = 0; m < PW / 2; ++m) { const f32x4 t0 = *(const LAS f32x4*)(W + 16 * ib + 2 * PW * hf + 4 * m); av[2 * m] = (f32x2){t0.x, t0.y}; av[2 * m + 1] = (f32x2){t0.z, t0.w}; }
#pragma unroll
            for (int q = 0; q < 4; ++q) {
                f32x2 d = S[q][PW * hf] * av[0];
#pragma unroll
                for (int p = 1; p < PW; ++p) d += S[q][PW * hf + p] * av[p];
                sa[q] += d.x + d.y;
            }
        }
#pragma unroll
        for (int q = 0; q < 4; ++q) { XSUM(sa[q]) }
        float vq[4];
#pragma unroll
        for (int q = 0; q < 4; ++q) vq[q] = MODE == 2 ? 0.f : W[320 + il + 16 * q];
#pragma unroll
        for (int hf = 0; hf < NS; ++hf) {
            f32x2 wv[PW], bv[PW], kv[PW];
#pragma unroll
            for (int m = 0; m < PW / 2; ++m) { const int o_ = 16 * ib + 2 * PW * hf + 4 * m; const f32x4 t0 = *(const LAS f32x4*)(W + 64 + o_), t1 = *(const LAS f32x4*)(W + 128 + o_), t2 = MODE == 2 ? t1 : *(const LAS f32x4*)(W + 192 + o_);
                wv[2 * m] = (f32x2){t0.x, t0.y}; wv[2 * m + 1] = (f32x2){t0.z, t0.w}; bv[2 * m] = (f32x2){t1.x, t1.y}; bv[2 * m + 1] = (f32x2){t1.z, t1.w}; kv[2 * m] = (f32x2){t2.x, t2.y}; kv[2 * m + 1] = (f32x2){t2.z, t2.w}; }
#pragma unroll
            for (int q = 0; q < 4; ++q) {
                const f32x2 sa2 = (f32x2){sa[q], sa[q]}, v2 = (f32x2){vq[q], vq[q]};
#pragma unroll
                for (int p = 0; p < PW; ++p) { if constexpr (MODE == 2) S[q][PW * hf + p] = S[q][PW * hf + p] * wv[p] + sa2 * bv[p]; else S[q][PW * hf + p] = S[q][PW * hf + p] * wv[p] + (sa2 * bv[p] + v2 * kv[p]); }
            }
        }
        if constexpr (MODE == 1) {
            f32x2 rv[8];
            LDV(rv, 4)
            float yq[4];
#pragma unroll
            for (int q = 0; q < 4; ++q) { f32x2 d = S[q][0] * rv[0];
#pragma unroll
                for (int p = 1; p < 8; ++p) d += S[q][p] * rv[p];
                yq[q] = d.x + d.y; }
#pragma unroll
            for (int q = 0; q < 4; ++q) XSUM(yq[q])
            const float y = ib == 0 ? yq[0] : (ib == 1 ? yq[1] : (ib == 2 ? yq[2] : yq[3]));
            post(yp, binp, vp, lgp, row - 1, t > 0);
            yp = y; binp = pv.bin; vp = pv.v; lgp = pv.lg;
        }
        pv = pn; raw1 = raw2;
    }
    if constexpr (MODE == 1) post(yp, binp, vp, lgp, row0 + nsteps - 1, true);
#undef LDV
#undef XSUM
    if constexpr (MODE == 1) {
        if (S_final) {
#pragma unroll
            for (int q = 0; q < 4; ++q)
#pragma unroll
                for (int m = 0; m < 4; ++m) *(f32x4*)(S_final + (il + 16 * q) * 64 + 16 * ib + 4 * m) = (f32x4){S[q][2 * m].x, S[q][2 * m].y, S[q][2 * m + 1].x, S[q][2 * m + 1].y};
        }
    } else {
        float* dst = MODE == 0 ? Uout : Pout;
#pragma unroll
        for (int q = 0; q < 4; ++q)
#pragma unroll
            for (int m = 0; m < 4; ++m) *(f32x4*)(dst + (il + 16 * q) * 64 + 16 * ib + 4 * m) = (f32x4){S[q][2 * m].x, S[q][2 * m].y, S[q][2 * m + 1].x, S[q][2 * m + 1].y};
    }
}
__device__ __forceinline__ void phase_scan_a(const DArgs& a, LAS unsigned char* lds) {
    const int wave = threadIdx.x >> 6, lane = threadIdx.x & 63, gw = blockIdx.x * NWAVE + wave, ngw = gridDim.x * NWAVE;
    LAS float* W = (LAS float*)(lds + 8192 + wave * 2048);
    for (int it = gw; it < NCHK * 16; it += ngw) { const int ch = it >> 4, h = it & 15;
        scan_item<0>(a, W, ch * CHK, CHK, h, lane, ch == 0, nullptr, nullptr, nullptr, (float*)(a.wsp() + W_UC) + (size_t)it * 4096, nullptr);
        scan_item<2>(a, W, ch * CHK, CHK, h, lane, ch == 0, nullptr, nullptr, nullptr, nullptr, (float*)(a.wsp() + W_PC) + (size_t)it * 4096); }
}
__device__ __forceinline__ void phase_scan_c(const DArgs& a, LAS unsigned char* lds) {
    const int wave = threadIdx.x >> 6, lane = threadIdx.x & 63, gw = blockIdx.x * NWAVE + wave, ngw = gridDim.x * NWAVE;
    for (int it = gw; it < NCHK * 16; it += ngw) { const int ch = it >> 4, h = it & 15;
        scan_item<1>(a, (LAS float*)(lds + 8192 + wave * 2048), ch * CHK, CHK, h, lane, ch == 0, nullptr, (const float*)(a.wsp() + W_SST) + (size_t)it * 4096, nullptr, nullptr, nullptr); }
}
__device__ __forceinline__ void phase_scan_b(const DArgs& a, LAS unsigned char* lds) {
    const int wave = threadIdx.x >> 6, lane = threadIdx.x & 63;
    if (blockIdx.x < 64) {
        const int h = blockIdx.x >> 2, rg = blockIdx.x & 3, fr = lane & 15, g = lane >> 4;
        LAS float* Sb = (LAS float*)lds;
        const float* Pc = (const float*)(a.wsp() + W_PC); const float* Uc = (const float*)(a.wsp() + W_UC); float* Sst = (float*)(a.wsp() + W_SST);
        for (int i = threadIdx.x; i < 16 * 68; i += NTHR) Sb[i] = 0.f;
        if (wave < 4) {
#pragma unroll
            for (int r = 0; r < 4; ++r) Sst[(size_t)h * 4096 + (rg * 16 + 4 * g + r) * 64 + 16 * wave + fr] = 0.f;
        }
        float bq[16], uq[4];
        if (wave < 4) { const float* pc = Pc + (size_t)h * 4096; const float* uc = Uc + (size_t)h * 4096;
#pragma unroll
            for (int ks = 0; ks < 16; ++ks) bq[ks] = pc[(16 * g + ks) * 64 + 16 * wave + fr];
#pragma unroll
            for (int r = 0; r < 4; ++r) uq[r] = uc[(rg * 16 + 4 * g + r) * 64 + 16 * wave + fr]; }
        __syncthreads();
        for (int ch = 0; ch < NCHK; ++ch) {
            f32x4 acc0, acc1 = (f32x4){0.f, 0.f, 0.f, 0.f};
            if (wave < 4) {
                float bn[16], un[4];
                const int chn = ch + 1 < NCHK ? ch + 1 : ch;
                const float* pc = Pc + ((size_t)chn * 16 + h) * 4096; const float* uc = Uc + ((size_t)chn * 16 + h) * 4096;
#pragma unroll
                for (int ks = 0; ks < 16; ++ks) bn[ks] = pc[(16 * g + ks) * 64 + 16 * wave + fr];
#pragma unroll
                for (int r = 0; r < 4; ++r) un[r] = uc[(rg * 16 + 4 * g + r) * 64 + 16 * wave + fr];
                float aq[16];
#pragma unroll
                for (int q = 0; q < 4; ++q) { const f32x4 v = *(const LAS f32x4*)(Sb + fr * 68 + 16 * g + 4 * q); aq[4 * q] = v.x; aq[4 * q + 1] = v.y; aq[4 * q + 2] = v.z; aq[4 * q + 3] = v.w; }
                acc0 = (f32x4){uq[0], uq[1], uq[2], uq[3]};
#pragma unroll
                for (int ks = 0; ks < 16; ks += 2) { acc0 = __builtin_amdgcn_mfma_f32_16x16x4f32(aq[ks], bq[ks], acc0, 0, 0, 0); acc1 = __builtin_amdgcn_mfma_f32_16x16x4f32(aq[ks + 1], bq[ks + 1], acc1, 0, 0, 0); }
                acc0 += acc1;
#pragma unroll
                for (int ks = 0; ks < 16; ++ks) bq[ks] = bn[ks];
#pragma unroll
                for (int r = 0; r < 4; ++r) uq[r] = un[r];
            }
            __syncthreads();
            if (wave < 4) {
                float* dst = ch + 1 < NCHK ? Sst + ((size_t)(ch + 1) * 16 + h) * 4096 : a.outp() + O_WKVP + (size_t)h * 4096;
#pragma unroll
                for (int r = 0; r < 4; ++r) { Sb[(4 * g + r) * 68 + 16 * wave + fr] = acc0[r]; dst[(rg * 16 + 4 * g + r) * 64 + 16 * wave + fr] = acc0[r]; }
            }
            __syncthreads();
        }
    } else {
        const int it = (blockIdx.x - 64) * NWAVE + wave;
        if (it < 128) { const int b = it >> 4, h = it & 15;
            scan_item<1>(a, (LAS float*)(lds + 8192 + wave * 2048), TP + b * 32, 32, h, lane, true, a.in(I_SSHIFT) + (size_t)b * DSHIFT, a.in(I_SWKV) + ((size_t)b * 16 + h) * 4096,
                         a.outp() + O_WKVS + ((size_t)b * 16 + h) * 4096, nullptr, nullptr); }
    }
}

__device__ __forceinline__ void phase_attn_prep(const DArgs& a, LAS unsigned char* lds) {
    const int wave = threadIdx.x >> 6, lane = threadIdx.x & 63, gw = blockIdx.x * NWAVE + wave, ngw = gridDim.x * NWAVE;
    const int gt = blockIdx.x * NTHR + threadIdx.x, ngt = gridDim.x * NTHR;
    const bf16_t* qk = (const bf16_t*)(a.wsp() + W_QK); const bf16_t* vT = (const bf16_t*)(a.wsp() + W_VT);
    bf16_t* Ks = (bf16_t*)(a.wsp() + W_KS); bf16_t* VsT = (bf16_t*)(a.wsp() + W_VST);
    for (int i = gt; i < 8 * 576 * 256; i += ngt) {
        const int c8 = i & 255, kk = (i >> 8) % 576, b = i / (576 * 256);
        u32x4 w = (u32x4){0u, 0u, 0u, 0u};
        if (kk < 512) { float v[8]; ld8f(a.in(I_CK) + ((size_t)b * 512 + kk) * D + c8 * 8, v); w.x = pk2(v[0], v[1]); w.y = pk2(v[2], v[3]); w.z = pk2(v[4], v[5]); w.w = pk2(v[6], v[7]); }
        else if (kk < 544) w = *(const u32x4*)(qk + (size_t)(TP + b * 32 + kk - 512) * 4096 + 2048 + c8 * 8);
        *(u32x4*)(Ks + ((size_t)b * 576 + kk) * D + c8 * 8) = w;
    }
    LAS float* scr = (LAS float*)(lds + wave * 8448);
    for (int it = gw; it < 8 * 512; it += ngw) { const int b = it >> 9, r = it & 511, kb = r >> 6, nb = r & 63;
        transpose_item(a.in(I_CV) + (size_t)b * 512 * D, D, VsT + (size_t)b * D * 576, 576, scr, kb * 64, nb * 32, lane); }
    for (int i = gt; i < 8 * D * 8; i += ngt) {
        const int g8 = i & 7, c = (i >> 3) & (D - 1), b = i >> 14;
        u32x4 w = (u32x4){0u, 0u, 0u, 0u};
        if (g8 < 4) w = *(const u32x4*)(vT + (size_t)c * TA + TP + b * 32 + g8 * 8);
        *(u32x4*)(VsT + ((size_t)b * D + c) * 576 + 512 + g8 * 8) = w;
    }
    for (int i = gt; i < 512 * D; i += ngt) { const int r = i >> 11, c = i & (D - 1);
        a.outp()[O_KP + i] = bf2f(qk[(size_t)(TP - 512 + r) * 4096 + 2048 + c]); a.outp()[O_VP + i] = bf2f(vT[(size_t)c * TA + TP - 512 + r]); }
    for (int i = gt; i < TS * D; i += ngt) { const int r = i >> 11, c = i & (D - 1);
        a.outp()[O_KS + i] = bf2f(qk[(size_t)(TP + r) * 4096 + 2048 + c]); a.outp()[O_VS + i] = bf2f(vT[(size_t)c * TA + TP + r]); }
}
constexpr int KT_LD = 272, VT_LD = 144;
constexpr int A_K = 0, A_V = 64 * KT_LD, A_B = A_V + 128 * VT_LD;
__device__ __forceinline__ void phase_attn(const DArgs& a, LAS unsigned char* lds) {
    const int tid = threadIdx.x, wave = tid >> 6, lane = tid & 63, fr = lane & 15, g = lane >> 4;
    const bf16_t* qk = (const bf16_t*)(a.wsp() + W_QK); const bf16_t* vT = (const bf16_t*)(a.wsp() + W_VT);
    const bf16_t* Ks = (const bf16_t*)(a.wsp() + W_KS); const bf16_t* VsT = (const bf16_t*)(a.wsp() + W_VST);
    const float* relb = a.in(I_RELB);
    bf16_t* oatt = (bf16_t*)(a.wsp() + W_MIX);
    LAS float* biasT = (LAS float*)(lds + A_B);
    const float scale = 0.08838834764831845f;
    constexpr int NITEMS = 2048 + 128;
    struct Item { int h, qrow, qpos, tile_lo, tile_hi, qc, nkeys, ldk, ldv, kpos_base; const bf16_t* Kb; const bf16_t* Vb; bool wact, prompt; };
    auto setup = [&](int it) -> Item { Item I; I.prompt = it < 2048; I.qc = 0;
        if (I.prompt) { const int pi = it >> 4; I.h = it & 15; I.qc = 2 * pi + (wave >> 2); I.qrow = I.qc * 64 + (wave & 3) * 16 + fr; I.qpos = I.qrow;
            I.tile_lo = 2 * pi - 8 < 0 ? 0 : 2 * pi - 8; I.tile_hi = 2 * pi + 1; I.nkeys = 1 << 30; I.ldk = 4096; I.ldv = TA; I.kpos_base = 0;
            I.Kb = qk + 2048 + I.h * 128; I.Vb = vT + (size_t)(I.h * 128) * TA; I.wact = true; }
        else { const int s_ = it - 2048, b = s_ >> 4; I.h = s_ & 15; const int w2 = wave & 1; I.qrow = TP + b * 32 + w2 * 16 + fr; I.qpos = 2048 + w2 * 16 + fr;
            I.tile_lo = 0; I.tile_hi = 8; I.nkeys = 544; I.ldk = D; I.ldv = 576; I.kpos_base = 1536;
            I.Kb = Ks + (size_t)b * 576 * D + I.h * 128; I.Vb = VsT + ((size_t)b * D + I.h * 128) * 576; I.wact = wave < 2; }
        return I; };
    u32x4 kreg[2], vreg[2];
    const int kr = tid >> 4, kc = tid & 15, vr = tid >> 3, vc = tid & 7;
#define ATT_LOAD(I_, tile) do { _Pragma("unroll") for (int p_ = 0; p_ < 2; ++p_) { \
        kreg[p_] = *(const u32x4*)((I_).Kb + (size_t)((tile) * 64 + kr + 32 * p_) * (I_).ldk + kc * 8); \
        vreg[p_] = *(const u32x4*)((I_).Vb + (size_t)(vr + 64 * p_) * (I_).ldv + (tile) * 64 + vc * 8); } } while (0)
#define ATT_STORE() do { _Pragma("unroll") for (int p_ = 0; p_ < 2; ++p_) { \
        *(LAS u32x4*)(lds + A_K + (kr + 32 * p_) * KT_LD + kc * 16) = kreg[p_]; \
        *(LAS u32x4*)(lds + A_V + (vr + 64 * p_) * VT_LD + vc * 16) = vreg[p_]; } } while (0)
#define ATT_LOADQ(dst_, I_) do { _Pragma("unroll") for (int ks = 0; ks < 4; ++ks) dst_[ks] = *(const bf16x8*)(qk + (size_t)(I_).qrow * 4096 + (I_).h * 128 + 32 * ks + 8 * g); } while (0)
    if ((int)blockIdx.x >= NITEMS) return;
    Item cur = setup(blockIdx.x);
    bf16x8 qf[4], qfn[4];
    float biasn = tid < 257 ? relb[cur.h * 257 + tid] : 0.f;
    ATT_LOADQ(qf, cur);
    ATT_LOAD(cur, cur.tile_lo);
    for (int it = blockIdx.x; it < NITEMS; it += gridDim.x) {
        const bool has_next = it + (int)gridDim.x < NITEMS;
        const Item nxt = setup(has_next ? it + (int)gridDim.x : it);
        f32x4 oacc[8];
#pragma unroll
        for (int n = 0; n < 8; ++n) oacc[n] = (f32x4){0.f, 0.f, 0.f, 0.f};
        float mrun = -1e30f, lrun = 0.f;
        __syncthreads();
        ATT_STORE();
        if (tid < 257) biasT[tid] = biasn;
        __syncthreads();
        for (int tile = cur.tile_lo; tile <= cur.tile_hi; ++tile) {
            if (tile < cur.tile_hi) ATT_LOAD(cur, tile + 1);
            else if (has_next) { ATT_LOAD(nxt, nxt.tile_lo); ATT_LOADQ(qfn, nxt); biasn = tid < 257 ? relb[nxt.h * 257 + tid] : 0.f; }
            const bool act = cur.wact && (!cur.prompt || (tile >= cur.qc - 8 && tile <= cur.qc));
            if (act) {
                f32x4 sacc[4];
#pragma unroll
                for (int kt = 0; kt < 4; ++kt) { sacc[kt] = (f32x4){0.f, 0.f, 0.f, 0.f};
#pragma unroll
                    for (int ks = 0; ks < 4; ++ks) { const bf16x8 kf = *(const LAS bf16x8*)(lds + A_K + (16 * kt + fr) * KT_LD + (32 * ks + 8 * g) * 2);
                        sacc[kt] = __builtin_amdgcn_mfma_f32_16x16x32_bf16(kf, qf[ks], sacc[kt], 0, 0, 0); } }
                const int kpos0 = cur.kpos_base + tile * 64, kidx0 = tile * 64;
                float tmax = -1e30f;
#pragma unroll
                for (int kt = 0; kt < 4; ++kt)
#pragma unroll
                    for (int r = 0; r < 4; ++r) { const int key = 16 * kt + 4 * g + r; float bias;
                        { int rel = cur.qpos - (kpos0 + key); rel = rel < -128 ? -128 : (rel > 128 ? 128 : rel); bias = biasT[rel + 128]; }
                        float s_ = sacc[kt][r] * scale + bias; if (kidx0 + key >= cur.nkeys) s_ = -1e30f; sacc[kt][r] = s_; tmax = fmaxf(tmax, s_); }
                tmax = fmaxf(tmax, __shfl_xor(tmax, 16)); tmax = fmaxf(tmax, __shfl_xor(tmax, 32));
                const float mnew = fmaxf(mrun, tmax), alpha = __expf(mrun - mnew); mrun = mnew;
                float psum = 0.f;
#pragma unroll
                for (int kt = 0; kt < 4; ++kt)
#pragma unroll
                    for (int r = 0; r < 4; ++r) { const float p_ = __expf(sacc[kt][r] - mnew); sacc[kt][r] = p_; psum += p_; }
                lrun = lrun * alpha + psum;
#pragma unroll
                for (int n = 0; n < 8; ++n) oacc[n] = oacc[n] * alpha;
#pragma unroll
                for (int j = 0; j < 2; ++j) {
                    u32x4 pw; pw.x = pk2(sacc[2 * j][0], sacc[2 * j][1]); pw.y = pk2(sacc[2 * j][2], sacc[2 * j][3]); pw.z = pk2(sacc[2 * j + 1][0], sacc[2 * j + 1][1]); pw.w = pk2(sacc[2 * j + 1][2], sacc[2 * j + 1][3]);
                    const bf16x8 pf = __builtin_bit_cast(bf16x8, pw);
#pragma unroll
                    for (int n = 0; n < 8; ++n) {
                        const u32x2 v0 = *(const LAS u32x2*)(lds + A_V + (16 * n + fr) * VT_LD + (32 * j + 4 * g) * 2);
                        const u32x2 v1 = *(const LAS u32x2*)(lds + A_V + (16 * n + fr) * VT_LD + (32 * j + 16 + 4 * g) * 2);
                        const bf16x8 vf = __builtin_bit_cast(bf16x8, (u32x4){v0.x, v0.y, v1.x, v1.y});
                        oacc[n] = __builtin_amdgcn_mfma_f32_16x16x32_bf16(vf, pf, oacc[n], 0, 0, 0);
                    }
                }
            }
            if (tile < cur.tile_hi) { __syncthreads(); ATT_STORE(); __syncthreads(); }
        }
        if (cur.wact) {
            float l = lrun; l += __shfl_xor(l, 16); l += __shfl_xor(l, 32);
            const float inv = 1.f / l;
#pragma unroll
            for (int n = 0; n < 8; ++n) { u32x2 w; w.x = pk2(oacc[n][0] * inv, oacc[n][1] * inv); w.y = pk2(oacc[n][2] * inv, oacc[n][3] * inv);
                *(u32x2*)(oatt + (size_t)cur.qrow * D + cur.h * 128 + 16 * n + 4 * g) = w; }
        }
        cur = nxt;
#pragma unroll
        for (int ks = 0; ks < 4; ++ks) qf[ks] = qfn[ks];
    }
    __syncthreads();
#undef ATT_LOAD
#undef ATT_STORE
#undef ATT_LOADQ
}


#define XB_TMO      128
#define XB_XCNT(j)  (256  + 64 * (j))
#define XB_XSUB(j)  (1280 + 64 * (j))
#define XB_XGEN(j)  (2304 + 64 * (j))
#define XB_TOP      3328
#define XB_TOPGEN   3392
#define XCD_BAR_WORDS 3456
#define XB_SPIN_CAP (1u << 18)
__device__ __forceinline__ unsigned xb_ld(unsigned* p)              { return __hip_atomic_load(p, __ATOMIC_RELAXED, __HIP_MEMORY_SCOPE_AGENT); }
__device__ __forceinline__ unsigned xb_add(unsigned* p, unsigned v) { return __hip_atomic_fetch_add(p, v, __ATOMIC_RELAXED, __HIP_MEMORY_SCOPE_AGENT); }
__device__ __forceinline__ unsigned xb_xcc_id() { return (unsigned)__builtin_amdgcn_s_getreg((3 << 11) | 20) & 0xFu; }
#define XB_SPIN(cond, bar) do { unsigned _sp = 0; while (cond) { __builtin_amdgcn_s_sleep(1); \
    if ((++_sp & 255u) == 0u) { if (xb_ld(&(bar)[XB_TMO])) break; if (_sp > XB_SPIN_CAP) { atomicAdd(&(bar)[XB_TMO], 1u); break; } } } } while (0)
struct XcdBarrier { unsigned* bar; unsigned x; volatile LAS unsigned* st; };
__device__ __forceinline__ XcdBarrier xcd_barrier_post(unsigned* bar, volatile LAS unsigned* st) {
    XcdBarrier b; b.bar = bar; b.x = xb_xcc_id(); b.st = st;
    if (threadIdx.x == 0) (void)xb_add(&bar[XB_XCNT(b.x)], 1u);
    return b;
}
__device__ __forceinline__ void xcd_barrier_complete(unsigned* bar, unsigned x, unsigned& nloc, unsigned& nx) {
    const unsigned G = gridDim.x * gridDim.y * gridDim.z;
    unsigned sum, cnt, mine, sp = 0u;
    for (;;) {
        sum = 0u; cnt = 0u; mine = 0u;
#pragma unroll
        for (unsigned j = 0; j < 16; ++j) { const unsigned c = xb_ld(&bar[XB_XCNT(j)]); sum += c; cnt += (c > 0u) ? 1u : 0u; mine = (j == x) ? c : mine; }
        if (sum == G) break;
        __builtin_amdgcn_s_sleep(1);
        if ((++sp & 255u) == 0u) { if (xb_ld(&bar[XB_TMO])) break; if (sp > XB_SPIN_CAP) { atomicAdd(&bar[XB_TMO], 1u); break; } }
    }
    nloc = mine > 0u ? mine : 1u; nx = cnt > 0u ? cnt : 1u;
}
__device__ __forceinline__ void xcd_barrier(const XcdBarrier& b) {
    asm volatile("s_waitcnt vmcnt(0)" ::: "memory");
    __syncthreads();
    if (threadIdx.x == 0) {
        unsigned* bar = b.bar;
        __builtin_amdgcn_s_waitcnt(0);
        unsigned nloc = b.st[0], nx = b.st[1];
        if (nloc == 0u) { xcd_barrier_complete(bar, b.x, nloc, nx); b.st[0] = nloc; b.st[1] = nx; }
        const unsigned old = xb_add(&bar[XB_XSUB(b.x)], 1u);
        const unsigned gen = old / nloc;
        if (old + 1u == (gen + 1u) * nloc) {
            __builtin_amdgcn_fence(__ATOMIC_RELEASE, "agent");
            asm volatile("s_waitcnt vmcnt(0)" ::: "memory");
            const unsigned og = xb_add(&bar[XB_TOP], 1u);
            const unsigned tg = og / nx;
            if (og + 1u == (tg + 1u) * nx) xb_add(&bar[XB_TOPGEN], 1u);
            else XB_SPIN(xb_ld(&bar[XB_TOPGEN]) == tg, bar);
            __builtin_amdgcn_fence(__ATOMIC_ACQUIRE, "agent");
            xb_add(&bar[XB_XGEN(b.x)], 1u);
            asm volatile("s_waitcnt vmcnt(0)" ::: "memory");
        } else {
            XB_SPIN(xb_ld(&bar[XB_XGEN(b.x)]) == gen, bar);
            __builtin_amdgcn_fence(__ATOMIC_ACQUIRE, "agent");
            asm volatile("s_waitcnt vmcnt(0)" ::: "memory");
        }
    }
    __syncthreads();
}

__global__ __launch_bounds__(512, 2) void mega(Args aa) {
    extern __shared__ __attribute__((aligned(16))) unsigned char shm[];
    LAS unsigned char* lds = (LAS unsigned char*)shm;
    cg::grid_group grid = cg::this_grid();
    {
        LAS unsigned long long* tabw = (LAS unsigned long long*)(lds + 131072);
        if (threadIdx.x == 0) {
#pragma unroll
            for (int i = 0; i < 32; ++i) tabw[i] = (unsigned long long)aa.in[i];
            tabw[32] = (unsigned long long)aa.out; tabw[33] = (unsigned long long)aa.ws;
        }
        __syncthreads();
    }
    DArgs a; a.tab = (LAS const unsigned long long*)(lds + 131072); a.ph_lo = aa.ph_lo; a.ph_hi = aa.ph_hi;
    volatile LAS unsigned* xb_st = (volatile LAS unsigned*)(lds + 131072 + 448);
    if (threadIdx.x == 0) { xb_st[0] = 0u; xb_st[1] = 0u; }
    __syncthreads();
    const XcdBarrier xb = xcd_barrier_post((unsigned*)(__attribute__((address_space(1))) unsigned*)(a.wsp() + W_BAR), xb_st);
#define gn a.in(I_GNORM)
#define ws a.wsp()
    const int nM = TA / 256;
#ifndef PHMASK
#define PHMASK 0x3fffff
#endif
#ifndef DUPMASK
#define DUPMASK 0
#endif
#define PH(p) if (((PHMASK >> (p)) & 1) && a.ph_lo <= (p) && (p) < a.ph_hi) for (int rep_ = 0; rep_ < (((DUPMASK >> (p)) & 1) ? 2 : 1); ++rep_, (((DUPMASK >> (p)) & 1) && rep_ < 2 ? grid.sync() : (void)0))
#define SYNC(p) if (a.ph_lo <= (p) && (p) + 1 < a.ph_hi) xcd_barrier(xb);
    if (a.ph_lo < 0) grid.sync();
    PH(0) { phase_mod_partial(a, lds); phase_convert(a, lds); }
    SYNC(0)
    PH(1) { phase_mod_final(a); }
    SYNC(1)
    PH(2) { phase_rowwise<true, false, true>(a, nullptr, 0, 0, gn + 0 * D, 0, 1, 0); }
    SYNC(2)
    PH(3) { pg8::EpiBf16<0> E{(bf16_t*)(ws + W_P), DIN0, nullptr};
        run_gemm(lds, D, D, D, ws + W_HA, ws + W_IN0T, nM, DIN0 / 256, 0, nullptr, nullptr, 0, 0, E);
        const int c0 = (nM * (DIN0 / 256)) % (int)gridDim.x; convert_sub(a, lds, CV_OUT0, c0); convert_sub(a, lds, CV_FF1_0, c0); }
    SYNC(3)
    PH(4) { phase_prep(a); }
    SYNC(4)
    PH(5) { { pg8::EpiBf16<0> E{(bf16_t*)(ws + W_MIX), D, nullptr};
          run_gemm(lds, 256, 1280, 256, ws + W_AL, ws + W_POOLT, nM, 4, 512, nullptr, nullptr, 0, 0, E); }
        { pg8::EpiF32 E{(float*)(ws + W_L), 3072};
          run_gemm(lds, 256, 1280, 256, ws + W_AL + 2048, ws + W_LORAT, nM, 12, 0, nullptr, nullptr, 0, 0, E); } }
    SYNC(5)
    PH(6) { phase_scan_a(a, lds); }
    SYNC(6)
    PH(7) { phase_scan_b(a, lds); }
    SYNC(7)
    PH(8) { phase_scan_c(a, lds); }
    SYNC(8)
    PH(9) { pg8::Epi2<pg8::EpiBf16<0>, pg8::EpiPartF32> E{{(bf16_t*)(ws + W_O), D, nullptr}, {(float*)(ws + W_OACC), D}};
        run_gemm(lds, D, D, D, ws + W_MIX, ws + W_OUT0T, 64, 8, 0, ws + W_MIX, ws + W_OUT0T, 0, 8, E, 8, 64); }
    SYNC(9)
    PH(10) { phase_rowwise<true, true, true>(a, gn + 1 * D, 0, 2, gn + 2 * D, 0, 4, 3, 8); }
    SYNC(10)
    PH(11) { pg8::EpiBf16<1> E{(bf16_t*)(ws + W_F1), DFF, nullptr};
        run_gemm(lds, D, D, D, ws + W_HA, ws + W_FF1T, nM, DFF / 256, 0, nullptr, nullptr, 0, 0, E);
        const int c0 = (nM * (DFF / 256)) % (int)gridDim.x; convert_sub(a, lds, CV_FF2_0, c0); convert_sub(a, lds, CV_QKV, c0); }
    SYNC(11)
    PH(12) { pg8::Epi2<pg8::EpiBf16<0>, pg8::EpiPartF32> E{{(bf16_t*)(ws + W_O), D, nullptr}, {(float*)(ws + W_OACC), D}};
        run_gemm(lds, DFF, DFF, DFF, ws + W_F1, ws + W_FF2T, 64, 8, 0, ws + W_F1, ws + W_FF2T, 0, 8, E, 32, 64); }
    SYNC(12)
    PH(13) { phase_rowwise<false, true, true>(a, gn + 3 * D, 0, 5, gn + 4 * D, 1, 1, 0, 32); }
    SYNC(13)
    PH(14) { pg8::Epi2<pg8::EpiBf16<0>, pg8::EpiBf16<0>> E{{(bf16_t*)(ws + W_QK), 4096, nullptr}, {(bf16_t*)(ws + W_VT), TA, nullptr}};
        run_gemm(lds, D, D, D, ws + W_HA, ws + W_QKVT, nM, 16, 0, ws + W_QKVT + (size_t)4096 * D * 2, ws + W_HA, 8, nM, E);
        const int c0 = (nM * 24) % (int)gridDim.x; convert_sub(a, lds, CV_OUT1, c0); convert_sub(a, lds, CV_FF1_1, c0); }
    SYNC(14)
    PH(15) { phase_attn_prep(a, lds); }
    SYNC(15)
    PH(16) { phase_attn(a, lds); }
    SYNC(16)
    PH(17) { pg8::Epi2<pg8::EpiBf16<0>, pg8::EpiPartF32> E{{(bf16_t*)(ws + W_O), D, nullptr}, {(float*)(ws + W_OACC), D}};
        run_gemm(lds, D, D, D, ws + W_MIX, ws + W_OUT1T, 64, 8, 0, ws + W_MIX, ws + W_OUT1T, 0, 8, E, 8, 64); }
    SYNC(17)
    PH(18) { phase_rowwise<false, true, true>(a, gn + 5 * D, 1, 2, gn + 6 * D, 1, 4, 3, 8); }
    SYNC(18)
    PH(19) { pg8::EpiBf16<1> E{(bf16_t*)(ws + W_F1), DFF, nullptr};
        run_gemm(lds, D, D, D, ws + W_HA, ws + W_FF1T, nM, DFF / 256, 0, nullptr, nullptr, 0, 0, E);
        const int c0 = (nM * (DFF / 256)) % (int)gridDim.x; convert_sub(a, lds, CV_FF2_1, c0); }
    SYNC(19)
    PH(20) { pg8::Epi2<pg8::EpiBf16<0>, pg8::EpiPartF32> E{{(bf16_t*)(ws + W_O), D, nullptr}, {(float*)(ws + W_OACC), D}};
        run_gemm(lds, DFF, DFF, DFF, ws + W_F1, ws + W_FF2T, 64, 8, 0, ws + W_F1, ws + W_FF2T, 0, 8, E, 32, 64); }
    SYNC(20)
    PH(21) { phase_rowwise<false, true, false>(a, gn + 7 * D, 1, 5, nullptr, 0, 0, 0, 32); }
#undef PH
#undef SYNC
#undef gn
#undef ws
}

constexpr int NPHASE = 22;
#ifndef MK_MULTI
#define MK_MULTI 0
#endif
extern "C" void kernel_launch(void* const* d_in, const int* in_sizes, int n_in, void* d_out, int out_size, void* d_ws, size_t ws_size, hipStream_t stream) {
    static int grid = 0;
    constexpr int LDS_BYTES = 131072 + 512;
    if (grid == 0) {
        if (n_in != 32 || ws_size < WS_TOTAL) { fprintf(stderr, "kernel_launch: unexpected n_in %d / ws %zu (need %zu)\n", n_in, ws_size, (size_t)WS_TOTAL); grid = -1; return; }
        int dev = 0, cus = 0, per_cu = 0;
        hipGetDevice(&dev); hipDeviceGetAttribute(&cus, hipDeviceAttributeMultiprocessorCount, dev);
        if (hipFuncSetAttribute((const void*)mega, hipFuncAttributeMaxDynamicSharedMemorySize, LDS_BYTES) != hipSuccess) { fprintf(stderr, "kernel_launch: hipFuncSetAttribute failed\n"); grid = -1; return; }
        hipOccupancyMaxActiveBlocksPerMultiprocessor(&per_cu, (const void*)mega, NTHR, LDS_BYTES);
        if (per_cu < 1) { fprintf(stderr, "kernel_launch: occupancy query says %d blocks per CU\n", per_cu); per_cu = 1; }
        (void)hipGetLastError();
        grid = cus;
    }
    if (grid < 0) return;
    Args a{};
    for (int i = 0; i < 32; ++i) a.in[i] = (const float*)d_in[i];
    a.out = (float*)d_out; a.ws = (unsigned char*)d_ws;
#if MK_MULTI
    for (int p = 0; p < NPHASE; ++p) { a.ph_lo = p; a.ph_hi = p + 1; hipLaunchKernelGGL(mega, dim3(grid), dim3(NTHR), LDS_BYTES, stream, a); }
#else
    a.ph_lo = 0; a.ph_hi = NPHASE;
    if (hipMemsetAsync((char*)d_ws + W_BAR, 0, XCD_BAR_WORDS * 4, stream) != hipSuccess) { fprintf(stderr, "kernel_launch: memset of barrier words failed\n"); return; }
    void* args[] = {&a};
    hipError_t e = hipLaunchCooperativeKernel((const void*)mega, dim3(grid), dim3(NTHR), args, LDS_BYTES, stream);
    if (e != hipSuccess) fprintf(stderr, "kernel_launch: cooperative launch failed: %s (grid %d)\n", hipGetErrorString(e), grid);
#endif
}
```

```cpp
#include <hip/hip_runtime.h>
#include <hip/hip_cooperative_groups.h>
#include <cstdio>
#include <cstdint>
namespace cg = cooperative_groups;

#define LAS __attribute__((address_space(3)))
typedef unsigned short bf16_t;
typedef short bf16x8 __attribute__((ext_vector_type(8)));
typedef short bf16x4 __attribute__((ext_vector_type(4)));
typedef float f32x4 __attribute__((ext_vector_type(4)));
typedef float f32x2 __attribute__((ext_vector_type(2)));
typedef unsigned u32x4 __attribute__((ext_vector_type(4)));
typedef unsigned u32x2 __attribute__((ext_vector_type(2)));

constexpr int TP = 16384, TS = 256, TA = TP + TS;
constexpr int D = 2048, DFF = 8192, DIN0 = 4352, DPOOL = 1024, DSHIFT = 3328;
constexpr int NWAVE = 8, NTHR = 512;
constexpr int CHK = 128, NCHK = TP / CHK;
constexpr size_t O_Y = 0, O_POOLP = 34078720, O_POOLS = 34094080, O_SHIFTP = 34216960, O_SHIFTS = 34220288,
                 O_WKVP = 34246912, O_WKVS = 34312448, O_KP = 34836736, O_VP = 35885312, O_KS = 36933888, O_VS = 37458176;
constexpr size_t W_IN0T = 0, W_OUT0T = 17825792, W_QKVT = 26214400, W_OUT1T = 51380224, W_FF1T = 59768832, W_FF2T = 93323264,
                 W_POOLT = 126877696, W_LORAT = 127401984, W_MOD = 128974848, W_MODPART = 129859584,
                 W_HA = 144015360, W_MIX = 212172800, W_O = 280330240, W_R = 348487680, WS_END = 697794560;
constexpr size_t W_AL = W_HA;
constexpr size_t W_SST = W_HA;
constexpr size_t W_PC = W_O, W_UC = W_O + 33554432;
constexpr size_t W_P = W_R, W_L = W_R + 144834560;
constexpr size_t W_F1 = W_R;
constexpr size_t W_QK = W_R, W_VT = W_R + 136314880, W_KS = W_R + 204472320, W_VST = W_R + 223346688;
constexpr int KSPLIT = 16;
constexpr size_t W_BAR = WS_END, WS_TOTAL = WS_END + 16384;
constexpr size_t W_OACC = W_R + 272629760, WS_END2 = WS_END;

struct Args {
    const float* in[32];
    float* out;
    unsigned char* ws;
    int ph_lo, ph_hi;
};
struct DArgs {
    LAS const unsigned long long* tab; int ph_lo, ph_hi;
    __device__ __forceinline__ unsigned long long ld(int i) const { const unsigned long long v = tab[i];
        const unsigned lo = __builtin_amdgcn_readfirstlane((unsigned)v), hi = __builtin_amdgcn_readfirstlane((unsigned)(v >> 32)); return ((unsigned long long)hi << 32) | lo; }
    __device__ __forceinline__ const float* in(int i) const { return (const float*)(const __attribute__((address_space(1))) float*)ld(i); }
    __device__ __forceinline__ float* outp() const { return (float*)(__attribute__((address_space(1))) float*)ld(32); }
    __device__ __forceinline__ unsigned char* wsp() const { return (unsigned char*)(__attribute__((address_space(1))) unsigned char*)ld(33); }
};
enum { I_XP = 0, I_XS, I_CP, I_CS, I_SPOOL, I_SSHIFT, I_SWKV, I_CK, I_CV, I_WADA, I_BADA, I_GNORM, I_WIN0, I_WPOOL, I_PSCALE, I_MU,
       I_W0, I_W2, I_A0, I_A2, I_G2, I_KK, I_KA, I_RK, I_LNW, I_LNB, I_WOUT0, I_WQKV, I_RELB, I_WOUT1, I_WFF1, I_WFF2 };

__device__ __forceinline__ float bf2f(bf16_t b) { return __uint_as_float(((unsigned)b) << 16); }
__device__ __forceinline__ float bflo(unsigned w) { return __uint_as_float(w << 16); }
__device__ __forceinline__ float bfhi(unsigned w) { return __uint_as_float(w & 0xffff0000u); }
__device__ __forceinline__ unsigned pk2(float lo, float hi) { unsigned r; asm("v_cvt_pk_bf16_f32 %0, %1, %2" : "=v"(r) : "v"(lo), "v"(hi)); return r; }
__device__ __forceinline__ bf16_t f2bf(float f) { return (bf16_t)(pk2(f, 0.f) & 0xffffu); }
__device__ __forceinline__ float rl(float v, int l) { return __int_as_float(__builtin_amdgcn_readlane(__float_as_int(v), l)); }
template <int CTRL> __device__ __forceinline__ float dppf(float v) { return __int_as_float(__builtin_amdgcn_update_dpp(0, __float_as_int(v), CTRL, 0xf, 0xf, false)); }
__device__ __forceinline__ float wave_sum(float v) {
    v += dppf<0xB1>(v); v += dppf<0x4E>(v); v += dppf<0x141>(v); v += dppf<0x140>(v);
    return (rl(v, 0) + rl(v, 16)) + (rl(v, 32) + rl(v, 48));
}
__device__ __forceinline__ float sigmoidf_(float x) { return __builtin_amdgcn_rcpf(1.f + __expf(-x)); }
__device__ __forceinline__ int entry_of(int row) { return row < TP ? 0 : 1 + ((row - TP) >> 5); }

namespace pg8 {
constexpr int BM = 256, BK = 64, HALF = 128, HTB = HALF * BK * 2, STAGE_BYTES = 8 * HTB, NXCD = 8, WGM = 8;
__device__ __forceinline__ int lds_byte(int r, int c) { const int st = (r >> 4) * 2 + (c >> 5), rr = r & 15, cc = c & 31, ob = rr * 64 + cc * 2; return st * 1024 + (ob ^ (((ob >> 9) & 1) << 5)); }
__device__ __forceinline__ void stage_rc(int b, int& R, int& C) { const int st = b / 1024, sb = b % 1024, swz = sb ^ (((sb >> 9) & 1) << 5); R = (st >> 1) * 16 + swz / 64; C = (st & 1) * 32 + (swz % 64) / 2; }
__device__ __forceinline__ int perm32(int rho) { const int n = rho >> 4, i = rho & 15; return 8 * (i >> 2) + 4 * n + (i & 3); }

struct Unit { const char* a; const char* b; int pm, pn, g, nt, sl; };
struct GDesc { const char* A; const char* B; int nM, nN; long a_pn_off; };
struct Sched {
    GDesc g0, g1; int n0, n1, G, c; long tstepA, tstepB; int nt0, S1, nt1, pm1; long ksb;
    __device__ __forceinline__ void decode(const GDesc& g, int L, Unit& u, int gi) const {
        const int nwg = g.nM * g.nN; int wgid = L;
        { const int q = nwg / NXCD, r = nwg % NXCD, xcd = wgid % NXCD, off = wgid / NXCD; wgid = (xcd < r ? xcd * (q + 1) : r * (q + 1) + (xcd - r) * q) + off; }
        const int nig = WGM * g.nN, gid = wgid / nig, fm = gid * WGM, gsz = (g.nM - fm) < WGM ? (g.nM - fm) : WGM;
        u.pm = fm + ((wgid % nig) % gsz); u.pn = (wgid % nig) / gsz; u.g = gi;
        u.a = g.A + (long)u.pm * tstepA + (long)u.pn * g.a_pn_off; u.b = g.B + (long)u.pn * tstepB;
    }
    __device__ __forceinline__ bool next(int i, Unit& u) const {
        const long L = (long)i * G + c;
        if (L < n0) { decode(g0, (int)L, u, 0); u.nt = nt0; return true; }
        if (L < n0 + n1) {
            if (S1 == 0) { decode(g1, (int)(L - n0), u, 1); u.nt = nt0; }
            else { const int q = (int)(L - n0), sl = q / g1.nN, pn = q % g1.nN; u.pm = pm1; u.pn = pn; u.g = 1; u.nt = nt1; u.sl = sl;
                u.a = g1.A + (long)pm1 * tstepA + (long)sl * ksb; u.b = g1.B + (long)pn * tstepB + (long)sl * ksb; }
            return true; }
        return false;
    }
};

template <int ACT> struct EpiBf16 {
    bf16_t* O; int ldc; const float* cs;
    __device__ __forceinline__ void operator()(const f32x4 (&acc)[2][2][4][2], const Unit& u, int wr, int wc, int fr, int fq) const {
        const int row0 = u.pm * BM + wr * 64 + fr, col0 = u.pn * BM + wc * 32 + 8 * fq;
        f32x4 sv[2][2];
        if (ACT == 2) {
#pragma unroll
            for (int bj = 0; bj < 2; ++bj)
#pragma unroll
                for (int n = 0; n < 2; ++n) sv[bj][n] = *(const f32x4*)(cs + col0 + bj * HALF + 4 * n);
        }
#pragma unroll
        for (int ai = 0; ai < 2; ++ai)
#pragma unroll
            for (int m = 0; m < 4; ++m) { bf16_t* rowp = O + (size_t)(row0 + ai * HALF + m * 16) * ldc + col0;
#pragma unroll
                for (int bj = 0; bj < 2; ++bj) { f32x4 v0 = acc[ai][bj][m][0], v1 = acc[ai][bj][m][1];
                    if (ACT == 1) {
#pragma unroll
                        for (int j = 0; j < 4; ++j) { const float a0 = fmaxf(v0[j], 0.f), a1 = fmaxf(v1[j], 0.f); v0[j] = a0 * a0; v1[j] = a1 * a1; } }
                    if (ACT == 2) { v0 = v0 * sv[bj][0]; v1 = v1 * sv[bj][1]; }
                    u32x4 w; w.x = pk2(v0[0], v0[1]); w.y = pk2(v0[2], v0[3]); w.z = pk2(v1[0], v1[1]); w.w = pk2(v1[2], v1[3]);
                    *(u32x4*)(rowp + bj * HALF) = w; } }
    }
};
struct EpiF32 {
    float* C; int ldc;
    __device__ __forceinline__ void operator()(const f32x4 (&acc)[2][2][4][2], const Unit& u, int wr, int wc, int fr, int fq) const {
        const int row0 = u.pm * BM + wr * 64 + fr, col0 = u.pn * BM + wc * 32 + 8 * fq;
#pragma unroll
        for (int ai = 0; ai < 2; ++ai)
#pragma unroll
            for (int m = 0; m < 4; ++m) { float* rowp = C + (size_t)(row0 + ai * HALF + m * 16) * ldc + col0;
#pragma unroll
                for (int bj = 0; bj < 2; ++bj)
#pragma unroll
                    for (int n = 0; n < 2; ++n) *(f32x4*)(rowp + bj * HALF + 4 * n) = acc[ai][bj][m][n]; }
    }
};
struct EpiPartF32 {
    float* C; int ldc;
    __device__ __forceinline__ void operator()(const f32x4 (&acc)[2][2][4][2], const Unit& u, int wr, int wc, int fr, int fq) const {
        const int row0 = wr * 64 + fr, col0 = u.pn * BM + wc * 32 + 8 * fq;
        float* base = C + (size_t)u.sl * 256 * ldc;
#pragma unroll
        for (int ai = 0; ai < 2; ++ai)
#pragma unroll
            for (int m = 0; m < 4; ++m) { float* rowp = base + (size_t)(row0 + ai * HALF + m * 16) * ldc + col0;
#pragma unroll
                for (int bj = 0; bj < 2; ++bj)
#pragma unroll
                    for (int n = 0; n < 2; ++n) *(f32x4*)(rowp + bj * HALF + 4 * n) = acc[ai][bj][m][n]; }
    }
};
template <class E0, class E1> struct Epi2 {
    E0 e0; E1 e1;
    __device__ __forceinline__ void operator()(const f32x4 (&acc)[2][2][4][2], const Unit& u, int wr, int wc, int fr, int fq) const {
        if (u.g == 0) e0(acc, u, wr, wc, fr, fq); else e1(acc, u, wr, wc, fr, fq);
    }
};

template <class Epi>
__device__ __forceinline__ void gemm_phase(LAS unsigned char* lds, const int K, const int lda, const int ldb, const Sched& S, const Epi& E) {
    const int tid = threadIdx.x, wid = __builtin_amdgcn_readfirstlane(tid >> 6), lane = tid & 63, wr = wid >> 2, wc = wid & 3, fr = lane & 15, fq = lane >> 4;
    unsigned voffA[2], voffB[2];
#pragma unroll
    for (int i = 0; i < 2; ++i) { int R, C; stage_rc(tid * 16 + i * 8192, R, C); const int Rb = (R & ~31) + perm32(R & 31);
        voffA[i] = (unsigned)(R * lda + C) * 2u; voffB[i] = (unsigned)(Rb * ldb + C) * 2u; }
    const size_t kstep = (size_t)(BK * 2);
    const size_t hstepA = (size_t)HALF * lda * 2, hstepB = (size_t)HALF * ldb * 2;
    const unsigned ldsw = (unsigned)wid * 1024u;
    const int aoff = lds_byte(wr * 64 + fr, fq * 8), boff = lds_byte(wc * 32 + fr, fq * 8);
#define PG8_SA(b, h) (((b) * 2 + (h)) * HTB)
#define PG8_SB(b, h) ((4 + (b) * 2 + (h)) * HTB)
#define PG8_STAGE(bufoff, gbase, voff) do { _Pragma("unroll") for (int _i = 0; _i < 2; ++_i) \
        __builtin_amdgcn_global_load_lds((const unsigned*)((const char*)(gbase) + (voff)[_i]), (LAS unsigned*)(lds + (bufoff) + ldsw + _i * 8192), 16, 0, 0); } while (0)
#define PG8_LDA(dst, b, h) do { _Pragma("unroll") for (int m = 0; m < 4; ++m) _Pragma("unroll") for (int k = 0; k < 2; ++k) dst[m][k] = *(const LAS bf16x8*)(lds + PG8_SA(b, h) + aoff + m * 2048 + k * 1024); } while (0)
#define PG8_LDB(dst, b, h) do { _Pragma("unroll") for (int n = 0; n < 2; ++n) _Pragma("unroll") for (int k = 0; k < 2; ++k) dst[n][k] = *(const LAS bf16x8*)(lds + PG8_SB(b, h) + boff + n * 2048 + k * 1024); } while (0)
#define PG8_MMA(ai, bj, At, Bt) do { __builtin_amdgcn_s_setprio(1); _Pragma("unroll") for (int m = 0; m < 4; ++m) _Pragma("unroll") for (int n = 0; n < 2; ++n) _Pragma("unroll") for (int k = 0; k < 2; ++k) \
        acc[ai][bj][m][n] = __builtin_amdgcn_mfma_f32_16x16x32_bf16(Bt[n][k], At[m][k], acc[ai][bj][m][n], 0, 0, 0); __builtin_amdgcn_s_setprio(0); } while (0)
#define PG8_WAIT_V(n) asm volatile("s_waitcnt vmcnt(" #n ")" ::: "memory")
#define PG8_WAIT_L(n) asm volatile("s_waitcnt lgkmcnt(" #n ")" ::: "memory")
#define PG8_BAR __builtin_amdgcn_s_barrier()
#define PG8_SCHED __builtin_amdgcn_sched_barrier(0)
    Unit cur, nxt; int ui = 0;
    if (!S.next(0, cur)) return;
    f32x4 acc[2][2][4][2];
#pragma unroll
    for (int a = 0; a < 2; ++a)
#pragma unroll
        for (int b = 0; b < 2; ++b)
#pragma unroll
            for (int m = 0; m < 4; ++m)
#pragma unroll
                for (int n = 0; n < 2; ++n) acc[a][b][m][n] = (f32x4){0.f, 0.f, 0.f, 0.f};
    bf16x8 At[4][2], B0[2][2], B1[2][2];
    const char* cA = cur.a; const char* cB = cur.b;
    PG8_STAGE(PG8_SB(0, 0), cB, voffB); PG8_STAGE(PG8_SB(0, 1), cB + hstepB, voffB); PG8_STAGE(PG8_SA(0, 0), cA, voffA); PG8_STAGE(PG8_SA(0, 1), cA + hstepA, voffA);
    if (wr == 1) PG8_BAR;
    PG8_WAIT_V(2); PG8_BAR;
    PG8_STAGE(PG8_SB(1, 0), cB + kstep, voffB); PG8_STAGE(PG8_SA(1, 0), cA + kstep, voffA); PG8_STAGE(PG8_SB(1, 1), cB + hstepB + kstep, voffB);
    PG8_WAIT_V(6); PG8_BAR;
    for (;;) {
        const bool has_next = S.next(ui + 1, nxt);
        const char* nA = has_next ? nxt.a : cA; const char* nB = has_next ? nxt.b : cB;
        const int nt = cur.nt;
#pragma unroll 1
        for (int t = 0; t < nt; t += 2) {
            const bool last = (t == nt - 2);
            const char* a1 = cA + (size_t)(t + 1) * kstep;
            const char* a2 = last ? nA : cA + (size_t)(t + 2) * kstep; const char* b2 = last ? nB : cB + (size_t)(t + 2) * kstep;
            const char* a3 = a2 + kstep; const char* b3 = b2 + kstep;
            PG8_LDB(B0, 0, 0); PG8_LDB(B1, 0, 1); PG8_SCHED; PG8_LDA(At, 0, 0); PG8_STAGE(PG8_SA(1, 1), a1 + hstepA, voffA);
            PG8_WAIT_V(8); PG8_WAIT_L(0); PG8_BAR; PG8_MMA(0, 0, At, B0); PG8_MMA(0, 1, At, B1); PG8_BAR; PG8_SCHED;
            PG8_LDA(At, 0, 1); PG8_STAGE(PG8_SB(0, 0), b2, voffB); PG8_STAGE(PG8_SB(0, 1), b2 + hstepB, voffB); PG8_STAGE(PG8_SA(0, 0), a2, voffA);
            PG8_WAIT_V(8); PG8_WAIT_L(0); PG8_BAR; PG8_MMA(1, 0, At, B0); PG8_MMA(1, 1, At, B1); PG8_BAR; PG8_SCHED;
            PG8_LDB(B0, 1, 0); PG8_LDB(B1, 1, 1); PG8_SCHED; PG8_LDA(At, 1, 0); PG8_STAGE(PG8_SA(0, 1), a2 + hstepA, voffA);
            PG8_WAIT_V(8); PG8_WAIT_L(0); PG8_BAR; PG8_MMA(0, 0, At, B0); PG8_MMA(0, 1, At, B1); PG8_BAR; PG8_SCHED;
            PG8_LDA(At, 1, 1); PG8_STAGE(PG8_SB(1, 0), b3, voffB); PG8_STAGE(PG8_SB(1, 1), b3 + hstepB, voffB); PG8_STAGE(PG8_SA(1, 0), a3, voffA);
            PG8_WAIT_V(8); PG8_WAIT_L(0); PG8_BAR; PG8_MMA(1, 0, At, B0); PG8_MMA(1, 1, At, B1); PG8_BAR; PG8_SCHED;
        }
        if (wr == 0) PG8_BAR;
        E(acc, cur, wr, wc, fr, fq);
        if (!has_next) break;
#pragma unroll
        for (int a = 0; a < 2; ++a)
#pragma unroll
            for (int b = 0; b < 2; ++b)
#pragma unroll
                for (int m = 0; m < 4; ++m)
#pragma unroll
                    for (int n = 0; n < 2; ++n) acc[a][b][m][n] = (f32x4){0.f, 0.f, 0.f, 0.f};
        cur = nxt; cA = nA; cB = nB; ++ui;
        if (wr == 1) PG8_BAR;
    }
    PG8_WAIT_V(0);
    PG8_BAR;
#undef PG8_SA
#undef PG8_SB
#undef PG8_STAGE
#undef PG8_LDA
#undef PG8_LDB
#undef PG8_MMA
#undef PG8_WAIT_V
#undef PG8_WAIT_L
#undef PG8_BAR
#undef PG8_SCHED
}
}

template <class Epi>
__device__ __forceinline__ void run_gemm(LAS unsigned char* lds, int K, int lda, int ldb, const void* A0, const void* B0, int nM0, int nN0, long apn0,
                                         const void* A1, const void* B1, int nM1, int nN1, const Epi& E, int S1 = 0, int pm1 = 0) {
    pg8::Sched S;
    S.nt0 = K / 64; S.S1 = S1; S.pm1 = pm1; S.nt1 = S1 ? K / 64 / S1 : 0; S.ksb = S1 ? (long)(K / S1) * 2 : 0;
    S.g0.A = (const char*)A0; S.g0.B = (const char*)B0; S.g0.nM = nM0; S.g0.nN = nN0; S.g0.a_pn_off = apn0;
    S.g1.A = (const char*)A1; S.g1.B = (const char*)B1; S.g1.nM = nM1; S.g1.nN = nN1; S.g1.a_pn_off = 0;
    S.n0 = nM0 * nN0; S.n1 = S1 ? S1 * nN1 : nM1 * nN1; S.G = gridDim.x; S.c = blockIdx.x;
    S.tstepA = (long)256 * lda * 2; S.tstepB = (long)256 * ldb * 2;
    pg8::gemm_phase<Epi>(lds, K, lda, ldb, S, E);
    __syncthreads();
}

__device__ __forceinline__ void transpose_item(const float* W, int ldw, bf16_t* WT, int ldo, LAS float* scr, int k0, int n0, int lane, const float* rs = nullptr) {
#pragma unroll 8
    for (int i = 0; i < 32; ++i) { const int kk = 2 * i + (lane >> 5); scr[kk * 33 + (lane & 31)] = W[(size_t)(k0 + kk) * ldw + n0 + (lane & 31)]; }
    asm volatile("s_waitcnt lgkmcnt(0)" ::: "memory");
    const int c = lane & 7;
#pragma unroll
    for (int j = 0; j < 4; ++j) { const int n = (lane >> 3) + 8 * j; const LAS float* s = scr + (8 * c) * 33 + n; const float m = rs ? rs[n0 + n] : 1.f;
        u32x4 o; o.x = pk2(s[0 * 33] * m, s[1 * 33] * m); o.y = pk2(s[2 * 33] * m, s[3 * 33] * m); o.z = pk2(s[4 * 33] * m, s[5 * 33] * m); o.w = pk2(s[6 * 33] * m, s[7 * 33] * m);
        *(u32x4*)(WT + (size_t)(n0 + n) * ldo + k0 + 8 * c) = o; }
    asm volatile("s_waitcnt lgkmcnt(0)" ::: "memory");
}
__device__ __forceinline__ void transpose_matrix(const float* W, int K, int N, bf16_t* WT, int ldo, LAS float* scr, int gw, int ngw, int lane, const float* rs = nullptr) {
    const int nblk = N / 32, nitems = (K / 64) * nblk;
    for (int it = gw; it < nitems; it += ngw) { const int kb = it / nblk, nb = it % nblk; transpose_item(W, N, WT, ldo, scr, kb * 64, nb * 32, lane, rs); }
}

__device__ __forceinline__ void phase_mod_partial(const DArgs& a, LAS unsigned char* lds) {
    LAS float* sil = (LAS float*)lds;
    for (int i = threadIdx.x; i < 9 * D; i += NTHR) { const int e = i / D, d = i % D; const float c = e == 0 ? a.in(I_CP)[d] : a.in(I_CS)[(e - 1) * D + d]; sil[i] = c / (1.f + __expf(-c)); }
    __syncthreads();
    const int wave = threadIdx.x >> 6, lane = threadIdx.x & 63, gw = blockIdx.x * NWAVE + wave, ngw = gridDim.x * NWAVE;
    float* part = (float*)(a.wsp() + W_MODPART);
    constexpr int NT = 6 * D / 256;
    constexpr int KR = D / KSPLIT;
    for (int it = gw; it < 2 * NT * KSPLIT; it += ngw) {
        const int ks = it % KSPLIT, nt = (it / KSPLIT) % NT, l = it / (KSPLIT * NT);
        const float* w = a.in(I_WADA) + (size_t)l * D * 6 * D + (size_t)(ks * KR) * 6 * D + nt * 256 + lane * 4;
        f32x4 acc[9];
#pragma unroll
        for (int e = 0; e < 9; ++e) acc[e] = (f32x4){0.f, 0.f, 0.f, 0.f};
#pragma unroll 4
        for (int d = 0; d < KR; ++d) {
            const f32x4 wv = *(const f32x4*)(w + (size_t)d * 6 * D);
#pragma unroll
            for (int e = 0; e < 9; ++e) { const float s = sil[e * D + ks * KR + d]; acc[e] += wv * s; }
        }
#pragma unroll
        for (int e = 0; e < 9; ++e) *(f32x4*)(part + ((size_t)(ks * 9 + e) * 2 + l) * 6 * D + nt * 256 + lane * 4) = acc[e];
    }
    __syncthreads();
}
enum { CV_OUT0 = 0, CV_QKV, CV_OUT1, CV_FF1_0, CV_FF2_0, CV_FF1_1, CV_FF2_1 };
__device__ __forceinline__ void convert_sub(const DArgs& a, LAS unsigned char* lds, int which, int c0) {
    if ((int)blockIdx.x < c0) return;
    const int wave = threadIdx.x >> 6, lane = threadIdx.x & 63, gw = ((int)blockIdx.x - c0) * NWAVE + wave, ngw = ((int)gridDim.x - c0) * NWAVE;
    LAS float* scr = (LAS float*)(lds + wave * 8448);
    unsigned char* w = a.wsp();
    switch (which) {
    case CV_OUT0: transpose_matrix(a.in(I_WOUT0), D, D, (bf16_t*)(w + W_OUT0T), D, scr, gw, ngw, lane); break;
    case CV_QKV: transpose_matrix(a.in(I_WQKV), D, 3 * D, (bf16_t*)(w + W_QKVT), D, scr, gw, ngw, lane); break;
    case CV_OUT1: transpose_matrix(a.in(I_WOUT1), D, D, (bf16_t*)(w + W_OUT1T), D, scr, gw, ngw, lane); break;
    case CV_FF1_0: transpose_matrix(a.in(I_WFF1), D, DFF, (bf16_t*)(w + W_FF1T), D, scr, gw, ngw, lane); break;
    case CV_FF2_0: transpose_matrix(a.in(I_WFF2), DFF, D, (bf16_t*)(w + W_FF2T), DFF, scr, gw, ngw, lane); break;
    case CV_FF1_1: transpose_matrix(a.in(I_WFF1) + (size_t)D * DFF, D, DFF, (bf16_t*)(w + W_FF1T), D, scr, gw, ngw, lane); break;
    default: transpose_matrix(a.in(I_WFF2) + (size_t)DFF * D, DFF, D, (bf16_t*)(w + W_FF2T), DFF, scr, gw, ngw, lane); break;
    }
}
__device__ __forceinline__ void phase_convert(const DArgs& a, LAS unsigned char* lds) {
    const int wave = threadIdx.x >> 6, lane = threadIdx.x & 63, gw = blockIdx.x * NWAVE + wave, ngw = gridDim.x * NWAVE;
    LAS float* scr = (LAS float*)(lds + wave * 8448);
    transpose_matrix(a.in(I_WIN0), D, DIN0, (bf16_t*)(a.wsp() + W_IN0T), D, scr, gw, ngw, lane);
    for (int g = 0; g < 4; ++g) transpose_matrix(a.in(I_WPOOL) + (size_t)g * 65536, 256, 256, (bf16_t*)(a.wsp() + W_POOLT) + (size_t)g * 65536, 256, scr, gw, ngw, lane, a.in(I_PSCALE) + g * 256);
    bf16_t* lt = (bf16_t*)(a.wsp() + W_LORAT);
    for (int i = blockIdx.x * NTHR + threadIdx.x; i < 3072 * 256; i += gridDim.x * NTHR) {
        const int row = i >> 8, k = i & 255, part = row >> 10, n = row & 1023; float v = 0.f;
        if (part == 0) { if (k < 64) v = a.in(I_W2)[k * 1024 + n]; }
        else if (part == 1) { if (k >= 64 && k < 128) v = a.in(I_A2)[(k - 64) * 1024 + n]; }
        else { if (k >= 128) v = a.in(I_G2)[(k - 128) * 1024 + n]; }
        lt[i] = f2bf(v);
    }
}
__device__ __forceinline__ void phase_mod_final(const DArgs& a) {
    const float* part = (const float*)(a.wsp() + W_MODPART); float* mod = (float*)(a.wsp() + W_MOD);
    for (int i = blockIdx.x * NTHR + threadIdx.x; i < 9 * 2 * 6 * D; i += gridDim.x * NTHR) {
        const int n = i % (6 * D), l = (i / (6 * D)) & 1;
        float s = a.in(I_BADA)[l * 6 * D + n];
#pragma unroll
        for (int ks = 0; ks < KSPLIT; ++ks) s += part[(size_t)ks * 9 * 2 * 6 * D + i];
        mod[i] = s;
    }
}
__device__ __forceinline__ void zero_oacc(const DArgs& a) {
    f32x4* p = (f32x4*)(a.wsp() + W_OACC);
    for (int i = blockIdx.x * NTHR + threadIdx.x; i < TS * D / 4; i += gridDim.x * NTHR) p[i] = (f32x4){0.f, 0.f, 0.f, 0.f};
}
template <bool XIN_INPUT, bool HAS_O, bool HAS_H>
__device__ __forceinline__ void phase_rowwise(const DArgs& a, const float* g_o, int l_gt, int gt_which, const float* g_h, int l_h, int sc_which, int sh_which, int nsl = 0) {
    const int wave = threadIdx.x >> 6, lane = threadIdx.x & 63, gw = blockIdx.x * NWAVE + wave, ngw = gridDim.x * NWAVE;
    const float* mod = (const float*)(a.wsp() + W_MOD);
    float* X = a.outp() + O_Y; const bf16_t* o = (const bf16_t*)(a.wsp() + W_O); bf16_t* hA = (bf16_t*)(a.wsp() + W_HA); const float* oacc = (const float*)(a.wsp() + W_OACC);
    for (int row = gw; row < TA; row += ngw) {
        const int e = entry_of(row);
        const float* xin = XIN_INPUT ? (row < TP ? a.in(I_XP) + (size_t)row * D : a.in(I_XS) + (size_t)(row - TP) * D) : X + (size_t)row * D;
        f32x4 x[8];
#pragma unroll
        for (int j = 0; j < 8; ++j) x[j] = *(const f32x4*)(xin + 4 * (lane + 64 * j));
        if (HAS_O) {
            f32x4 ov[8]; float ss = 0.f;
            if (row < TP) {
#pragma unroll
                for (int j = 0; j < 8; ++j) { const u32x2 w = *(const u32x2*)(o + (size_t)row * D + 4 * (lane + 64 * j)); ov[j] = (f32x4){bflo(w.x), bfhi(w.x), bflo(w.y), bfhi(w.y)}; }
            } else {
#pragma unroll
                for (int j = 0; j < 8; ++j) ov[j] = (f32x4){0.f, 0.f, 0.f, 0.f};
#pragma unroll 2
                for (int sl = 0; sl < nsl; ++sl) {
#pragma unroll
                    for (int j = 0; j < 8; ++j) ov[j] += *(const f32x4*)(oacc + ((size_t)sl * TS + (row - TP)) * D + 4 * (lane + 64 * j));
                }
            }
#pragma unroll
            for (int j = 0; j < 8; ++j) ss += (ov[j].x * ov[j].x + ov[j].y * ov[j].y) + (ov[j].z * ov[j].z + ov[j].w * ov[j].w);
            const float rstd = rsqrtf(wave_sum(ss) * (1.f / D) + 1e-6f);
            const float* gt = mod + (size_t)(e * 2 + l_gt) * 6 * D + gt_which * D;
#pragma unroll
            for (int j = 0; j < 8; ++j) { const int c = 4 * (lane + 64 * j); const f32x4 g = *(const f32x4*)(gt + c), go = *(const f32x4*)(g_o + c);
                x[j] += g * (ov[j] * rstd * go); *(f32x4*)(X + (size_t)row * D + c) = x[j]; }
        }
        if (HAS_H) {
            float ss = 0.f;
#pragma unroll
            for (int j = 0; j < 8; ++j) ss += (x[j].x * x[j].x + x[j].y * x[j].y) + (x[j].z * x[j].z + x[j].w * x[j].w);
            const float rstd = rsqrtf(wave_sum(ss) * (1.f / D) + 1e-6f);
            const float* sc = mod + (size_t)(e * 2 + l_h) * 6 * D + sc_which * D; const float* sh = mod + (size_t)(e * 2 + l_h) * 6 * D + sh_which * D;
#pragma unroll
            for (int j = 0; j < 8; ++j) { const int c = 4 * (lane + 64 * j); const f32x4 g = *(const f32x4*)(g_h + c), s1 = *(const f32x4*)(sc + c), s0 = *(const f32x4*)(sh + c);
                const f32x4 h = x[j] * rstd * g * (s1 + 1.f) + s0; u32x2 w; w.x = pk2(h.x, h.y); w.y = pk2(h.z, h.w);
                *(u32x2*)(hA + (size_t)row * D + c) = w; }
        }
    }
}
__device__ __forceinline__ void ld8bf(const bf16_t* p, float (&v)[8]) { const u32x4 w = *(const u32x4*)p; v[0] = bflo(w.x); v[1] = bfhi(w.x); v[2] = bflo(w.y); v[3] = bfhi(w.y); v[4] = bflo(w.z); v[5] = bfhi(w.z); v[6] = bflo(w.w); v[7] = bfhi(w.w); }
__device__ __forceinline__ void ld8f(const float* p, float (&v)[8]) { const f32x4 a = *(const f32x4*)p, b = *(const f32x4*)(p + 4); v[0] = a.x; v[1] = a.y; v[2] = a.z; v[3] = a.w; v[4] = b.x; v[5] = b.y; v[6] = b.z; v[7] = b.w; }
__device__ __forceinline__ void st8bf(bf16_t* p, const float (&v)[8]) { u32x4 w; w.x = pk2(v[0], v[1]); w.y = pk2(v[2], v[3]); w.z = pk2(v[4], v[5]); w.w = pk2(v[6], v[7]); *(u32x4*)p = w; }
template <int WIN> __device__ __forceinline__ void pool_sum(const bf16_t* p, float (&s)[8], float (&u)[8]) {
    u32x4 w[WIN];
#pragma unroll
    for (int sf = 0; sf < WIN; ++sf) w[sf] = *(const u32x4*)(p - (size_t)sf * DIN0);
    u[0] = bflo(w[0].x); u[1] = bfhi(w[0].x); u[2] = bflo(w[0].y); u[3] = bfhi(w[0].y); u[4] = bflo(w[0].z); u[5] = bfhi(w[0].z); u[6] = bflo(w[0].w); u[7] = bfhi(w[0].w);
#pragma unroll
    for (int i = 0; i < 8; ++i) s[i] = u[i];
#pragma unroll
    for (int sf = 1; sf < WIN; ++sf) { s[0] += bflo(w[sf].x); s[1] += bfhi(w[sf].x); s[2] += bflo(w[sf].y); s[3] += bfhi(w[sf].y); s[4] += bflo(w[sf].z); s[5] += bfhi(w[sf].z); s[6] += bflo(w[sf].w); s[7] += bfhi(w[sf].w); }
}
__device__ __forceinline__ void phase_prep(const DArgs& a) {
    const bf16_t* P = (const bf16_t*)(a.wsp() + W_P); bf16_t* AL = (bf16_t*)(a.wsp() + W_AL);
    const int gt = blockIdx.x * NTHR + threadIdx.x, ngt = gridDim.x * NTHR;
    for (int idx = gt; idx < TA * 160; idx += ngt) {
        const int row = idx / 160, it = idx % 160; const bool prompt = row < TP; const int t = prompt ? row : ((row - TP) & 31), b = prompt ? 0 : ((row - TP) >> 5);
        if (it < 128) {
            const int c0 = it * 8, gi = c0 >> 8, win = 2 << gi;
            float s[8], u[8], v[8];
            if (t >= win - 1) {
                const bf16_t* p = P + (size_t)row * DIN0 + c0;
                if (gi == 0) pool_sum<2>(p, s, u); else if (gi == 1) pool_sum<4>(p, s, u); else if (gi == 2) pool_sum<8>(p, s, u); else pool_sum<16>(p, s, u);
                const float inv = 1.f / (float)win;
#pragma unroll
                for (int i = 0; i < 8; ++i) s[i] = s[i] * inv - u[i];
            } else {
#pragma unroll
                for (int i = 0; i < 8; ++i) s[i] = 0.f;
                for (int sf = 0; sf < win; ++sf) { const int tt = t - sf;
                    if (tt >= 0) { ld8bf(P + (size_t)(row - sf) * DIN0 + c0, v);
#pragma unroll
                        for (int i = 0; i < 8; ++i) s[i] += v[i]; }
                    else if (!prompt) { ld8f(a.in(I_SPOOL) + ((size_t)b * 15 + (15 + tt)) * DPOOL + c0, v);
#pragma unroll
                        for (int i = 0; i < 8; ++i) s[i] += v[i]; } }
                const float cnt = prompt ? (float)min(win, t + 1) : (float)win, inv = 1.f / cnt;
                ld8bf(P + (size_t)row * DIN0 + c0, u);
#pragma unroll
                for (int i = 0; i < 8; ++i) s[i] = s[i] * inv - u[i];
            }
            st8bf(AL + (size_t)row * 1280 + c0, s);
        } else {
            const int q0 = (it - 128) * 8, e0 = 3072 + q0;
            float z[8], zp[8], mu[8];
            ld8bf(P + (size_t)row * DIN0 + DPOOL + e0, z);
            if (t > 0) ld8bf(P + (size_t)(row - 1) * DIN0 + DPOOL + e0, zp);
            else if (!prompt) ld8f(a.in(I_SSHIFT) + (size_t)b * DSHIFT + e0, zp);
            else {
#pragma unroll
                for (int i = 0; i < 8; ++i) zp[i] = 0.f; }
            ld8f(a.in(I_MU) + e0, mu);
#pragma unroll
            for (int i = 0; i < 8; ++i) { const float zs = z[i] + (zp[i] - z[i]) * mu[i];
                z[i] = q0 < 64 ? 1.f - 2.f / (1.f + __expf(2.f * zs)) : (q0 < 128 ? zs : sigmoidf_(zs)); }
            st8bf(AL + (size_t)row * 1280 + 1024 + q0, z);
        }
    }
    for (int i = gt; i < 15 * DPOOL; i += ngt) a.outp()[O_POOLP + i] = bf2f(P[(size_t)(TP - 15 + i / DPOOL) * DIN0 + (i % DPOOL)]);
    for (int i = gt; i < 8 * 15 * DPOOL; i += ngt) { const int b = i / (15 * DPOOL), r = (i / DPOOL) % 15, c = i % DPOOL; a.outp()[O_POOLS + i] = bf2f(P[(size_t)(TP + b * 32 + 17 + r) * DIN0 + c]); }
    for (int i = gt; i < DSHIFT; i += ngt) a.outp()[O_SHIFTP + i] = bf2f(P[(size_t)(TP - 1) * DIN0 + DPOOL + i]);
    for (int i = gt; i < 8 * DSHIFT; i += ngt) { const int b = i / DSHIFT, e = i % DSHIFT; a.outp()[O_SHIFTS + i] = bf2f(P[(size_t)(TP + b * 32 + 31) * DIN0 + DPOOL + e]); }
}

struct ScanConst { float mu_r, mu_k, mu_v, w0, a0, kkc, kac, rk, lnw, lnb; };
struct ScanRaw { bf16_t zr, zk, zv; float lw, la, lg; };
template <bool NEEDG> __device__ __forceinline__ ScanRaw scan_load(const bf16_t* P, const float* L, int row, int c) {
    ScanRaw r; const bf16_t* p = P + (size_t)row * DIN0 + DPOOL + c; r.zr = p[0]; r.zk = p[1024]; r.zv = p[2048];
    const float* l = L + (size_t)row * 3072 + c; r.lw = l[0]; r.la = l[1024]; r.lg = NEEDG ? l[2048] : 0.f; return r;
}
template <int MODE>
__device__ __forceinline__ void scan_item(const DArgs& a, LAS float* W  , int row0, int nsteps, int h, int lane, bool first_is_start, const float* shift_prev  ,
                                          const float* S_init  , float* S_final  , float* Uout, float* Pout) {
    const bf16_t* P = (const bf16_t*)(a.wsp() + W_P); const float* L = (const float*)(a.wsp() + W_L); bf16_t* mix = (bf16_t*)(a.wsp() + W_MIX);
    const int c = h * 64 + lane, ib = lane >> 4, il = lane & 15;
    ScanConst k; k.mu_r = a.in(I_MU)[c]; k.mu_k = a.in(I_MU)[1024 + c]; k.mu_v = a.in(I_MU)[2048 + c]; k.w0 = a.in(I_W0)[c]; k.a0 = a.in(I_A0)[c];
    k.kkc = a.in(I_KK)[c]; k.kac = a.in(I_KA)[c]; k.rk = a.in(I_RK)[c]; k.lnw = a.in(I_LNW)[c]; k.lnb = a.in(I_LNB)[c];
    float zr_p, zk_p, zv_p;
    if (!first_is_start) { const bf16_t* p = P + (size_t)(row0 - 1) * DIN0 + DPOOL + c; zr_p = bf2f(p[0]); zk_p = bf2f(p[1024]); zv_p = bf2f(p[2048]); }
    else if (shift_prev) { zr_p = shift_prev[c]; zk_p = shift_prev[1024 + c]; zv_p = shift_prev[2048 + c]; }
    else { zr_p = 0.f; zk_p = 0.f; zv_p = 0.f; }
    f32x2 S[4][8];
    if constexpr (MODE == 1) {
#pragma unroll
        for (int q = 0; q < 4; ++q)
#pragma unroll
            for (int m = 0; m < 4; ++m) { const f32x4 v = *(const f32x4*)(S_init + (il + 16 * q) * 64 + 16 * ib + 4 * m); S[q][2 * m] = (f32x2){v.x, v.y}; S[q][2 * m + 1] = (f32x2){v.z, v.w}; }
    } else {
#pragma unroll
        for (int q = 0; q < 4; ++q)
#pragma unroll
            for (int p = 0; p < 8; ++p) S[q][p] = MODE == 2 ? (f32x2){(q == ib && 2 * p == il) ? 1.f : 0.f, (q == ib && 2 * p + 1 == il) ? 1.f : 0.f} : (f32x2){0.f, 0.f};
    }
#define LDV(dst_, vec_) { _Pragma("unroll") for (int m = 0; m < 4; ++m) { const f32x4 t_ = *(const LAS f32x4*)(W + (vec_) * 64 + 16 * ib + 4 * m); dst_[2 * m] = (f32x2){t_.x, t_.y}; dst_[2 * m + 1] = (f32x2){t_.z, t_.w}; } }
#define XSUM(x_) { const u32x2 s16_ = __builtin_amdgcn_permlane16_swap(__float_as_uint(x_), __float_as_uint(x_), false, false); x_ = __uint_as_float(s16_.x) + __uint_as_float(s16_.y); \
                   const u32x2 s32_ = __builtin_amdgcn_permlane32_swap(__float_as_uint(x_), __float_as_uint(x_), false, false); x_ = __uint_as_float(s32_.x) + __uint_as_float(s32_.y); }
    struct Prep { float an, dec, bn, kmod, r, v, lg, bin; };
    auto prep = [&](const ScanRaw& rw) -> Prep {
        Prep o; const float zr = bf2f(rw.zr), zk = bf2f(rw.zk), zv = bf2f(rw.zv);
        const float r = zr + (zr_p - zr) * k.mu_r, kx = zk + (zk_p - zk) * k.mu_k; o.v = zv + (zv_p - zv) * k.mu_v;
        zr_p = zr; zk_p = zk; zv_p = zv;
        o.dec = __expf(-0.60653066f * sigmoidf_(k.w0 + rw.lw));
        const float ai = sigmoidf_(k.a0 + rw.la);
        const float kkr = kx * k.kkc, ssq = wave_sum(kkr * kkr), kk = kkr * rsqrtf(fmaxf(ssq, 1e-24f));
        o.kmod = kx * (1.f + (ai - 1.f) * k.kac); o.an = -kk; o.bn = kk * ai; o.r = r; o.lg = rw.lg; o.bin = r * o.kmod * k.rk; return o; };
    auto post = [&](float y, float bin, float v, float lg, int row, bool doit) {
        const float mean = wave_sum(y) * (1.f / 64.f), dy = y - mean, var = wave_sum(dy * dy) * (1.f / 64.f);
        const float yn = dy * rsqrtf(var + 64e-5f) * k.lnw + k.lnb;
        const float bonus = wave_sum(bin) * v;
        if (doit) mix[(size_t)row * D + 1024 + c] = f2bf((yn + bonus) * lg); };
    ScanRaw raw1 = scan_load<MODE == 1>(P, L, row0 + (nsteps > 1 ? 1 : 0), c);
    Prep pv = prep(scan_load<MODE == 1>(P, L, row0, c));
    float yp = 0.f, binp = 0.f, vp = 0.f, lgp = 0.f;
    for (int t = 0; t < nsteps; ++t) {
        const int row = row0 + t;
        const ScanRaw raw2 = scan_load<MODE == 1>(P, L, row0 + (t + 2 < nsteps ? t + 2 : nsteps - 1), c);
        W[lane] = pv.an; W[64 + lane] = pv.dec; W[128 + lane] = pv.bn; if constexpr (MODE != 2) { W[192 + lane] = pv.kmod; W[320 + lane] = pv.v; } if constexpr (MODE == 1) W[256 + lane] = pv.r;
        const Prep pn = prep(raw1);
        constexpr int NS = 2, PW = 8 / NS;
        float sa[4];
#pragma unroll
        for (int q = 0; q < 4; ++q) sa[q] = 0.f;
#pragma unroll
        for (int hf = 0; hf < NS; ++hf) {
            f32x2 av[PW];
#pragma unroll
            for (int m = 0; m < PW / 2; ++m) { const f32x4 t0 = *(const LAS f32x4*)(W + 16 * ib + 2 * PW * hf + 4 * m); av[2 * m] = (f32x2){t0.x, t0.y}; av[2 * m + 1] = (f32x2){t0.z, t0.w}; }
#pragma unroll
            for (int q = 0; q < 4; ++q) {
                f32x2 d = S[q][PW * hf] * av[0];
#pragma unroll
                for (int p = 1; p < PW; ++p) d += S[q][PW * hf + p] * av[p];
                sa[q] += d.x + d.y;
            }
        }
#pragma unroll
        for (int q = 0; q < 4; ++q) { XSUM(sa[q]) }
        float vq[4];
#pragma unroll
        for (int q = 0; q < 4; ++q) vq[q] = MODE == 2 ? 0.f : W[320 + il + 16 * q];
#pragma unroll
        for (int hf = 0; hf < NS; ++hf) {
            f32x2 wv[PW], bv[PW], kv[PW];
#pragma unroll
            for (int m = 0; m < PW / 2; ++m) { const int o_ = 16 * ib + 2 * PW * hf + 4 * m; const f32x4 t0 = *(const LAS f32x4*)(W + 64 + o_), t1 = *(const LAS f32x4*)(W + 128 + o_), t2 = MODE == 2 ? t1 : *(const LAS f32x4*)(W + 192 + o_);
                wv[2 * m] = (f32x2){t0.x, t0.y}; wv[2 * m + 1] = (f32x2){t0.z, t0.w}; bv[2 * m] = (f32x2){t1.x, t1.y}; bv[2 * m + 1] = (f32x2){t1.z, t1.w}; kv[2 * m] = (f32x2){t2.x, t2.y}; kv[2 * m + 1] = (f32x2){t2.z, t2.w}; }
#pragma unroll
            for (int q = 0; q < 4; ++q) {
                const f32x2 sa2 = (f32x2){sa[q], sa[q]}, v2 = (f32x2){vq[q], vq[q]};
#pragma unroll
                for (int p = 0; p < PW; ++p) { if constexpr (MODE == 2) S[q][PW * hf + p] = S[q][PW * hf + p] * wv[p] + sa2 * bv[p]; else S[q][PW * hf + p] = S[q][PW * hf + p] * wv[p] + (sa2 * bv[p] + v2 * kv[p]); }
            }
        }
        if constexpr (MODE == 1) {
            f32x2 rv[8];
            LDV(rv, 4)
            float yq[4];
#pragma unroll
            for (int q = 0; q < 4; ++q) { f32x2 d = S[q][0] * rv[0];
#pragma unroll
                for (int p = 1; p < 8; ++p) d += S[q][p] * rv[p];
                yq[q] = d.x + d.y; }
            const u32x2 s02 = __builtin_amdgcn_permlane32_swap(__float_as_uint(yq[0]), __float_as_uint(yq[2]), false, false);
            const u32x2 s13 = __builtin_amdgcn_permlane32_swap(__float_as_uint(yq[1]), __float_as_uint(yq[3]), false, false);
            const float r02 = __uint_as_float(s02.x) + __uint_as_float(s02.y), r13 = __uint_as_float(s13.x) + __uint_as_float(s13.y);
            const u32x2 sy = __builtin_amdgcn_permlane16_swap(__float_as_uint(r02), __float_as_uint(r13), false, false);
            const float y = __uint_as_float(sy.x) + __uint_as_float(sy.y);
            post(yp, binp, vp, lgp, row - 1, t > 0);
            yp = y; binp = pv.bin; vp = pv.v; lgp = pv.lg;
        }
        pv = pn; raw1 = raw2;
    }
    if constexpr (MODE == 1) post(yp, binp, vp, lgp, row0 + nsteps - 1, true);
#undef LDV
#undef XSUM
    if constexpr (MODE == 1) {
        if (S_final) {
#pragma unroll
            for (int q = 0; q < 4; ++q)
#pragma unroll
                for (int m = 0; m < 4; ++m) *(f32x4*)(S_final + (il + 16 * q) * 64 + 16 * ib + 4 * m) = (f32x4){S[q][2 * m].x, S[q][2 * m].y, S[q][2 * m + 1].x, S[q][2 * m + 1].y};
        }
    } else {
        float* dst = MODE == 0 ? Uout : Pout;
#pragma unroll
        for (int q = 0; q < 4; ++q)
#pragma unroll
            for (int m = 0; m < 4; ++m) *(f32x4*)(dst + (il + 16 * q) * 64 + 16 * ib + 4 * m) = (f32x4){S[q][2 * m].x, S[q][2 * m].y, S[q][2 * m + 1].x, S[q][2 * m + 1].y};
    }
}
__device__ __forceinline__ void phase_scan_a(const DArgs& a, LAS unsigned char* lds) {
    const int wave = threadIdx.x >> 6, lane = threadIdx.x & 63, gw = blockIdx.x * NWAVE + wave, ngw = gridDim.x * NWAVE;
    LAS float* W = (LAS float*)(lds + 8192 + wave * 2048);
    for (int it = gw; it < NCHK * 16; it += ngw) { const int ch = it >> 4, h = it & 15;
        scan_item<0>(a, W, ch * CHK, CHK, h, lane, ch == 0, nullptr, nullptr, nullptr, (float*)(a.wsp() + W_UC) + (size_t)it * 4096, nullptr);
        scan_item<2>(a, W, ch * CHK, CHK, h, lane, ch == 0, nullptr, nullptr, nullptr, nullptr, (float*)(a.wsp() + W_PC) + (size_t)it * 4096); }
}
__device__ __forceinline__ void phase_scan_c(const DArgs& a, LAS unsigned char* lds) {
    const int wave = threadIdx.x >> 6, lane = threadIdx.x & 63, gw = blockIdx.x * NWAVE + wave, ngw = gridDim.x * NWAVE;
    for (int it = gw; it < NCHK * 16; it += ngw) { const int ch = it >> 4, h = it & 15;
        scan_item<1>(a, (LAS float*)(lds + 8192 + wave * 2048), ch * CHK, CHK, h, lane, ch == 0, nullptr, (const float*)(a.wsp() + W_SST) + (size_t)it * 4096, nullptr, nullptr, nullptr); }
}
__device__ __forceinline__ void phase_scan_b(const DArgs& a, LAS unsigned char* lds) {
    const int wave = threadIdx.x >> 6, lane = threadIdx.x & 63;
    if (blockIdx.x < 64) {
        const int h = blockIdx.x >> 2, rg = blockIdx.x & 3, fr = lane & 15, g = lane >> 4;
        LAS float* Sb = (LAS float*)lds;
        const float* Pc = (const float*)(a.wsp() + W_PC); const float* Uc = (const float*)(a.wsp() + W_UC); float* Sst = (float*)(a.wsp() + W_SST);
        for (int i = threadIdx.x; i < 16 * 68; i += NTHR) Sb[i] = 0.f;
        if (wave < 4) {
#pragma unroll
            for (int r = 0; r < 4; ++r) Sst[(size_t)h * 4096 + (rg * 16 + 4 * g + r) * 64 + 16 * wave + fr] = 0.f;
        }
        float bq[16], uq[4];
        if (wave < 4) { const float* pc = Pc + (size_t)h * 4096; const float* uc = Uc + (size_t)h * 4096;
#pragma unroll
            for (int ks = 0; ks < 16; ++ks) bq[ks] = pc[(16 * g + ks) * 64 + 16 * wave + fr];
#pragma unroll
            for (int r = 0; r < 4; ++r) uq[r] = uc[(rg * 16 + 4 * g + r) * 64 + 16 * wave + fr]; }
        __syncthreads();
        for (int ch = 0; ch < NCHK; ++ch) {
            f32x4 acc0, acc1 = (f32x4){0.f, 0.f, 0.f, 0.f};
            if (wave < 4) {
                float bn[16], un[4];
                const int chn = ch + 1 < NCHK ? ch + 1 : ch;
                const float* pc = Pc + ((size_t)chn * 16 + h) * 4096; const float* uc = Uc + ((size_t)chn * 16 + h) * 4096;
#pragma unroll
                for (int ks = 0; ks < 16; ++ks) bn[ks] = pc[(16 * g + ks) * 64 + 16 * wave + fr];
#pragma unroll
                for (int r = 0; r < 4; ++r) un[r] = uc[(rg * 16 + 4 * g + r) * 64 + 16 * wave + fr];
                float aq[16];
#pragma unroll
                for (int q = 0; q < 4; ++q) { const f32x4 v = *(const LAS f32x4*)(Sb + fr * 68 + 16 * g + 4 * q); aq[4 * q] = v.x; aq[4 * q + 1] = v.y; aq[4 * q + 2] = v.z; aq[4 * q + 3] = v.w; }
                acc0 = (f32x4){uq[0], uq[1], uq[2], uq[3]};
#pragma unroll
                for (int ks = 0; ks < 16; ks += 2) { acc0 = __builtin_amdgcn_mfma_f32_16x16x4f32(aq[ks], bq[ks], acc0, 0, 0, 0); acc1 = __builtin_amdgcn_mfma_f32_16x16x4f32(aq[ks + 1], bq[ks + 1], acc1, 0, 0, 0); }
                acc0 += acc1;
#pragma unroll
                for (int ks = 0; ks < 16; ++ks) bq[ks] = bn[ks];
#pragma unroll
                for (int r = 0; r < 4; ++r) uq[r] = un[r];
            }
            __syncthreads();
            if (wave < 4) {
                float* dst = ch + 1 < NCHK ? Sst + ((size_t)(ch + 1) * 16 + h) * 4096 : a.outp() + O_WKVP + (size_t)h * 4096;
#pragma unroll
                for (int r = 0; r < 4; ++r) { Sb[(4 * g + r) * 68 + 16 * wave + fr] = acc0[r]; dst[(rg * 16 + 4 * g + r) * 64 + 16 * wave + fr] = acc0[r]; }
            }
            __syncthreads();
        }
    } else {
        const int it = (blockIdx.x - 64) * NWAVE + wave;
        if (it < 128) { const int b = it >> 4, h = it & 15;
            scan_item<1>(a, (LAS float*)(lds + 8192 + wave * 2048), TP + b * 32, 32, h, lane, true, a.in(I_SSHIFT) + (size_t)b * DSHIFT, a.in(I_SWKV) + ((size_t)b * 16 + h) * 4096,
                         a.outp() + O_WKVS + ((size_t)b * 16 + h) * 4096, nullptr, nullptr); }
    }
}

__device__ __forceinline__ void phase_attn_prep(const DArgs& a, LAS unsigned char* lds) {
    const int wave = threadIdx.x >> 6, lane = threadIdx.x & 63, gw = blockIdx.x * NWAVE + wave, ngw = gridDim.x * NWAVE;
    const int gt = blockIdx.x * NTHR + threadIdx.x, ngt = gridDim.x * NTHR;
    const bf16_t* qk = (const bf16_t*)(a.wsp() + W_QK); const bf16_t* vT = (const bf16_t*)(a.wsp() + W_VT);
    bf16_t* Ks = (bf16_t*)(a.wsp() + W_KS); bf16_t* VsT = (bf16_t*)(a.wsp() + W_VST);
    for (int i = gt; i < 8 * 576 * 256; i += ngt) {
        const int c8 = i & 255, kk = (i >> 8) % 576, b = i / (576 * 256);
        u32x4 w = (u32x4){0u, 0u, 0u, 0u};
        if (kk < 512) { float v[8]; ld8f(a.in(I_CK) + ((size_t)b * 512 + kk) * D + c8 * 8, v); w.x = pk2(v[0], v[1]); w.y = pk2(v[2], v[3]); w.z = pk2(v[4], v[5]); w.w = pk2(v[6], v[7]); }
        else if (kk < 544) w = *(const u32x4*)(qk + (size_t)(TP + b * 32 + kk - 512) * 4096 + 2048 + c8 * 8);
        *(u32x4*)(Ks + ((size_t)b * 576 + kk) * D + c8 * 8) = w;
    }
    LAS float* scr = (LAS float*)(lds + wave * 8448);
    for (int it = gw; it < 8 * 512; it += ngw) { const int b = it >> 9, r = it & 511, kb = r >> 6, nb = r & 63;
        transpose_item(a.in(I_CV) + (size_t)b * 512 * D, D, VsT + (size_t)b * D * 576, 576, scr, kb * 64, nb * 32, lane); }
    for (int i = gt; i < 8 * D * 8; i += ngt) {
        const int g8 = i & 7, c = (i >> 3) & (D - 1), b = i >> 14;
        u32x4 w = (u32x4){0u, 0u, 0u, 0u};
        if (g8 < 4) w = *(const u32x4*)(vT + (size_t)c * TA + TP + b * 32 + g8 * 8);
        *(u32x4*)(VsT + ((size_t)b * D + c) * 576 + 512 + g8 * 8) = w;
    }
    for (int i = gt; i < 512 * D; i += ngt) { const int r = i >> 11, c = i & (D - 1);
        a.outp()[O_KP + i] = bf2f(qk[(size_t)(TP - 512 + r) * 4096 + 2048 + c]); a.outp()[O_VP + i] = bf2f(vT[(size_t)c * TA + TP - 512 + r]); }
    for (int i = gt; i < TS * D; i += ngt) { const int r = i >> 11, c = i & (D - 1);
        a.outp()[O_KS + i] = bf2f(qk[(size_t)(TP + r) * 4096 + 2048 + c]); a.outp()[O_VS + i] = bf2f(vT[(size_t)c * TA + TP + r]); }
}
constexpr int KT_LD = 272, VT_LD = 144;
constexpr int A_K = 0, A_V = 64 * KT_LD, A_B = A_V + 128 * VT_LD;
__device__ __forceinline__ void phase_attn(const DArgs& a, LAS unsigned char* lds) {
    const int tid = threadIdx.x, wave = tid >> 6, lane = tid & 63, fr = lane & 15, g = lane >> 4;
    const bf16_t* qk = (const bf16_t*)(a.wsp() + W_QK); const bf16_t* vT = (const bf16_t*)(a.wsp() + W_VT);
    const bf16_t* Ks = (const bf16_t*)(a.wsp() + W_KS); const bf16_t* VsT = (const bf16_t*)(a.wsp() + W_VST);
    const float* relb = a.in(I_RELB);
    bf16_t* oatt = (bf16_t*)(a.wsp() + W_MIX);
    LAS float* biasT = (LAS float*)(lds + A_B);
    const float scale = 0.08838834764831845f;
    constexpr int NITEMS = 2048 + 128;
    struct Item { int h, qrow, qpos, tile_lo, tile_hi, qc, nkeys, ldk, ldv, kpos_base; const bf16_t* Kb; const bf16_t* Vb; bool wact, prompt; };
    auto setup = [&](int it) -> Item { Item I; I.prompt = it < 2048; I.qc = 0;
        if (I.prompt) { const int pi = it >> 4; I.h = it & 15; I.qc = 2 * pi + (wave >> 2); I.qrow = I.qc * 64 + (wave & 3) * 16 + fr; I.qpos = I.qrow;
            I.tile_lo = 2 * pi - 8 < 0 ? 0 : 2 * pi - 8; I.tile_hi = 2 * pi + 1; I.nkeys = 1 << 30; I.ldk = 4096; I.ldv = TA; I.kpos_base = 0;
            I.Kb = qk + 2048 + I.h * 128; I.Vb = vT + (size_t)(I.h * 128) * TA; I.wact = true; }
        else { const int s_ = it - 2048, b = s_ >> 4; I.h = s_ & 15; const int w2 = wave & 1; I.qrow = TP + b * 32 + w2 * 16 + fr; I.qpos = 2048 + w2 * 16 + fr;
            I.tile_lo = 0; I.tile_hi = 8; I.nkeys = 544; I.ldk = D; I.ldv = 576; I.kpos_base = 1536;
            I.Kb = Ks + (size_t)b * 576 * D + I.h * 128; I.Vb = VsT + ((size_t)b * D + I.h * 128) * 576; I.wact = wave < 2; }
        return I; };
    u32x4 kreg[2], vreg[2];
    const int kr = tid >> 4, kc = tid & 15, vr = tid >> 3, vc = tid & 7;
#define ATT_LOAD(I_, tile) do { _Pragma("unroll") for (int p_ = 0; p_ < 2; ++p_) { \
        kreg[p_] = *(const u32x4*)((I_).Kb + (size_t)((tile) * 64 + kr + 32 * p_) * (I_).ldk + kc * 8); \
        vreg[p_] = *(const u32x4*)((I_).Vb + (size_t)(vr + 64 * p_) * (I_).ldv + (tile) * 64 + vc * 8); } } while (0)
#define ATT_STORE() do { _Pragma("unroll") for (int p_ = 0; p_ < 2; ++p_) { \
        *(LAS u32x4*)(lds + A_K + (kr + 32 * p_) * KT_LD + kc * 16) = kreg[p_]; \
        *(LAS u32x4*)(lds + A_V + (vr + 64 * p_) * VT_LD + vc * 16) = vreg[p_]; } } while (0)
#define ATT_LOADQ(dst_, I_) do { _Pragma("unroll") for (int ks = 0; ks < 4; ++ks) dst_[ks] = *(const bf16x8*)(qk + (size_t)(I_).qrow * 4096 + (I_).h * 128 + 32 * ks + 8 * g); } while (0)
    if ((int)blockIdx.x >= NITEMS) return;
    Item cur = setup(blockIdx.x);
    bf16x8 qf[4], qfn[4];
    float biasn = tid < 257 ? relb[cur.h * 257 + tid] : 0.f;
    ATT_LOADQ(qf, cur);
    ATT_LOAD(cur, cur.tile_lo);
    for (int it = blockIdx.x; it < NITEMS; it += gridDim.x) {
        const bool has_next = it + (int)gridDim.x < NITEMS;
        const Item nxt = setup(has_next ? it + (int)gridDim.x : it);
        f32x4 oacc[8];
#pragma unroll
        for (int n = 0; n < 8; ++n) oacc[n] = (f32x4){0.f, 0.f, 0.f, 0.f};
        float mrun = -1e30f, lrun = 0.f;
        __syncthreads();
        ATT_STORE();
        if (tid < 257) biasT[tid] = biasn;
        __syncthreads();
        for (int tile = cur.tile_lo; tile <= cur.tile_hi; ++tile) {
            if (tile < cur.tile_hi) ATT_LOAD(cur, tile + 1);
            else if (has_next) { ATT_LOAD(nxt, nxt.tile_lo); ATT_LOADQ(qfn, nxt); biasn = tid < 257 ? relb[nxt.h * 257 + tid] : 0.f; }
            const bool act = cur.wact && (!cur.prompt || (tile >= cur.qc - 8 && tile <= cur.qc));
            if (act) {
                f32x4 sacc[4];
#pragma unroll
                for (int kt = 0; kt < 4; ++kt) { sacc[kt] = (f32x4){0.f, 0.f, 0.f, 0.f};
#pragma unroll
                    for (int ks = 0; ks < 4; ++ks) { const bf16x8 kf = *(const LAS bf16x8*)(lds + A_K + (16 * kt + fr) * KT_LD + (32 * ks + 8 * g) * 2);
                        sacc[kt] = __builtin_amdgcn_mfma_f32_16x16x32_bf16(kf, qf[ks], sacc[kt], 0, 0, 0); } }
                const int kpos0 = cur.kpos_base + tile * 64, kidx0 = tile * 64;
                float tmax = -1e30f;
#pragma unroll
                for (int kt = 0; kt < 4; ++kt)
#pragma unroll
                    for (int r = 0; r < 4; ++r) { const int key = 16 * kt + 4 * g + r; float bias;
                        { int rel = cur.qpos - (kpos0 + key); rel = rel < -128 ? -128 : (rel > 128 ? 128 : rel); bias = biasT[rel + 128]; }
                        float s_ = sacc[kt][r] * scale + bias; if (kidx0 + key >= cur.nkeys) s_ = -1e30f; sacc[kt][r] = s_; tmax = fmaxf(tmax, s_); }
                tmax = fmaxf(tmax, __shfl_xor(tmax, 16)); tmax = fmaxf(tmax, __shfl_xor(tmax, 32));
                const float mnew = fmaxf(mrun, tmax), alpha = __expf(mrun - mnew); mrun = mnew;
                float psum = 0.f;
#pragma unroll
                for (int kt = 0; kt < 4; ++kt)
#pragma unroll
                    for (int r = 0; r < 4; ++r) { const float p_ = __expf(sacc[kt][r] - mnew); sacc[kt][r] = p_; psum += p_; }
                lrun = lrun * alpha + psum;
#pragma unroll
                for (int n = 0; n < 8; ++n) oacc[n] = oacc[n] * alpha;
#pragma unroll
                for (int j = 0; j < 2; ++j) {
                    u32x4 pw; pw.x = pk2(sacc[2 * j][0], sacc[2 * j][1]); pw.y = pk2(sacc[2 * j][2], sacc[2 * j][3]); pw.z = pk2(sacc[2 * j + 1][0], sacc[2 * j + 1][1]); pw.w = pk2(sacc[2 * j + 1][2], sacc[2 * j + 1][3]);
                    const bf16x8 pf = __builtin_bit_cast(bf16x8, pw);
#pragma unroll
                    for (int n = 0; n < 8; ++n) {
                        const u32x2 v0 = *(const LAS u32x2*)(lds + A_V + (16 * n + fr) * VT_LD + (32 * j + 4 * g) * 2);
                        const u32x2 v1 = *(const LAS u32x2*)(lds + A_V + (16 * n + fr) * VT_LD + (32 * j + 16 + 4 * g) * 2);
                        const bf16x8 vf = __builtin_bit_cast(bf16x8, (u32x4){v0.x, v0.y, v1.x, v1.y});
                        oacc[n] = __builtin_amdgcn_mfma_f32_16x16x32_bf16(vf, pf, oacc[n], 0, 0, 0);
                    }
                }
            }
            if (tile < cur.tile_hi) { __syncthreads(); ATT_STORE(); __syncthreads(); }
        }
        if (cur.wact) {
            float l = lrun; l += __shfl_xor(l, 16); l += __shfl_xor(l, 32);
            const float inv = 1.f / l;
#pragma unroll
            for (int n = 0; n < 8; ++n) { u32x2 w; w.x = pk2(oacc[n][0] * inv, oacc[n][1] * inv); w.y = pk2(oacc[n][2] * inv, oacc[n][3] * inv);
                *(u32x2*)(oatt + (size_t)cur.qrow * D + cur.h * 128 + 16 * n + 4 * g) = w; }
        }
        cur = nxt;
#pragma unroll
        for (int ks = 0; ks < 4; ++ks) qf[ks] = qfn[ks];
    }
    __syncthreads();
#undef ATT_LOAD
#undef ATT_STORE
#undef ATT_LOADQ
}


#define XB_TMO      128
#define XB_XCNT(j)  (256  + 64 * (j))
#define XB_XSUB(j)  (1280 + 64 * (j))
#define XB_XGEN(j)  (2304 + 64 * (j))
#define XB_TOP      3328
#define XB_TOPGEN   3392
#define XCD_BAR_WORDS 3456
#define XB_SPIN_CAP (1u << 18)
__device__ __forceinline__ unsigned xb_ld(unsigned* p)              { return __hip_atomic_load(p, __ATOMIC_RELAXED, __HIP_MEMORY_SCOPE_AGENT); }
__device__ __forceinline__ unsigned xb_add(unsigned* p, unsigned v) { return __hip_atomic_fetch_add(p, v, __ATOMIC_RELAXED, __HIP_MEMORY_SCOPE_AGENT); }
__device__ __forceinline__ unsigned xb_xcc_id() { return (unsigned)__builtin_amdgcn_s_getreg((3 << 11) | 20) & 0xFu; }
#define XB_SPIN(cond, bar) do { unsigned _sp = 0; while (cond) { __builtin_amdgcn_s_sleep(1); \
    if ((++_sp & 255u) == 0u) { if (xb_ld(&(bar)[XB_TMO])) break; if (_sp > XB_SPIN_CAP) { atomicAdd(&(bar)[XB_TMO], 1u); break; } } } } while (0)
struct XcdBarrier { unsigned* bar; unsigned x; volatile LAS unsigned* st; };
__device__ __forceinline__ XcdBarrier xcd_barrier_post(unsigned* bar, volatile LAS unsigned* st) {
    XcdBarrier b; b.bar = bar; b.x = xb_xcc_id(); b.st = st;
    if (threadIdx.x == 0) (void)xb_add(&bar[XB_XCNT(b.x)], 1u);
    return b;
}
__device__ __forceinline__ void xcd_barrier_complete(unsigned* bar, unsigned x, unsigned& nloc, unsigned& nx) {
    const unsigned G = gridDim.x * gridDim.y * gridDim.z;
    unsigned sum, cnt, mine, sp = 0u;
    for (;;) {
        sum = 0u; cnt = 0u; mine = 0u;
#pragma unroll
        for (unsigned j = 0; j < 16; ++j) { const unsigned c = xb_ld(&bar[XB_XCNT(j)]); sum += c; cnt += (c > 0u) ? 1u : 0u; mine = (j == x) ? c : mine; }
        if (sum == G) break;
        __builtin_amdgcn_s_sleep(1);
        if ((++sp & 255u) == 0u) { if (xb_ld(&bar[XB_TMO])) break; if (sp > XB_SPIN_CAP) { atomicAdd(&bar[XB_TMO], 1u); break; } }
    }
    nloc = mine > 0u ? mine : 1u; nx = cnt > 0u ? cnt : 1u;
}
__device__ __forceinline__ void xcd_barrier(const XcdBarrier& b) {
    asm volatile("s_waitcnt vmcnt(0)" ::: "memory");
    __syncthreads();
    if (threadIdx.x == 0) {
        unsigned* bar = b.bar;
        __builtin_amdgcn_s_waitcnt(0);
        unsigned nloc = b.st[0], nx = b.st[1];
        if (nloc == 0u) { xcd_barrier_complete(bar, b.x, nloc, nx); b.st[0] = nloc; b.st[1] = nx; }
        const unsigned old = xb_add(&bar[XB_XSUB(b.x)], 1u);
        const unsigned gen = old / nloc;
        if (old + 1u == (gen + 1u) * nloc) {
            __builtin_amdgcn_fence(__ATOMIC_RELEASE, "agent");
            asm volatile("s_waitcnt vmcnt(0)" ::: "memory");
            const unsigned og = xb_add(&bar[XB_TOP], 1u);
            const unsigned tg = og / nx;
            if (og + 1u == (tg + 1u) * nx) xb_add(&bar[XB_TOPGEN], 1u);
            else XB_SPIN(xb_ld(&bar[XB_TOPGEN]) == tg, bar);
            __builtin_amdgcn_fence(__ATOMIC_ACQUIRE, "agent");
            xb_add(&bar[XB_XGEN(b.x)], 1u);
            asm volatile("s_waitcnt vmcnt(0)" ::: "memory");
        } else {
            XB_SPIN(xb_ld(&bar[XB_XGEN(b.x)]) == gen, bar);
            __builtin_amdgcn_fence(__ATOMIC_ACQUIRE, "agent");
            asm volatile("s_waitcnt vmcnt(0)" ::: "memory");
        }
    }
    __syncthreads();
}

__global__ __launch_bounds__(512, 2) void mega(Args aa) {
    extern __shared__ __attribute__((aligned(16))) unsigned char shm[];
    LAS unsigned char* lds = (LAS unsigned char*)shm;
    cg::grid_group grid = cg::this_grid();
    {
        LAS unsigned long long* tabw = (LAS unsigned long long*)(lds + 131072);
        if (threadIdx.x == 0) {
#pragma unroll
            for (int i = 0; i < 32; ++i) tabw[i] = (unsigned long long)aa.in[i];
            tabw[32] = (unsigned long long)aa.out; tabw[33] = (unsigned long long)aa.ws;
        }
        __syncthreads();
    }
    DArgs a; a.tab = (LAS const unsigned long long*)(lds + 131072); a.ph_lo = aa.ph_lo; a.ph_hi = aa.ph_hi;
    volatile LAS unsigned* xb_st = (volatile LAS unsigned*)(lds + 131072 + 448);
    if (threadIdx.x == 0) { xb_st[0] = 0u; xb_st[1] = 0u; }
    __syncthreads();
    const XcdBarrier xb = xcd_barrier_post((unsigned*)(__attribute__((address_space(1))) unsigned*)(a.wsp() + W_BAR), xb_st);
#define gn a.in(I_GNORM)
#define ws a.wsp()
    const int nM = TA / 256;
#ifndef PHMASK
#define PHMASK 0x3fffff
#endif
#ifndef DUPMASK
#define DUPMASK 0
#endif
#define PH(p) if (((PHMASK >> (p)) & 1) && a.ph_lo <= (p) && (p) < a.ph_hi) for (int rep_ = 0; rep_ < (((DUPMASK >> (p)) & 1) ? 2 : 1); ++rep_, (((DUPMASK >> (p)) & 1) && rep_ < 2 ? grid.sync() : (void)0))
#define SYNC(p) if (a.ph_lo <= (p) && (p) + 1 < a.ph_hi) xcd_barrier(xb);
    if (a.ph_lo < 0) grid.sync();
    PH(0) { phase_mod_partial(a, lds); phase_convert(a, lds); }
    SYNC(0)
    PH(1) { phase_mod_final(a); }
    SYNC(1)
    PH(2) { phase_rowwise<true, false, true>(a, nullptr, 0, 0, gn + 0 * D, 0, 1, 0); }
    SYNC(2)
    PH(3) { pg8::EpiBf16<0> E{(bf16_t*)(ws + W_P), DIN0, nullptr};
        run_gemm(lds, D, D, D, ws + W_HA, ws + W_IN0T, nM, DIN0 / 256, 0, nullptr, nullptr, 0, 0, E);
        const int c0 = (nM * (DIN0 / 256)) % (int)gridDim.x; convert_sub(a, lds, CV_OUT0, c0); convert_sub(a, lds, CV_FF1_0, c0); }
    SYNC(3)
    PH(4) { phase_prep(a); }
    SYNC(4)
    PH(5) { { pg8::EpiBf16<0> E{(bf16_t*)(ws + W_MIX), D, nullptr};
          run_gemm(lds, 256, 1280, 256, ws + W_AL, ws + W_POOLT, nM, 4, 512, nullptr, nullptr, 0, 0, E); }
        { pg8::EpiF32 E{(float*)(ws + W_L), 3072};
          run_gemm(lds, 256, 1280, 256, ws + W_AL + 2048, ws + W_LORAT, nM, 12, 0, nullptr, nullptr, 0, 0, E); } }
    SYNC(5)
    PH(6) { phase_scan_a(a, lds); }
    SYNC(6)
    PH(7) { phase_scan_b(a, lds); }
    SYNC(7)
    PH(8) { phase_scan_c(a, lds); }
    SYNC(8)
    PH(9) { pg8::Epi2<pg8::EpiBf16<0>, pg8::EpiPartF32> E{{(bf16_t*)(ws + W_O), D, nullptr}, {(float*)(ws + W_OACC), D}};
        run_gemm(lds, D, D, D, ws + W_MIX, ws + W_OUT0T, 64, 8, 0, ws + W_MIX, ws + W_OUT0T, 0, 8, E, 8, 64); }
    SYNC(9)
    PH(10) { phase_rowwise<true, true, true>(a, gn + 1 * D, 0, 2, gn + 2 * D, 0, 4, 3, 8); }
    SYNC(10)
    PH(11) { pg8::EpiBf16<1> E{(bf16_t*)(ws + W_F1), DFF, nullptr};
        run_gemm(lds, D, D, D, ws + W_HA, ws + W_FF1T, nM, DFF / 256, 0, nullptr, nullptr, 0, 0, E);
        const int c0 = (nM * (DFF / 256)) % (int)gridDim.x; convert_sub(a, lds, CV_FF2_0, c0); convert_sub(a, lds, CV_QKV, c0); }
    SYNC(11)
    PH(12) { pg8::Epi2<pg8::EpiBf16<0>, pg8::EpiPartF32> E{{(bf16_t*)(ws + W_O), D, nullptr}, {(float*)(ws + W_OACC), D}};
        run_gemm(lds, DFF, DFF, DFF, ws + W_F1, ws + W_FF2T, 64, 8, 0, ws + W_F1, ws + W_FF2T, 0, 8, E, 32, 64); }
    SYNC(12)
    PH(13) { phase_rowwise<false, true, true>(a, gn + 3 * D, 0, 5, gn + 4 * D, 1, 1, 0, 32); }
    SYNC(13)
    PH(14) { pg8::Epi2<pg8::EpiBf16<0>, pg8::EpiBf16<0>> E{{(bf16_t*)(ws + W_QK), 4096, nullptr}, {(bf16_t*)(ws + W_VT), TA, nullptr}};
        run_gemm(lds, D, D, D, ws + W_HA, ws + W_QKVT, nM, 16, 0, ws + W_QKVT + (size_t)4096 * D * 2, ws + W_HA, 8, nM, E);
        const int c0 = (nM * 24) % (int)gridDim.x; convert_sub(a, lds, CV_OUT1, c0); convert_sub(a, lds, CV_FF1_1, c0); }
    SYNC(14)
    PH(15) { phase_attn_prep(a, lds); }
    SYNC(15)
    PH(16) { phase_attn(a, lds); }
    SYNC(16)
    PH(17) { pg8::Epi2<pg8::EpiBf16<0>, pg8::EpiPartF32> E{{(bf16_t*)(ws + W_O), D, nullptr}, {(float*)(ws + W_OACC), D}};
        run_gemm(lds, D, D, D, ws + W_MIX, ws + W_OUT1T, 64, 8, 0, ws + W_MIX, ws + W_OUT1T, 0, 8, E, 8, 64); }
    SYNC(17)
    PH(18) { phase_rowwise<false, true, true>(a, gn + 5 * D, 1, 2, gn + 6 * D, 1, 4, 3, 8); }
    SYNC(18)
    PH(19) { pg8::EpiBf16<1> E{(bf16_t*)(ws + W_F1), DFF, nullptr};
        run_gemm(lds, D, D, D, ws + W_HA, ws + W_FF1T, nM, DFF / 256, 0, nullptr, nullptr, 0, 0, E);
        const int c0 = (nM * (DFF / 256)) % (int)gridDim.x; convert_sub(a, lds, CV_FF2_1, c0); }
    SYNC(19)
    PH(20) { pg8::Epi2<pg8::EpiBf16<0>, pg8::EpiPartF32> E{{(bf16_t*)(ws + W_O), D, nullptr}, {(float*)(ws + W_OACC), D}};
        run_gemm(lds, DFF, DFF, DFF, ws + W_F1, ws + W_FF2T, 64, 8, 0, ws + W_F1, ws + W_FF2T, 0, 8, E, 32, 64); }
    SYNC(20)
    PH(21) { phase_rowwise<false, true, false>(a, gn + 7 * D, 1, 5, nullptr, 0, 0, 0, 32); }
#undef PH
#undef SYNC
#undef gn
#undef ws
}

constexpr int NPHASE = 22;
#ifndef MK_MULTI
#define MK_MULTI 0
#endif
extern "C" void kernel_launch(void* const* d_in, const int* in_sizes, int n_in, void* d_out, int out_size, void* d_ws, size_t ws_size, hipStream_t stream) {
    static int grid = 0;
    constexpr int LDS_BYTES = 131072 + 512;
    if (grid == 0) {
        if (n_in != 32 || ws_size < WS_TOTAL) { fprintf(stderr, "kernel_launch: unexpected n_in %d / ws %zu (need %zu)\n", n_in, ws_size, (size_t)WS_TOTAL); grid = -1; return; }
        int dev = 0, cus = 0, per_cu = 0;
        hipGetDevice(&dev); hipDeviceGetAttribute(&cus, hipDeviceAttributeMultiprocessorCount, dev);
        if (hipFuncSetAttribute((const void*)mega, hipFuncAttributeMaxDynamicSharedMemorySize, LDS_BYTES) != hipSuccess) { fprintf(stderr, "kernel_launch: hipFuncSetAttribute failed\n"); grid = -1; return; }
        hipOccupancyMaxActiveBlocksPerMultiprocessor(&per_cu, (const void*)mega, NTHR, LDS_BYTES);
        if (per_cu < 1) { fprintf(stderr, "kernel_launch: occupancy query says %d blocks per CU\n", per_cu); per_cu = 1; }
        (void)hipGetLastError();
        grid = cus;
    }
    if (grid < 0) return;
    Args a{};
    for (int i = 0; i < 32; ++i) a.in[i] = (const float*)d_in[i];
    a.out = (float*)d_out; a.ws = (unsigned char*)d_ws;
#if MK_MULTI
    for (int p = 0; p < NPHASE; ++p) { a.ph_lo = p; a.ph_hi = p + 1; hipLaunchKernelGGL(mega, dim3(grid), dim3(NTHR), LDS_BYTES, stream, a); }
#else
    a.ph_lo = 0; a.ph_hi = NPHASE;
    if (hipMemsetAsync((char*)d_ws + W_BAR, 0, XCD_BAR_WORDS * 4, stream) != hipSuccess) { fprintf(stderr, "kernel_launch: memset of barrier words failed\n"); return; }
    void* args[] = {&a};
    hipError_t e = hipLaunchCooperativeKernel((const void*)mega, dim3(grid), dim3(NTHR), args, LDS_BYTES, stream);
    if (e != hipSuccess) fprintf(stderr, "kernel_launch: cooperative launch failed: %s (grid %d)\n", hipGetErrorString(e), grid);
#endif
}
```

```cpp
#include <hip/hip_runtime.h>
#include <hip/hip_cooperative_groups.h>
#include <cstdio>
#include <cstdint>
namespace cg = cooperative_groups;

#define LAS __attribute__((address_space(3)))
typedef unsigned short bf16_t;
typedef short bf16x8 __attribute__((ext_vector_type(8)));
typedef short bf16x4 __attribute__((ext_vector_type(4)));
typedef float f32x4 __attribute__((ext_vector_type(4)));
typedef float f32x2 __attribute__((ext_vector_type(2)));
typedef unsigned u32x4 __attribute__((ext_vector_type(4)));
typedef unsigned u32x2 __attribute__((ext_vector_type(2)));

constexpr int TP = 16384, TS = 256, TA = TP + TS;
constexpr int D = 2048, DFF = 8192, DIN0 = 4352, DPOOL = 1024, DSHIFT = 3328;
constexpr int NWAVE = 8, NTHR = 512;
constexpr int CHK = 128, NCHK = TP / CHK;
constexpr size_t O_Y = 0, O_POOLP = 34078720, O_POOLS = 34094080, O_SHIFTP = 34216960, O_SHIFTS = 34220288,
                 O_WKVP = 34246912, O_WKVS = 34312448, O_KP = 34836736, O_VP = 35885312, O_KS = 36933888, O_VS = 37458176;
constexpr size_t W_IN0T = 0, W_OUT0T = 17825792, W_QKVT = 26214400, W_OUT1T = 51380224, W_FF1T = 59768832, W_FF2T = 93323264,
                 W_POOLT = 126877696, W_LORAT = 127401984, W_MOD = 128974848, W_MODPART = 129859584,
                 W_HA = 144015360, W_MIX = 212172800, W_O = 280330240, W_R = 348487680, WS_END = 697794560;
constexpr size_t W_AL = W_HA;
constexpr size_t W_SST = W_HA;
constexpr size_t W_PC = W_O, W_UC = W_O + 33554432;
constexpr size_t W_P = W_R, W_L = W_R + 144834560;
constexpr size_t W_F1 = W_R;
constexpr size_t W_QK = W_R, W_VT = W_R + 136314880, W_KS = W_R + 204472320, W_VST = W_R + 223346688;
constexpr int KSPLIT = 16;
constexpr size_t W_BAR = WS_END, WS_TOTAL = WS_END + 16384;
constexpr size_t W_OACC = W_R + 272629760, WS_END2 = WS_END;

struct Args {
    const float* in[32];
    float* out;
    unsigned char* ws;
    int ph_lo, ph_hi;
};
struct DArgs {
    LAS const unsigned long long* tab; int ph_lo, ph_hi;
    __device__ __forceinline__ unsigned long long ld(int i) const { const unsigned long long v = tab[i];
        const unsigned lo = __builtin_amdgcn_readfirstlane((unsigned)v), hi = __builtin_amdgcn_readfirstlane((unsigned)(v >> 32)); return ((unsigned long long)hi << 32) | lo; }
    __device__ __forceinline__ const float* in(int i) const { return (const float*)(const __attribute__((address_space(1))) float*)ld(i); }
    __device__ __forceinline__ float* outp() const { return (float*)(__attribute__((address_space(1))) float*)ld(32); }
    __device__ __forceinline__ unsigned char* wsp() const { return (unsigned char*)(__attribute__((address_space(1))) unsigned char*)ld(33); }
};
enum { I_XP = 0, I_XS, I_CP, I_CS, I_SPOOL, I_SSHIFT, I_SWKV, I_CK, I_CV, I_WADA, I_BADA, I_GNORM, I_WIN0, I_WPOOL, I_PSCALE, I_MU,
       I_W0, I_W2, I_A0, I_A2, I_G2, I_KK, I_KA, I_RK, I_LNW, I_LNB, I_WOUT0, I_WQKV, I_RELB, I_WOUT1, I_WFF1, I_WFF2 };

__device__ __forceinline__ float bf2f(bf16_t b) { return __uint_as_float(((unsigned)b) << 16); }
__device__ __forceinline__ float bflo(unsigned w) { return __uint_as_float(w << 16); }
__device__ __forceinline__ float bfhi(unsigned w) { return __uint_as_float(w & 0xffff0000u); }
__device__ __forceinline__ unsigned pk2(float lo, float hi) { unsigned r; asm("v_cvt_pk_bf16_f32 %0, %1, %2" : "=v"(r) : "v"(lo), "v"(hi)); return r; }
__device__ __forceinline__ bf16_t f2bf(float f) { return (bf16_t)(pk2(f, 0.f) & 0xffffu); }
__device__ __forceinline__ float rl(float v, int l) { return __int_as_float(__builtin_amdgcn_readlane(__float_as_int(v), l)); }
template <int CTRL> __device__ __forceinline__ float dppf(float v) { return __int_as_float(__builtin_amdgcn_update_dpp(0, __float_as_int(v), CTRL, 0xf, 0xf, false)); }
__device__ __forceinline__ float wave_sum(float v) {
    v += dppf<0xB1>(v); v += dppf<0x4E>(v); v += dppf<0x141>(v); v += dppf<0x140>(v);
    return (rl(v, 0) + rl(v, 16)) + (rl(v, 32) + rl(v, 48));
}
__device__ __forceinline__ float sigmoidf_(float x) { return __builtin_amdgcn_rcpf(1.f + __expf(-x)); }
__device__ __forceinline__ int entry_of(int row) { return row < TP ? 0 : 1 + ((row - TP) >> 5); }

namespace pg8 {
constexpr int BM = 256, BK = 64, HALF = 128, HTB = HALF * BK * 2, STAGE_BYTES = 8 * HTB, NXCD = 8, WGM = 8;
__device__ __forceinline__ int lds_byte(int r, int c) { const int st = (r >> 4) * 2 + (c >> 5), rr = r & 15, cc = c & 31, ob = rr * 64 + cc * 2; return st * 1024 + (ob ^ (((ob >> 9) & 1) << 5)); }
__device__ __forceinline__ void stage_rc(int b, int& R, int& C) { const int st = b / 1024, sb = b % 1024, swz = sb ^ (((sb >> 9) & 1) << 5); R = (st >> 1) * 16 + swz / 64; C = (st & 1) * 32 + (swz % 64) / 2; }
__device__ __forceinline__ int perm32(int rho) { const int n = rho >> 4, i = rho & 15; return 8 * (i >> 2) + 4 * n + (i & 3); }

struct Unit { const char* a; const char* b; int pm, pn, g, nt, sl; };
struct GDesc { const char* A; const char* B; int nM, nN; long a_pn_off; };
struct Sched {
    GDesc g0, g1; int n0, n1, G, c; long tstepA, tstepB; int nt0, S1, nt1, pm1; long ksb;
    __device__ __forceinline__ void decode(const GDesc& g, int L, Unit& u, int gi) const {
        const int nwg = g.nM * g.nN; int wgid = L;
        { const int q = nwg / NXCD, r = nwg % NXCD, xcd = wgid % NXCD, off = wgid / NXCD; wgid = (xcd < r ? xcd * (q + 1) : r * (q + 1) + (xcd - r) * q) + off; }
        const int nig = WGM * g.nN, gid = wgid / nig, fm = gid * WGM, gsz = (g.nM - fm) < WGM ? (g.nM - fm) : WGM;
        u.pm = fm + ((wgid % nig) % gsz); u.pn = (wgid % nig) / gsz; u.g = gi;
        u.a = g.A + (long)u.pm * tstepA + (long)u.pn * g.a_pn_off; u.b = g.B + (long)u.pn * tstepB;
    }
    __device__ __forceinline__ bool next(int i, Unit& u) const {
        const long L = (long)i * G + c;
        if (L < n0) { decode(g0, (int)L, u, 0); u.nt = nt0; return true; }
        if (L < n0 + n1) {
            if (S1 == 0) { decode(g1, (int)(L - n0), u, 1); u.nt = nt0; }
            else { const int q = (int)(L - n0), sl = q / g1.nN, pn = q % g1.nN; u.pm = pm1; u.pn = pn; u.g = 1; u.nt = nt1; u.sl = sl;
                u.a = g1.A + (long)pm1 * tstepA + (long)sl * ksb; u.b = g1.B + (long)pn * tstepB + (long)sl * ksb; }
            return true; }
        return false;
    }
};

template <int ACT> struct EpiBf16 {
    bf16_t* O; int ldc; const float* cs;
    __device__ __forceinline__ void operator()(const f32x4 (&acc)[2][2][4][2], const Unit& u, int wr, int wc, int fr, int fq) const {
        const int row0 = u.pm * BM + wr * 64 + fr, col0 = u.pn * BM + wc * 32 + 8 * fq;
        f32x4 sv[2][2];
        if (ACT == 2) {
#pragma unroll
            for (int bj = 0; bj < 2; ++bj)
#pragma unroll
                for (int n = 0; n < 2; ++n) sv[bj][n] = *(const f32x4*)(cs + col0 + bj * HALF + 4 * n);
        }
#pragma unroll
        for (int ai = 0; ai < 2; ++ai)
#pragma unroll
            for (int m = 0; m < 4; ++m) { bf16_t* rowp = O + (size_t)(row0 + ai * HALF + m * 16) * ldc + col0;
#pragma unroll
                for (int bj = 0; bj < 2; ++bj) { f32x4 v0 = acc[ai][bj][m][0], v1 = acc[ai][bj][m][1];
                    if (ACT == 1) {
#pragma unroll
                        for (int j = 0; j < 4; ++j) { const float a0 = fmaxf(v0[j], 0.f), a1 = fmaxf(v1[j], 0.f); v0[j] = a0 * a0; v1[j] = a1 * a1; } }
                    if (ACT == 2) { v0 = v0 * sv[bj][0]; v1 = v1 * sv[bj][1]; }
                    u32x4 w; w.x = pk2(v0[0], v0[1]); w.y = pk2(v0[2], v0[3]); w.z = pk2(v1[0], v1[1]); w.w = pk2(v1[2], v1[3]);
                    *(u32x4*)(rowp + bj * HALF) = w; } }
    }
};
struct EpiF32 {
    float* C; int ldc;
    __device__ __forceinline__ void operator()(const f32x4 (&acc)[2][2][4][2], const Unit& u, int wr, int wc, int fr, int fq) const {
        const int row0 = u.pm * BM + wr * 64 + fr, col0 = u.pn * BM + wc * 32 + 8 * fq;
#pragma unroll
        for (int ai = 0; ai < 2; ++ai)
#pragma unroll
            for (int m = 0; m < 4; ++m) { float* rowp = C + (size_t)(row0 + ai * HALF + m * 16) * ldc + col0;
#pragma unroll
                for (int bj = 0; bj < 2; ++bj)
#pragma unroll
                    for (int n = 0; n < 2; ++n) *(f32x4*)(rowp + bj * HALF + 4 * n) = acc[ai][bj][m][n]; }
    }
};
struct EpiPartF32 {
    float* C; int ldc;
    __device__ __forceinline__ void operator()(const f32x4 (&acc)[2][2][4][2], const Unit& u, int wr, int wc, int fr, int fq) const {
        const int row0 = wr * 64 + fr, col0 = u.pn * BM + wc * 32 + 8 * fq;
        float* base = C + (size_t)u.sl * 256 * ldc;
#pragma unroll
        for (int ai = 0; ai < 2; ++ai)
#pragma unroll
            for (int m = 0; m < 4; ++m) { float* rowp = base + (size_t)(row0 + ai * HALF + m * 16) * ldc + col0;
#pragma unroll
                for (int bj = 0; bj < 2; ++bj)
#pragma unroll
                    for (int n = 0; n < 2; ++n) *(f32x4*)(rowp + bj * HALF + 4 * n) = acc[ai][bj][m][n]; }
    }
};
template <class E0, class E1> struct Epi2 {
    E0 e0; E1 e1;
    __device__ __forceinline__ void operator()(const f32x4 (&acc)[2][2][4][2], const Unit& u, int wr, int wc, int fr, int fq) const {
        if (u.g == 0) e0(acc, u, wr, wc, fr, fq); else e1(acc, u, wr, wc, fr, fq);
    }
};

template <class Epi>
__device__ __forceinline__ void gemm_phase(LAS unsigned char* lds, const int K, const int lda, const int ldb, const Sched& S, const Epi& E) {
    const int tid = threadIdx.x, wid = __builtin_amdgcn_readfirstlane(tid >> 6), lane = tid & 63, wr = wid >> 2, wc = wid & 3, fr = lane & 15, fq = lane >> 4;
    unsigned voffA[2], voffB[2];
#pragma unroll
    for (int i = 0; i < 2; ++i) { int R, C; stage_rc(tid * 16 + i * 8192, R, C); const int Rb = (R & ~31) + perm32(R & 31);
        voffA[i] = (unsigned)(R * lda + C) * 2u; voffB[i] = (unsigned)(Rb * ldb + C) * 2u; }
    const size_t kstep = (size_t)(BK * 2);
    const size_t hstepA = (size_t)HALF * lda * 2, hstepB = (size_t)HALF * ldb * 2;
    const unsigned ldsw = (unsigned)wid * 1024u;
    const int aoff = lds_byte(wr * 64 + fr, fq * 8), boff = lds_byte(wc * 32 + fr, fq * 8);
#define PG8_SA(b, h) (((b) * 2 + (h)) * HTB)
#define PG8_SB(b, h) ((4 + (b) * 2 + (h)) * HTB)
#define PG8_STAGE(bufoff, gbase, voff) do { _Pragma("unroll") for (int _i = 0; _i < 2; ++_i) \
        __builtin_amdgcn_global_load_lds((const unsigned*)((const char*)(gbase) + (voff)[_i]), (LAS unsigned*)(lds + (bufoff) + ldsw + _i * 8192), 16, 0, 0); } while (0)
#define PG8_LDA(dst, b, h) do { _Pragma("unroll") for (int m = 0; m < 4; ++m) _Pragma("unroll") for (int k = 0; k < 2; ++k) dst[m][k] = *(const LAS bf16x8*)(lds + PG8_SA(b, h) + aoff + m * 2048 + k * 1024); } while (0)
#define PG8_LDB(dst, b, h) do { _Pragma("unroll") for (int n = 0; n < 2; ++n) _Pragma("unroll") for (int k = 0; k < 2; ++k) dst[n][k] = *(const LAS bf16x8*)(lds + PG8_SB(b, h) + boff + n * 2048 + k * 1024); } while (0)
#define PG8_MMA(ai, bj, At, Bt) do { __builtin_amdgcn_s_setprio(1); _Pragma("unroll") for (int m = 0; m < 4; ++m) _Pragma("unroll") for (int n = 0; n < 2; ++n) _Pragma("unroll") for (int k = 0; k < 2; ++k) \
        acc[ai][bj][m][n] = __builtin_amdgcn_mfma_f32_16x16x32_bf16(Bt[n][k], At[m][k], acc[ai][bj][m][n], 0, 0, 0); __builtin_amdgcn_s_setprio(0); } while (0)
#define PG8_WAIT_V(n) asm volatile("s_waitcnt vmcnt(" #n ")" ::: "memory")
#define PG8_WAIT_L(n) asm volatile("s_waitcnt lgkmcnt(" #n ")" ::: "memory")
#define PG8_BAR __builtin_amdgcn_s_barrier()
#define PG8_SCHED __builtin_amdgcn_sched_barrier(0)
    Unit cur, nxt; int ui = 0;
    if (!S.next(0, cur)) return;
    f32x4 acc[2][2][4][2];
#pragma unroll
    for (int a = 0; a < 2; ++a)
#pragma unroll
        for (int b = 0; b < 2; ++b)
#pragma unroll
            for (int m = 0; m < 4; ++m)
#pragma unroll
                for (int n = 0; n < 2; ++n) acc[a][b][m][n] = (f32x4){0.f, 0.f, 0.f, 0.f};
    bf16x8 At[4][2], B0[2][2], B1[2][2];
    const char* cA = cur.a; const char* cB = cur.b;
    PG8_STAGE(PG8_SB(0, 0), cB, voffB); PG8_STAGE(PG8_SB(0, 1), cB + hstepB, voffB); PG8_STAGE(PG8_SA(0, 0), cA, voffA); PG8_STAGE(PG8_SA(0, 1), cA + hstepA, voffA);
    if (wr == 1) PG8_BAR;
    PG8_WAIT_V(2); PG8_BAR;
    PG8_STAGE(PG8_SB(1, 0), cB + kstep, voffB); PG8_STAGE(PG8_SA(1, 0), cA + kstep, voffA); PG8_STAGE(PG8_SB(1, 1), cB + hstepB + kstep, voffB);
    PG8_WAIT_V(6); PG8_BAR;
    for (;;) {
        const bool has_next = S.next(ui + 1, nxt);
        const char* nA = has_next ? nxt.a : cA; const char* nB = has_next ? nxt.b : cB;
        const int nt = cur.nt;
#pragma unroll 1
        for (int t = 0; t < nt; t += 2) {
            const bool last = (t == nt - 2);
            const char* a1 = cA + (size_t)(t + 1) * kstep;
            const char* a2 = last ? nA : cA + (size_t)(t + 2) * kstep; const char* b2 = last ? nB : cB + (size_t)(t + 2) * kstep;
            const char* a3 = a2 + kstep; const char* b3 = b2 + kstep;
            PG8_LDB(B0, 0, 0); PG8_LDB(B1, 0, 1); PG8_SCHED; PG8_LDA(At, 0, 0); PG8_STAGE(PG8_SA(1, 1), a1 + hstepA, voffA);
            PG8_WAIT_V(8); PG8_WAIT_L(0); PG8_BAR; PG8_MMA(0, 0, At, B0); PG8_MMA(0, 1, At, B1); PG8_BAR; PG8_SCHED;
            PG8_LDA(At, 0, 1); PG8_STAGE(PG8_SB(0, 0), b2, voffB); PG8_STAGE(PG8_SB(0, 1), b2 + hstepB, voffB); PG8_STAGE(PG8_SA(0, 0), a2, voffA);
            PG8_WAIT_V(8); PG8_WAIT_L(0); PG8_BAR; PG8_MMA(1, 0, At, B0); PG8_MMA(1, 1, At, B1); PG8_BAR; PG8_SCHED;
            PG8_LDB(B0, 1, 0); PG8_LDB(B1, 1, 1); PG8_SCHED; PG8_LDA(At, 1, 0); PG8_STAGE(PG8_SA(0, 1), a2 + hstepA, voffA);
            PG8_WAIT_V(8); PG8_WAIT_L(0); PG8_BAR; PG8_MMA(0, 0, At, B0); PG8_MMA(0, 1, At, B1); PG8_BAR; PG8_SCHED;
            PG8_LDA(At, 1, 1); PG8_STAGE(PG8_SB(1, 0), b3, voffB); PG8_STAGE(PG8_SB(1, 1), b3 + hstepB, voffB); PG8_STAGE(PG8_SA(1, 0), a3, voffA);
            PG8_WAIT_V(8); PG8_WAIT_L(0); PG8_BAR; PG8_MMA(1, 0, At, B0); PG8_MMA(1, 1, At, B1); PG8_BAR; PG8_SCHED;
        }
        if (wr == 0) PG8_BAR;
        E(acc, cur, wr, wc, fr, fq);
        if (!has_next) break;
#pragma unroll
        for (int a = 0; a < 2; ++a)
#pragma unroll
            for (int b = 0; b < 2; ++b)
#pragma unroll
                for (int m = 0; m < 4; ++m)
#pragma unroll
                    for (int n = 0; n < 2; ++n) acc[a][b][m][n] = (f32x4){0.f, 0.f, 0.f, 0.f};
        cur = nxt; cA = nA; cB = nB; ++ui;
        if (wr == 1) PG8_BAR;
    }
    PG8_WAIT_V(0);
    PG8_BAR;
#undef PG8_SA
#undef PG8_SB
#undef PG8_STAGE
#undef PG8_LDA
#undef PG8_LDB
#undef PG8_MMA
#undef PG8_WAIT_V
#undef PG8_WAIT_L
#undef PG8_BAR
#undef PG8_SCHED
}
}

template <class Epi>
__device__ __forceinline__ void run_gemm(LAS unsigned char* lds, int K, int lda, int ldb, const void* A0, const void* B0, int nM0, int nN0, long apn0,
                                         const void* A1, const void* B1, int nM1, int nN1, const Epi& E, int S1 = 0, int pm1 = 0) {
    pg8::Sched S;
    S.nt0 = K / 64; S.S1 = S1; S.pm1 = pm1; S.nt1 = S1 ? K / 64 / S1 : 0; S.ksb = S1 ? (long)(K / S1) * 2 : 0;
    S.g0.A = (const char*)A0; S.g0.B = (const char*)B0; S.g0.nM = nM0; S.g0.nN = nN0; S.g0.a_pn_off = apn0;
    S.g1.A = (const char*)A1; S.g1.B = (const char*)B1; S.g1.nM = nM1; S.g1.nN = nN1; S.g1.a_pn_off = 0;
    S.n0 = nM0 * nN0; S.n1 = S1 ? S1 * nN1 : nM1 * nN1; S.G = gridDim.x; S.c = blockIdx.x;
    S.tstepA = (long)256 * lda * 2; S.tstepB = (long)256 * ldb * 2;
    pg8::gemm_phase<Epi>(lds, K, lda, ldb, S, E);
    __syncthreads();
}

__device__ __forceinline__ void transpose_item(const float* W, int ldw, bf16_t* WT, int ldo, LAS float* scr, int k0, int n0, int lane, const float* rs = nullptr) {
#pragma unroll 8
    for (int i = 0; i < 32; ++i) { const int kk = 2 * i + (lane >> 5); scr[kk * 33 + (lane & 31)] = W[(size_t)(k0 + kk) * ldw + n0 + (lane & 31)]; }
    asm volatile("s_waitcnt lgkmcnt(0)" ::: "memory");
    const int c = lane & 7;
#pragma unroll
    for (int j = 0; j < 4; ++j) { const int n = (lane >> 3) + 8 * j; const LAS float* s = scr + (8 * c) * 33 + n; const float m = rs ? rs[n0 + n] : 1.f;
        u32x4 o; o.x = pk2(s[0 * 33] * m, s[1 * 33] * m); o.y = pk2(s[2 * 33] * m, s[3 * 33] * m); o.z = pk2(s[4 * 33] * m, s[5 * 33] * m); o.w = pk2(s[6 * 33] * m, s[7 * 33] * m);
        *(u32x4*)(WT + (size_t)(n0 + n) * ldo + k0 + 8 * c) = o; }
    asm volatile("s_waitcnt lgkmcnt(0)" ::: "memory");
}
__device__ __forceinline__ void transpose_matrix(const float* W, int K, int N, bf16_t* WT, int ldo, LAS float* scr, int gw, int ngw, int lane, const float* rs = nullptr) {
    const int nblk = N / 32, nitems = (K / 64) * nblk;
    for (int it = gw; it < nitems; it += ngw) { const int kb = it / nblk, nb = it % nblk; transpose_item(W, N, WT, ldo, scr, kb * 64, nb * 32, lane, rs); }
}

__device__ __forceinline__ void phase_mod_partial(const DArgs& a, LAS unsigned char* lds) {
    LAS float* sil = (LAS float*)lds;
    for (int i = threadIdx.x; i < 9 * D; i += NTHR) { const int e = i / D, d = i % D; const float c = e == 0 ? a.in(I_CP)[d] : a.in(I_CS)[(e - 1) * D + d]; sil[i] = c / (1.f + __expf(-c)); }
    __syncthreads();
    const int wave = threadIdx.x >> 6, lane = threadIdx.x & 63, gw = blockIdx.x * NWAVE + wave, ngw = gridDim.x * NWAVE;
    float* part = (float*)(a.wsp() + W_MODPART);
    constexpr int NT = 6 * D / 256;
    constexpr int KR = D / KSPLIT;
    for (int it = gw; it < 2 * NT * KSPLIT; it += ngw) {
        const int ks = it % KSPLIT, nt = (it / KSPLIT) % NT, l = it / (KSPLIT * NT);
        const float* w = a.in(I_WADA) + (size_t)l * D * 6 * D + (size_t)(ks * KR) * 6 * D + nt * 256 + lane * 4;
        f32x4 acc[9];
#pragma unroll
        for (int e = 0; e < 9; ++e) acc[e] = (f32x4){0.f, 0.f, 0.f, 0.f};
#pragma unroll 4
        for (int d = 0; d < KR; ++d) {
            const f32x4 wv = *(const f32x4*)(w + (size_t)d * 6 * D);
#pragma unroll
            for (int e = 0; e < 9; ++e) { const float s = sil[e * D + ks * KR + d]; acc[e] += wv * s; }
        }
#pragma unroll
        for (int e = 0; e < 9; ++e) *(f32x4*)(part + ((size_t)(ks * 9 + e) * 2 + l) * 6 * D + nt * 256 + lane * 4) = acc[e];
    }
    __syncthreads();
}
enum { CV_OUT0 = 0, CV_QKV, CV_OUT1, CV_FF1_0, CV_FF2_0, CV_FF1_1, CV_FF2_1 };
__device__ __forceinline__ void convert_sub(const DArgs& a, LAS unsigned char* lds, int which, int c0) {
    if ((int)blockIdx.x < c0) return;
    const int wave = threadIdx.x >> 6, lane = threadIdx.x & 63, gw = ((int)blockIdx.x - c0) * NWAVE + wave, ngw = ((int)gridDim.x - c0) * NWAVE;
    LAS float* scr = (LAS float*)(lds + wave * 8448);
    unsigned char* w = a.wsp();
    switch (which) {
    case CV_OUT0: transpose_matrix(a.in(I_WOUT0), D, D, (bf16_t*)(w + W_OUT0T), D, scr, gw, ngw, lane); break;
    case CV_QKV: transpose_matrix(a.in(I_WQKV), D, 3 * D, (bf16_t*)(w + W_QKVT), D, scr, gw, ngw, lane); break;
    case CV_OUT1: transpose_matrix(a.in(I_WOUT1), D, D, (bf16_t*)(w + W_OUT1T), D, scr, gw, ngw, lane); break;
    case CV_FF1_0: transpose_matrix(a.in(I_WFF1), D, DFF, (bf16_t*)(w + W_FF1T), D, scr, gw, ngw, lane); break;
    case CV_FF2_0: transpose_matrix(a.in(I_WFF2), DFF, D, (bf16_t*)(w + W_FF2T), DFF, scr, gw, ngw, lane); break;
    case CV_FF1_1: transpose_matrix(a.in(I_WFF1) + (size_t)D * DFF, D, DFF, (bf16_t*)(w + W_FF1T), D, scr, gw, ngw, lane); break;
    default: transpose_matrix(a.in(I_WFF2) + (size_t)DFF * D, DFF, D, (bf16_t*)(w + W_FF2T), DFF, scr, gw, ngw, lane); break;
    }
}
__device__ __forceinline__ void phase_convert(const DArgs& a, LAS unsigned char* lds) {
    const int wave = threadIdx.x >> 6, lane = threadIdx.x & 63, gw = blockIdx.x * NWAVE + wave, ngw = gridDim.x * NWAVE;
    LAS float* scr = (LAS float*)(lds + wave * 8448);
    transpose_matrix(a.in(I_WIN0), D, DIN0, (bf16_t*)(a.wsp() + W_IN0T), D, scr, gw, ngw, lane);
    for (int g = 0; g < 4; ++g) transpose_matrix(a.in(I_WPOOL) + (size_t)g * 65536, 256, 256, (bf16_t*)(a.wsp() + W_POOLT) + (size_t)g * 65536, 256, scr, gw, ngw, lane, a.in(I_PSCALE) + g * 256);
    bf16_t* lt = (bf16_t*)(a.wsp() + W_LORAT);
    for (int i = blockIdx.x * NTHR + threadIdx.x; i < 3072 * 256; i += gridDim.x * NTHR) {
        const int row = i >> 8, k = i & 255, part = row >> 10, n = row & 1023; float v = 0.f;
        if (part == 0) { if (k < 64) v = a.in(I_W2)[k * 1024 + n]; }
        else if (part == 1) { if (k >= 64 && k < 128) v = a.in(I_A2)[(k - 64) * 1024 + n]; }
        else { if (k >= 128) v = a.in(I_G2)[(k - 128) * 1024 + n]; }
        lt[i] = f2bf(v);
    }
}
__device__ __forceinline__ void phase_mod_final(const DArgs& a) {
    const float* part = (const float*)(a.wsp() + W_MODPART); float* mod = (float*)(a.wsp() + W_MOD);
    for (int i = blockIdx.x * NTHR + threadIdx.x; i < 9 * 2 * 6 * D; i += gridDim.x * NTHR) {
        const int n = i % (6 * D), l = (i / (6 * D)) & 1;
        float s = a.in(I_BADA)[l * 6 * D + n];
#pragma unroll
        for (int ks = 0; ks < KSPLIT; ++ks) s += part[(size_t)ks * 9 * 2 * 6 * D + i];
        mod[i] = s;
    }
}
__device__ __forceinline__ void zero_oacc(const DArgs& a) {
    f32x4* p = (f32x4*)(a.wsp() + W_OACC);
    for (int i = blockIdx.x * NTHR + threadIdx.x; i < TS * D / 4; i += gridDim.x * NTHR) p[i] = (f32x4){0.f, 0.f, 0.f, 0.f};
}
template <bool XIN_INPUT, bool HAS_O, bool HAS_H>
__device__ __forceinline__ void phase_rowwise(const DArgs& a, const float* g_o, int l_gt, int gt_which, const float* g_h, int l_h, int sc_which, int sh_which, int nsl = 0) {
    const int wave = threadIdx.x >> 6, lane = threadIdx.x & 63, gw = blockIdx.x * NWAVE + wave, ngw = gridDim.x * NWAVE;
    const float* mod = (const float*)(a.wsp() + W_MOD);
    float* X = a.outp() + O_Y; const bf16_t* o = (const bf16_t*)(a.wsp() + W_O); bf16_t* hA = (bf16_t*)(a.wsp() + W_HA); const float* oacc = (const float*)(a.wsp() + W_OACC);
    f32x4 A2[HAS_H ? 8 : 1];
#pragma unroll
    for (int j = 0; j < 8; ++j) { const int c = 4 * (lane + 64 * j);
        if constexpr (HAS_H) { A2[j] = *(const f32x4*)(g_h + c) * (*(const f32x4*)(mod + (size_t)(0 * 2 + l_h) * 6 * D + sc_which * D + c) + 1.f); } }
    for (int row = gw; row < TA; row += ngw) {
        const int e = entry_of(row);
        const float* xin = XIN_INPUT ? (row < TP ? a.in(I_XP) + (size_t)row * D : a.in(I_XS) + (size_t)(row - TP) * D) : X + (size_t)row * D;
        f32x4 x[8];
#pragma unroll
        for (int j = 0; j < 8; ++j) x[j] = *(const f32x4*)(xin + 4 * (lane + 64 * j));
        if (HAS_O) {
            f32x4 ov[8]; float ss = 0.f;
            if (row < TP) {
#pragma unroll
                for (int j = 0; j < 8; ++j) { const u32x2 w = *(const u32x2*)(o + (size_t)row * D + 4 * (lane + 64 * j)); ov[j] = (f32x4){bflo(w.x), bfhi(w.x), bflo(w.y), bfhi(w.y)}; }
            } else {
#pragma unroll
                for (int j = 0; j < 8; ++j) ov[j] = (f32x4){0.f, 0.f, 0.f, 0.f};
#pragma unroll 2
                for (int sl = 0; sl < nsl; ++sl) {
#pragma unroll
                    for (int j = 0; j < 8; ++j) ov[j] += *(const f32x4*)(oacc + ((size_t)sl * TS + (row - TP)) * D + 4 * (lane + 64 * j));
                }
            }
#pragma unroll
            for (int j = 0; j < 8; ++j) ss += (ov[j].x * ov[j].x + ov[j].y * ov[j].y) + (ov[j].z * ov[j].z + ov[j].w * ov[j].w);
            const float rstd = rsqrtf(wave_sum(ss) * (1.f / D) + 1e-6f);
            const float* gt = mod + (size_t)(e * 2 + l_gt) * 6 * D + gt_which * D;
#pragma unroll
            for (int j = 0; j < 8; ++j) { const int c = 4 * (lane + 64 * j);
                const f32x4 ga = *(const f32x4*)(gt + c) * *(const f32x4*)(g_o + c);
                x[j] += ga * (ov[j] * rstd); *(f32x4*)(X + (size_t)row * D + c) = x[j]; }
        }
        if (HAS_H) {
            float ss = 0.f;
#pragma unroll
            for (int j = 0; j < 8; ++j) ss += (x[j].x * x[j].x + x[j].y * x[j].y) + (x[j].z * x[j].z + x[j].w * x[j].w);
            const float rstd = rsqrtf(wave_sum(ss) * (1.f / D) + 1e-6f);
            const float* sc = mod + (size_t)(e * 2 + l_h) * 6 * D + sc_which * D; const float* sh = mod + (size_t)(e * 2 + l_h) * 6 * D + sh_which * D;
#pragma unroll
            for (int j = 0; j < 8; ++j) { const int c = 4 * (lane + 64 * j);
                f32x4 gs; const f32x4 s0 = *(const f32x4*)(sh + c); if (row < TP) gs = A2[j]; else gs = *(const f32x4*)(g_h + c) * (*(const f32x4*)(sc + c) + 1.f);
                const f32x4 h = x[j] * rstd * gs + s0; u32x2 w; w.x = pk2(h.x, h.y); w.y = pk2(h.z, h.w);
                *(u32x2*)(hA + (size_t)row * D + c) = w; }
        }
    }
}
__device__ __forceinline__ void ld8bf(const bf16_t* p, float (&v)[8]) { const u32x4 w = *(const u32x4*)p; v[0] = bflo(w.x); v[1] = bfhi(w.x); v[2] = bflo(w.y); v[3] = bfhi(w.y); v[4] = bflo(w.z); v[5] = bfhi(w.z); v[6] = bflo(w.w); v[7] = bfhi(w.w); }
__device__ __forceinline__ void ld8f(const float* p, float (&v)[8]) { const f32x4 a = *(const f32x4*)p, b = *(const f32x4*)(p + 4); v[0] = a.x; v[1] = a.y; v[2] = a.z; v[3] = a.w; v[4] = b.x; v[5] = b.y; v[6] = b.z; v[7] = b.w; }
__device__ __forceinline__ void st8bf(bf16_t* p, const float (&v)[8]) { u32x4 w; w.x = pk2(v[0], v[1]); w.y = pk2(v[2], v[3]); w.z = pk2(v[4], v[5]); w.w = pk2(v[6], v[7]); *(u32x4*)p = w; }
template <int WIN> __device__ __forceinline__ void pool_sum(const bf16_t* p, float (&s)[8], float (&u)[8]) {
    u32x4 w[WIN];
#pragma unroll
    for (int sf = 0; sf < WIN; ++sf) w[sf] = *(const u32x4*)(p - (size_t)sf * DIN0);
    u[0] = bflo(w[0].x); u[1] = bfhi(w[0].x); u[2] = bflo(w[0].y); u[3] = bfhi(w[0].y); u[4] = bflo(w[0].z); u[5] = bfhi(w[0].z); u[6] = bflo(w[0].w); u[7] = bfhi(w[0].w);
#pragma unroll
    for (int i = 0; i < 8; ++i) s[i] = u[i];
#pragma unroll
    for (int sf = 1; sf < WIN; ++sf) { s[0] += bflo(w[sf].x); s[1] += bfhi(w[sf].x); s[2] += bflo(w[sf].y); s[3] += bfhi(w[sf].y); s[4] += bflo(w[sf].z); s[5] += bfhi(w[sf].z); s[6] += bflo(w[sf].w); s[7] += bfhi(w[sf].w); }
}
__device__ __forceinline__ void phase_prep(const DArgs& a) {
    const bf16_t* P = (const bf16_t*)(a.wsp() + W_P); bf16_t* AL = (bf16_t*)(a.wsp() + W_AL);
    const int gt = blockIdx.x * NTHR + threadIdx.x, ngt = gridDim.x * NTHR;
    for (int idx = gt; idx < TA * 160; idx += ngt) {
        const int row = idx / 160, it = idx % 160; const bool prompt = row < TP; const int t = prompt ? row : ((row - TP) & 31), b = prompt ? 0 : ((row - TP) >> 5);
        if (it < 128) {
            const int c0 = it * 8, gi = c0 >> 8, win = 2 << gi;
            float s[8], u[8], v[8];
            if (t >= win - 1) {
                const bf16_t* p = P + (size_t)row * DIN0 + c0;
                if (gi == 0) pool_sum<2>(p, s, u); else if (gi == 1) pool_sum<4>(p, s, u); else if (gi == 2) pool_sum<8>(p, s, u); else pool_sum<16>(p, s, u);
                const float inv = 1.f / (float)win;
#pragma unroll
                for (int i = 0; i < 8; ++i) s[i] = s[i] * inv - u[i];
            } else {
#pragma unroll
                for (int i = 0; i < 8; ++i) s[i] = 0.f;
                for (int sf = 0; sf < win; ++sf) { const int tt = t - sf;
                    if (tt >= 0) { ld8bf(P + (size_t)(row - sf) * DIN0 + c0, v);
#pragma unroll
                        for (int i = 0; i < 8; ++i) s[i] += v[i]; }
                    else if (!prompt) { ld8f(a.in(I_SPOOL) + ((size_t)b * 15 + (15 + tt)) * DPOOL + c0, v);
#pragma unroll
                        for (int i = 0; i < 8; ++i) s[i] += v[i]; } }
                const float cnt = prompt ? (float)min(win, t + 1) : (float)win, inv = 1.f / cnt;
                ld8bf(P + (size_t)row * DIN0 + c0, u);
#pragma unroll
                for (int i = 0; i < 8; ++i) s[i] = s[i] * inv - u[i];
            }
            st8bf(AL + (size_t)row * 1280 + c0, s);
        } else {
            const int q0 = (it - 128) * 8, e0 = 3072 + q0;
            float z[8], zp[8], mu[8];
            ld8bf(P + (size_t)row * DIN0 + DPOOL + e0, z);
            if (t > 0) ld8bf(P + (size_t)(row - 1) * DIN0 + DPOOL + e0, zp);
            else if (!prompt) ld8f(a.in(I_SSHIFT) + (size_t)b * DSHIFT + e0, zp);
            else {
#pragma unroll
                for (int i = 0; i < 8; ++i) zp[i] = 0.f; }
            ld8f(a.in(I_MU) + e0, mu);
#pragma unroll
            for (int i = 0; i < 8; ++i) { const float zs = z[i] + (zp[i] - z[i]) * mu[i];
                z[i] = q0 < 64 ? 1.f - 2.f / (1.f + __expf(2.f * zs)) : (q0 < 128 ? zs : sigmoidf_(zs)); }
            st8bf(AL + (size_t)row * 1280 + 1024 + q0, z);
        }
    }
    for (int i = gt; i < 15 * DPOOL; i += ngt) a.outp()[O_POOLP + i] = bf2f(P[(size_t)(TP - 15 + i / DPOOL) * DIN0 + (i % DPOOL)]);
    for (int i = gt; i < 8 * 15 * DPOOL; i += ngt) { const int b = i / (15 * DPOOL), r = (i / DPOOL) % 15, c = i % DPOOL; a.outp()[O_POOLS + i] = bf2f(P[(size_t)(TP + b * 32 + 17 + r) * DIN0 + c]); }
    for (int i = gt; i < DSHIFT; i += ngt) a.outp()[O_SHIFTP + i] = bf2f(P[(size_t)(TP - 1) * DIN0 + DPOOL + i]);
    for (int i = gt; i < 8 * DSHIFT; i += ngt) { const int b = i / DSHIFT, e = i % DSHIFT; a.outp()[O_SHIFTS + i] = bf2f(P[(size_t)(TP + b * 32 + 31) * DIN0 + DPOOL + e]); }
}

struct ScanConst { float mu_r, mu_k, mu_v, w0, a0, kkc, kac, rk, lnw, lnb; };
struct ScanRaw { bf16_t zr, zk, zv; float lw, la, lg; };
template <bool NEEDG> __device__ __forceinline__ ScanRaw scan_load(const bf16_t* P, const float* L, int row, int c) {
    ScanRaw r; const bf16_t* p = P + (size_t)row * DIN0 + DPOOL + c; r.zr = p[0]; r.zk = p[1024]; r.zv = p[2048];
    const float* l = L + (size_t)row * 3072 + c; r.lw = l[0]; r.la = l[1024]; r.lg = NEEDG ? l[2048] : 0.f; return r;
}
template <int MODE>
__device__ __forceinline__ void scan_item(const DArgs& a, LAS float* W  , int row0, int nsteps, int h, int lane, bool first_is_start, const float* shift_prev  ,
                                          const float* S_init  , float* S_final  , float* Uout, float* Pout) {
    const bf16_t* P = (const bf16_t*)(a.wsp() + W_P); const float* L = (const float*)(a.wsp() + W_L); bf16_t* mix = (bf16_t*)(a.wsp() + W_MIX);
    const int c = h * 64 + lane, ib = lane >> 4, il = lane & 15;
    ScanConst k; k.mu_r = a.in(I_MU)[c]; k.mu_k = a.in(I_MU)[1024 + c]; k.mu_v = a.in(I_MU)[2048 + c]; k.w0 = a.in(I_W0)[c]; k.a0 = a.in(I_A0)[c];
    k.kkc = a.in(I_KK)[c]; k.kac = a.in(I_KA)[c]; k.rk = a.in(I_RK)[c]; k.lnw = a.in(I_LNW)[c]; k.lnb = a.in(I_LNB)[c];
    float zr_p, zk_p, zv_p;
    if (!first_is_start) { const bf16_t* p = P + (size_t)(row0 - 1) * DIN0 + DPOOL + c; zr_p = bf2f(p[0]); zk_p = bf2f(p[1024]); zv_p = bf2f(p[2048]); }
    else if (shift_prev) { zr_p = shift_prev[c]; zk_p = shift_prev[1024 + c]; zv_p = shift_prev[2048 + c]; }
    else { zr_p = 0.f; zk_p = 0.f; zv_p = 0.f; }
    f32x2 S[4][8];
    if constexpr (MODE == 1) {
#pragma unroll
        for (int q = 0; q < 4; ++q)
#pragma unroll
            for (int m = 0; m < 4; ++m) { const f32x4 v = *(const f32x4*)(S_init + (il + 16 * q) * 64 + 16 * ib + 4 * m); S[q][2 * m] = (f32x2){v.x, v.y}; S[q][2 * m + 1] = (f32x2){v.z, v.w}; }
    } else {
#pragma unroll
        for (int q = 0; q < 4; ++q)
#pragma unroll
            for (int p = 0; p < 8; ++p) S[q][p] = MODE == 2 ? (f32x2){(q == ib && 2 * p == il) ? 1.f : 0.f, (q == ib && 2 * p + 1 == il) ? 1.f : 0.f} : (f32x2){0.f, 0.f};
    }
#define LDV(dst_, vec_) { _Pragma("unroll") for (int m = 0; m < 4; ++m) { const f32x4 t_ = *(const LAS f32x4*)(W + (vec_) * 64 + 16 * ib + 4 * m); dst_[2 * m] = (f32x2){t_.x, t_.y}; dst_[2 * m + 1] = (f32x2){t_.z, t_.w}; } }
#define XSUM(x_) { const u32x2 s16_ = __builtin_amdgcn_permlane16_swap(__float_as_uint(x_), __float_as_uint(x_), false, false); x_ = __uint_as_float(s16_.x) + __uint_as_float(s16_.y); \
                   const u32x2 s32_ = __builtin_amdgcn_permlane32_swap(__float_as_uint(x_), __float_as_uint(x_), false, false); x_ = __uint_as_float(s32_.x) + __uint_as_float(s32_.y); }
    struct Prep { float an, dec, bn, kmod, r, v, lg, bin; };
    auto prep = [&](const ScanRaw& rw) -> Prep {
        Prep o; const float zr = bf2f(rw.zr), zk = bf2f(rw.zk), zv = bf2f(rw.zv);
        const float r = zr + (zr_p - zr) * k.mu_r, kx = zk + (zk_p - zk) * k.mu_k; o.v = zv + (zv_p - zv) * k.mu_v;
        zr_p = zr; zk_p = zk; zv_p = zv;
        o.dec = __expf(-0.60653066f * sigmoidf_(k.w0 + rw.lw));
        const float ai = sigmoidf_(k.a0 + rw.la);
        const float kkr = kx * k.kkc, ssq = wave_sum(kkr * kkr), kk = kkr * rsqrtf(fmaxf(ssq, 1e-24f));
        o.kmod = kx * (1.f + (ai - 1.f) * k.kac); o.an = -kk; o.bn = kk * ai; o.r = r; o.lg = rw.lg; o.bin = r * o.kmod * k.rk; return o; };
    auto post = [&](float y, float bin, float v, float lg, int row, bool doit) {
        const float mean = wave_sum(y) * (1.f / 64.f), dy = y - mean, var = wave_sum(dy * dy) * (1.f / 64.f);
        const float yn = dy * rsqrtf(var + 64e-5f) * k.lnw + k.lnb;
        const float bonus = wave_sum(bin) * v;
        if (doit) mix[(size_t)row * D + 1024 + c] = f2bf((yn + bonus) * lg); };
    ScanRaw raw1 = scan_load<MODE == 1>(P, L, row0 + (nsteps > 1 ? 1 : 0), c);
    Prep pv = prep(scan_load<MODE == 1>(P, L, row0, c));
    float yp = 0.f, binp = 0.f, vp = 0.f, lgp = 0.f;
    for (int t = 0; t < nsteps; ++t) {
        const int row = row0 + t;
        const ScanRaw raw2 = scan_load<MODE == 1>(P, L, row0 + (t + 2 < nsteps ? t + 2 : nsteps - 1), c);
        W[lane] = pv.an; W[64 + lane] = pv.dec; W[128 + lane] = pv.bn; if constexpr (MODE != 2) { W[192 + lane] = pv.kmod; W[320 + lane] = pv.v; } if constexpr (MODE == 1) W[256 + lane] = pv.r;
        const Prep pn = prep(raw1);
        constexpr int NS = 2, PW = 8 / NS;
        float sa[4];
#pragma unroll
        for (int q = 0; q < 4; ++q) sa[q] = 0.f;
#pragma unroll
        for (int hf = 0; hf < NS; ++hf) {
            f32x2 av[PW];
#pragma unroll
            for (int m = 0; m < PW / 2; ++m) { const f32x4 t0 = *(const LAS f32x4*)(W + 16 * ib + 2 * PW * hf + 4 * m); av[2 * m] = (f32x2){t0.x, t0.y}; av[2 * m + 1] = (f32x2){t0.z, t0.w}; }
#pragma unroll
            for (int q = 0; q < 4; ++q) {
                f32x2 d = S[q][PW * hf] * av[0];
#pragma unroll
                for (int p = 1; p < PW; ++p) d += S[q][PW * hf + p] * av[p];
                sa[q] += d.x + d.y;
            }
        }
#pragma unroll
        for (int q = 0; q < 4; ++q) { XSUM(sa[q]) }
        float vq[4];
#pragma unroll
        for (int q = 0; q < 4; ++q) vq[q] = MODE == 2 ? 0.f : W[320 + il + 16 * q];
#pragma unroll
        for (int hf = 0; hf < NS; ++hf) {
            f32x2 wv[PW], bv[PW], kv[PW];
#pragma unroll
            for (int m = 0; m < PW / 2; ++m) { const int o_ = 16 * ib + 2 * PW * hf + 4 * m; const f32x4 t0 = *(const LAS f32x4*)(W + 64 + o_), t1 = *(const LAS f32x4*)(W + 128 + o_), t2 = MODE == 2 ? t1 : *(const LAS f32x4*)(W + 192 + o_);
                wv[2 * m] = (f32x2){t0.x, t0.y}; wv[2 * m + 1] = (f32x2){t0.z, t0.w}; bv[2 * m] = (f32x2){t1.x, t1.y}; bv[2 * m + 1] = (f32x2){t1.z, t1.w}; kv[2 * m] = (f32x2){t2.x, t2.y}; kv[2 * m + 1] = (f32x2){t2.z, t2.w}; }
#pragma unroll
            for (int q = 0; q < 4; ++q) {
                const f32x2 sa2 = (f32x2){sa[q], sa[q]}, v2 = (f32x2){vq[q], vq[q]};
#pragma unroll
                for (int p = 0; p < PW; ++p) { if constexpr (MODE == 2) S[q][PW * hf + p] = S[q][PW * hf + p] * wv[p] + sa2 * bv[p]; else S[q][PW * hf + p] = S[q][PW * hf + p] * wv[p] + (sa2 * bv[p] + v2 * kv[p]); }
            }
        }
        if constexpr (MODE == 1) {
            f32x2 rv[8];
            LDV(rv, 4)
            float yq[4];
#pragma unroll
            for (int q = 0; q < 4; ++q) { f32x2 d = S[q][0] * rv[0];
#pragma unroll
                for (int p = 1; p < 8; ++p) d += S[q][p] * rv[p];
                yq[q] = d.x + d.y; }
            const u32x2 s02 = __builtin_amdgcn_permlane32_swap(__float_as_uint(yq[0]), __float_as_uint(yq[2]), false, false);
            const u32x2 s13 = __builtin_amdgcn_permlane32_swap(__float_as_uint(yq[1]), __float_as_uint(yq[3]), false, false);
            const float r02 = __uint_as_float(s02.x) + __uint_as_float(s02.y), r13 = __uint_as_float(s13.x) + __uint_as_float(s13.y);
            const u32x2 sy = __builtin_amdgcn_permlane16_swap(__float_as_uint(r02), __float_as_uint(r13), false, false);
            const float y = __uint_as_float(sy.x) + __uint_as_float(sy.y);
            post(yp, binp, vp, lgp, row - 1, t > 0);
            yp = y; binp = pv.bin; vp = pv.v; lgp = pv.lg;
        }
        pv = pn; raw1 = raw2;
    }
    if constexpr (MODE == 1) post(yp, binp, vp, lgp, row0 + nsteps - 1, true);
#undef LDV
#undef XSUM
    if constexpr (MODE == 1) {
        if (S_final) {
#pragma unroll
            for (int q = 0; q < 4; ++q)
#pragma unroll
                for (int m = 0; m < 4; ++m) *(f32x4*)(S_final + (il + 16 * q) * 64 + 16 * ib + 4 * m) = (f32x4){S[q][2 * m].x, S[q][2 * m].y, S[q][2 * m + 1].x, S[q][2 * m + 1].y};
        }
    } else {
        float* dst = MODE == 0 ? Uout : Pout;
#pragma unroll
        for (int q = 0; q < 4; ++q)
#pragma unroll
            for (int m = 0; m < 4; ++m) *(f32x4*)(dst + (il + 16 * q) * 64 + 16 * ib + 4 * m) = (f32x4){S[q][2 * m].x, S[q][2 * m].y, S[q][2 * m + 1].x, S[q][2 * m + 1].y};
    }
}
__device__ __forceinline__ void phase_scan_a(const DArgs& a, LAS unsigned char* lds) {
    const int wave = threadIdx.x >> 6, lane = threadIdx.x & 63, gw = blockIdx.x * NWAVE + wave, ngw = gridDim.x * NWAVE;
    LAS float* W = (LAS float*)(lds + 8192 + wave * 2048);
    for (int it = gw; it < NCHK * 16; it += ngw) { const int ch = it >> 4, h = it & 15;
        scan_item<0>(a, W, ch * CHK, CHK, h, lane, ch == 0, nullptr, nullptr, nullptr, (float*)(a.wsp() + W_UC) + (size_t)it * 4096, nullptr);
        scan_item<2>(a, W, ch * CHK, CHK, h, lane, ch == 0, nullptr, nullptr, nullptr, nullptr, (float*)(a.wsp() + W_PC) + (size_t)it * 4096); }
}
__device__ __forceinline__ void phase_scan_c(const DArgs& a, LAS unsigned char* lds) {
    const int wave = threadIdx.x >> 6, lane = threadIdx.x & 63, gw = blockIdx.x * NWAVE + wave, ngw = gridDim.x * NWAVE;
    for (int it = gw; it < NCHK * 16; it += ngw) { const int ch = it >> 4, h = it & 15;
        scan_item<1>(a, (LAS float*)(lds + 8192 + wave * 2048), ch * CHK, CHK, h, lane, ch == 0, nullptr, (const float*)(a.wsp() + W_SST) + (size_t)it * 4096, nullptr, nullptr, nullptr); }
}
__device__ __forceinline__ void phase_scan_b(const DArgs& a, LAS unsigned char* lds) {
    const int wave = threadIdx.x >> 6, lane = threadIdx.x & 63;
    if (blockIdx.x < 64) {
        const int h = blockIdx.x >> 2, rg = blockIdx.x & 3, fr = lane & 15, g = lane >> 4;
        LAS float* Sb = (LAS float*)lds;
        const float* Pc = (const float*)(a.wsp() + W_PC); const float* Uc = (const float*)(a.wsp() + W_UC); float* Sst = (float*)(a.wsp() + W_SST);
        for (int i = threadIdx.x; i < 16 * 68; i += NTHR) Sb[i] = 0.f;
        if (wave < 4) {
#pragma unroll
            for (int r = 0; r < 4; ++r) Sst[(size_t)h * 4096 + (rg * 16 + 4 * g + r) * 64 + 16 * wave + fr] = 0.f;
        }
        float bq[16], uq[4];
        if (wave < 4) { const float* pc = Pc + (size_t)h * 4096; const float* uc = Uc + (size_t)h * 4096;
#pragma unroll
            for (int ks = 0; ks < 16; ++ks) bq[ks] = pc[(16 * g + ks) * 64 + 16 * wave + fr];
#pragma unroll
            for (int r = 0; r < 4; ++r) uq[r] = uc[(rg * 16 + 4 * g + r) * 64 + 16 * wave + fr]; }
        __syncthreads();
        for (int ch = 0; ch < NCHK; ++ch) {
            f32x4 acc0, acc1 = (f32x4){0.f, 0.f, 0.f, 0.f};
            if (wave < 4) {
                float bn[16], un[4];
                const int chn = ch + 1 < NCHK ? ch + 1 : ch;
                const float* pc = Pc + ((size_t)chn * 16 + h) * 4096; const float* uc = Uc + ((size_t)chn * 16 + h) * 4096;
#pragma unroll
                for (int ks = 0; ks < 16; ++ks) bn[ks] = pc[(16 * g + ks) * 64 + 16 * wave + fr];
#pragma unroll
                for (int r = 0; r < 4; ++r) un[r] = uc[(rg * 16 + 4 * g + r) * 64 + 16 * wave + fr];
                float aq[16];
#pragma unroll
                for (int q = 0; q < 4; ++q) { const f32x4 v = *(const LAS f32x4*)(Sb + fr * 68 + 16 * g + 4 * q); aq[4 * q] = v.x; aq[4 * q + 1] = v.y; aq[4 * q + 2] = v.z; aq[4 * q + 3] = v.w; }
                acc0 = (f32x4){uq[0], uq[1], uq[2], uq[3]};
#pragma unroll
                for (int ks = 0; ks < 16; ks += 2) { acc0 = __builtin_amdgcn_mfma_f32_16x16x4f32(aq[ks], bq[ks], acc0, 0, 0, 0); acc1 = __builtin_amdgcn_mfma_f32_16x16x4f32(aq[ks + 1], bq[ks + 1], acc1, 0, 0, 0); }
                acc0 += acc1;
#pragma unroll
                for (int ks = 0; ks < 16; ++ks) bq[ks] = bn[ks];
#pragma unroll
                for (int r = 0; r < 4; ++r) uq[r] = un[r];
            }
            __syncthreads();
            if (wave < 4) {
                float* dst = ch + 1 < NCHK ? Sst + ((size_t)(ch + 1) * 16 + h) * 4096 : a.outp() + O_WKVP + (size_t)h * 4096;
#pragma unroll
                for (int r = 0; r < 4; ++r) { Sb[(4 * g + r) * 68 + 16 * wave + fr] = acc0[r]; dst[(rg * 16 + 4 * g + r) * 64 + 16 * wave + fr] = acc0[r]; }
            }
            __syncthreads();
        }
    } else {
        const int it = (blockIdx.x - 64) * NWAVE + wave;
        if (it < 128) { const int b = it >> 4, h = it & 15;
            scan_item<1>(a, (LAS float*)(lds + 8192 + wave * 2048), TP + b * 32, 32, h, lane, true, a.in(I_SSHIFT) + (size_t)b * DSHIFT, a.in(I_SWKV) + ((size_t)b * 16 + h) * 4096,
                         a.outp() + O_WKVS + ((size_t)b * 16 + h) * 4096, nullptr, nullptr); }
    }
}

__device__ __forceinline__ void phase_attn_prep(const DArgs& a, LAS unsigned char* lds) {
    const int wave = threadIdx.x >> 6, lane = threadIdx.x & 63, gw = blockIdx.x * NWAVE + wave, ngw = gridDim.x * NWAVE;
    const int gt = blockIdx.x * NTHR + threadIdx.x, ngt = gridDim.x * NTHR;
    const bf16_t* qk = (const bf16_t*)(a.wsp() + W_QK); const bf16_t* vT = (const bf16_t*)(a.wsp() + W_VT);
    bf16_t* Ks = (bf16_t*)(a.wsp() + W_KS); bf16_t* VsT = (bf16_t*)(a.wsp() + W_VST);
    for (int i = gt; i < 8 * 576 * 256; i += ngt) {
        const int c8 = i & 255, kk = (i >> 8) % 576, b = i / (576 * 256);
        u32x4 w = (u32x4){0u, 0u, 0u, 0u};
        if (kk < 512) { float v[8]; ld8f(a.in(I_CK) + ((size_t)b * 512 + kk) * D + c8 * 8, v); w.x = pk2(v[0], v[1]); w.y = pk2(v[2], v[3]); w.z = pk2(v[4], v[5]); w.w = pk2(v[6], v[7]); }
        else if (kk < 544) w = *(const u32x4*)(qk + (size_t)(TP + b * 32 + kk - 512) * 4096 + 2048 + c8 * 8);
        *(u32x4*)(Ks + ((size_t)b * 576 + kk) * D + c8 * 8) = w;
    }
    LAS float* scr = (LAS float*)(lds + wave * 8448);
    for (int it = gw; it < 8 * 512; it += ngw) { const int b = it >> 9, r = it & 511, kb = r >> 6, nb = r & 63;
        transpose_item(a.in(I_CV) + (size_t)b * 512 * D, D, VsT + (size_t)b * D * 576, 576, scr, kb * 64, nb * 32, lane); }
    for (int i = gt; i < 8 * D * 8; i += ngt) {
        const int g8 = i & 7, c = (i >> 3) & (D - 1), b = i >> 14;
        u32x4 w = (u32x4){0u, 0u, 0u, 0u};
        if (g8 < 4) w = *(const u32x4*)(vT + (size_t)c * TA + TP + b * 32 + g8 * 8);
        *(u32x4*)(VsT + ((size_t)b * D + c) * 576 + 512 + g8 * 8) = w;
    }
    for (int i = gt; i < 512 * D; i += ngt) { const int r = i >> 11, c = i & (D - 1);
        a.outp()[O_KP + i] = bf2f(qk[(size_t)(TP - 512 + r) * 4096 + 2048 + c]); a.outp()[O_VP + i] = bf2f(vT[(size_t)c * TA + TP - 512 + r]); }
    for (int i = gt; i < TS * D; i += ngt) { const int r = i >> 11, c = i & (D - 1);
        a.outp()[O_KS + i] = bf2f(qk[(size_t)(TP + r) * 4096 + 2048 + c]); a.outp()[O_VS + i] = bf2f(vT[(size_t)c * TA + TP + r]); }
}
constexpr int KT_LD = 272, VT_LD = 144;
constexpr int A_K = 0, A_V = 64 * KT_LD, A_B = A_V + 128 * VT_LD;
__device__ __forceinline__ void phase_attn(const DArgs& a, LAS unsigned char* lds) {
    const int tid = threadIdx.x, wave = tid >> 6, lane = tid & 63, fr = lane & 15, g = lane >> 4;
    const bf16_t* qk = (const bf16_t*)(a.wsp() + W_QK); const bf16_t* vT = (const bf16_t*)(a.wsp() + W_VT);
    const bf16_t* Ks = (const bf16_t*)(a.wsp() + W_KS); const bf16_t* VsT = (const bf16_t*)(a.wsp() + W_VST);
    const float* relb = a.in(I_RELB);
    bf16_t* oatt = (bf16_t*)(a.wsp() + W_MIX);
    LAS float* biasT = (LAS float*)(lds + A_B);
    const float scale = 0.08838834764831845f;
    constexpr int NITEMS = 2048 + 128;
    struct Item { int h, qrow, qpos, tile_lo, tile_hi, qc, nkeys, ldk, ldv, kpos_base; const bf16_t* Kb; const bf16_t* Vb; bool wact, prompt; };
    auto setup = [&](int it) -> Item { Item I; I.prompt = it < 2048; I.qc = 0;
        if (I.prompt) { const int pi = it >> 4; I.h = it & 15; I.qc = 2 * pi + (wave >> 2); I.qrow = I.qc * 64 + (wave & 3) * 16 + fr; I.qpos = I.qrow;
            I.tile_lo = 2 * pi - 8 < 0 ? 0 : 2 * pi - 8; I.tile_hi = 2 * pi + 1; I.nkeys = 1 << 30; I.ldk = 4096; I.ldv = TA; I.kpos_base = 0;
            I.Kb = qk + 2048 + I.h * 128; I.Vb = vT + (size_t)(I.h * 128) * TA; I.wact = true; }
        else { const int s_ = it - 2048, b = s_ >> 4; I.h = s_ & 15; const int w2 = wave & 1; I.qrow = TP + b * 32 + w2 * 16 + fr; I.qpos = 2048 + w2 * 16 + fr;
            I.tile_lo = 0; I.tile_hi = 8; I.nkeys = 544; I.ldk = D; I.ldv = 576; I.kpos_base = 1536;
            I.Kb = Ks + (size_t)b * 576 * D + I.h * 128; I.Vb = VsT + ((size_t)b * D + I.h * 128) * 576; I.wact = wave < 2; }
        return I; };
    u32x4 kreg[2], vreg[2];
    const int kr = tid >> 4, kc = tid & 15, vr = tid >> 3, vc = tid & 7;
#define ATT_LOAD(I_, tile) do { _Pragma("unroll") for (int p_ = 0; p_ < 2; ++p_) { \
        kreg[p_] = *(const u32x4*)((I_).Kb + (size_t)((tile) * 64 + kr + 32 * p_) * (I_).ldk + kc * 8); \
        vreg[p_] = *(const u32x4*)((I_).Vb + (size_t)(vr + 64 * p_) * (I_).ldv + (tile) * 64 + vc * 8); } } while (0)
#define ATT_STORE() do { _Pragma("unroll") for (int p_ = 0; p_ < 2; ++p_) { \
        *(LAS u32x4*)(lds + A_K + (kr + 32 * p_) * KT_LD + kc * 16) = kreg[p_]; \
        *(LAS u32x4*)(lds + A_V + (vr + 64 * p_) * VT_LD + vc * 16) = vreg[p_]; } } while (0)
#define ATT_LOADQ(dst_, I_) do { _Pragma("unroll") for (int ks = 0; ks < 4; ++ks) dst_[ks] = *(const bf16x8*)(qk + (size_t)(I_).qrow * 4096 + (I_).h * 128 + 32 * ks + 8 * g); } while (0)
    if ((int)blockIdx.x >= NITEMS) return;
    Item cur = setup(blockIdx.x);
    bf16x8 qf[4], qfn[4];
    float biasn = tid < 257 ? relb[cur.h * 257 + tid] : 0.f;
    ATT_LOADQ(qf, cur);
    ATT_LOAD(cur, cur.tile_lo);
    for (int it = blockIdx.x; it < NITEMS; it += gridDim.x) {
        const bool has_next = it + (int)gridDim.x < NITEMS;
        const Item nxt = setup(has_next ? it + (int)gridDim.x : it);
        f32x4 oacc[8];
#pragma unroll
        for (int n = 0; n < 8; ++n) oacc[n] = (f32x4){0.f, 0.f, 0.f, 0.f};
        float mrun = -1e30f, lrun = 0.f;
        __syncthreads();
        ATT_STORE();
        if (tid < 257) biasT[tid] = biasn;
        __syncthreads();
        for (int tile = cur.tile_lo; tile <= cur.tile_hi; ++tile) {
            if (tile < cur.tile_hi) ATT_LOAD(cur, tile + 1);
            else if (has_next) { ATT_LOAD(nxt, nxt.tile_lo); ATT_LOADQ(qfn, nxt); biasn = tid < 257 ? relb[nxt.h * 257 + tid] : 0.f; }
            const bool act = cur.wact && (!cur.prompt || (tile >= cur.qc - 8 && tile <= cur.qc));
            if (act) {
                f32x4 sacc[4];
#pragma unroll
                for (int kt = 0; kt < 4; ++kt) { sacc[kt] = (f32x4){0.f, 0.f, 0.f, 0.f};
#pragma unroll
                    for (int ks = 0; ks < 4; ++ks) { const bf16x8 kf = *(const LAS bf16x8*)(lds + A_K + (16 * kt + fr) * KT_LD + (32 * ks + 8 * g) * 2);
                        sacc[kt] = __builtin_amdgcn_mfma_f32_16x16x32_bf16(kf, qf[ks], sacc[kt], 0, 0, 0); } }
                const int kpos0 = cur.kpos_base + tile * 64, kidx0 = tile * 64;
                float tmax = -1e30f;
#pragma unroll
                for (int kt = 0; kt < 4; ++kt)
#pragma unroll
                    for (int r = 0; r < 4; ++r) { const int key = 16 * kt + 4 * g + r; float bias;
                        { int rel = cur.qpos - (kpos0 + key); rel = rel < -128 ? -128 : (rel > 128 ? 128 : rel); bias = biasT[rel + 128]; }
                        float s_ = sacc[kt][r] * scale + bias; if (kidx0 + key >= cur.nkeys) s_ = -1e30f; sacc[kt][r] = s_; tmax = fmaxf(tmax, s_); }
                tmax = fmaxf(tmax, __shfl_xor(tmax, 16)); tmax = fmaxf(tmax, __shfl_xor(tmax, 32));
                const float mnew = fmaxf(mrun, tmax), alpha = __expf(mrun - mnew); mrun = mnew;
                float psum = 0.f;
#pragma unroll
                for (int kt = 0; kt < 4; ++kt)
#pragma unroll
                    for (int r = 0; r < 4; ++r) { const float p_ = __expf(sacc[kt][r] - mnew); sacc[kt][r] = p_; psum += p_; }
                lrun = lrun * alpha + psum;
#pragma unroll
                for (int n = 0; n < 8; ++n) oacc[n] = oacc[n] * alpha;
#pragma unroll
                for (int j = 0; j < 2; ++j) {
                    u32x4 pw; pw.x = pk2(sacc[2 * j][0], sacc[2 * j][1]); pw.y = pk2(sacc[2 * j][2], sacc[2 * j][3]); pw.z = pk2(sacc[2 * j + 1][0], sacc[2 * j + 1][1]); pw.w = pk2(sacc[2 * j + 1][2], sacc[2 * j + 1][3]);
                    const bf16x8 pf = __builtin_bit_cast(bf16x8, pw);
#pragma unroll
                    for (int n = 0; n < 8; ++n) {
                        const u32x2 v0 = *(const LAS u32x2*)(lds + A_V + (16 * n + fr) * VT_LD + (32 * j + 4 * g) * 2);
                        const u32x2 v1 = *(const LAS u32x2*)(lds + A_V + (16 * n + fr) * VT_LD + (32 * j + 16 + 4 * g) * 2);
                        const bf16x8 vf = __builtin_bit_cast(bf16x8, (u32x4){v0.x, v0.y, v1.x, v1.y});
                        oacc[n] = __builtin_amdgcn_mfma_f32_16x16x32_bf16(vf, pf, oacc[n], 0, 0, 0);
                    }
                }
            }
            if (tile < cur.tile_hi) { __syncthreads(); ATT_STORE(); __syncthreads(); }
        }
        if (cur.wact) {
            float l = lrun; l += __shfl_xor(l, 16); l += __shfl_xor(l, 32);
            const float inv = 1.f / l;
#pragma unroll
            for (int n = 0; n < 8; ++n) { u32x2 w; w.x = pk2(oacc[n][0] * inv, oacc[n][1] * inv); w.y = pk2(oacc[n][2] * inv, oacc[n][3] * inv);
                *(u32x2*)(oatt + (size_t)cur.qrow * D + cur.h * 128 + 16 * n + 4 * g) = w; }
        }
        cur = nxt;
#pragma unroll
        for (int ks = 0; ks < 4; ++ks) qf[ks] = qfn[ks];
    }
    __syncthreads();
#undef ATT_LOAD
#undef ATT_STORE
#undef ATT_LOADQ
}


#define XB_TMO      128
#define XB_XCNT(j)  (256  + 64 * (j))
#define XB_XSUB(j)  (1280 + 64 * (j))
#define XB_XGEN(j)  (2304 + 64 * (j))
#define XB_TOP      3328
#define XB_TOPGEN   3392
#define XCD_BAR_WORDS 3456
#define XB_SPIN_CAP (1u << 18)
__device__ __forceinline__ unsigned xb_ld(unsigned* p)              { return __hip_atomic_load(p, __ATOMIC_RELAXED, __HIP_MEMORY_SCOPE_AGENT); }
__device__ __forceinline__ unsigned xb_add(unsigned* p, unsigned v) { return __hip_atomic_fetch_add(p, v, __ATOMIC_RELAXED, __HIP_MEMORY_SCOPE_AGENT); }
__device__ __forceinline__ unsigned xb_xcc_id() { return (unsigned)__builtin_amdgcn_s_getreg((3 << 11) | 20) & 0xFu; }
#define XB_SPIN(cond, bar) do { unsigned _sp = 0; while (cond) { __builtin_amdgcn_s_sleep(1); \
    if ((++_sp & 255u) == 0u) { if (xb_ld(&(bar)[XB_TMO])) break; if (_sp > XB_SPIN_CAP) { atomicAdd(&(bar)[XB_TMO], 1u); break; } } } } while (0)
struct XcdBarrier { unsigned* bar; unsigned x; volatile LAS unsigned* st; };
__device__ __forceinline__ XcdBarrier xcd_barrier_post(unsigned* bar, volatile LAS unsigned* st) {
    XcdBarrier b; b.bar = bar; b.x = xb_xcc_id(); b.st = st;
    if (threadIdx.x == 0) (void)xb_add(&bar[XB_XCNT(b.x)], 1u);
    return b;
}
__device__ __forceinline__ void xcd_barrier_complete(unsigned* bar, unsigned x, unsigned& nloc, unsigned& nx) {
    const unsigned G = gridDim.x * gridDim.y * gridDim.z;
    unsigned sum, cnt, mine, sp = 0u;
    for (;;) {
        sum = 0u; cnt = 0u; mine = 0u;
#pragma unroll
        for (unsigned j = 0; j < 16; ++j) { const unsigned c = xb_ld(&bar[XB_XCNT(j)]); sum += c; cnt += (c > 0u) ? 1u : 0u; mine = (j == x) ? c : mine; }
        if (sum == G) break;
        __builtin_amdgcn_s_sleep(1);
        if ((++sp & 255u) == 0u) { if (xb_ld(&bar[XB_TMO])) break; if (sp > XB_SPIN_CAP) { atomicAdd(&bar[XB_TMO], 1u); break; } }
    }
    nloc = mine > 0u ? mine : 1u; nx = cnt > 0u ? cnt : 1u;
}
__device__ __forceinline__ void xcd_barrier(const XcdBarrier& b) {
    asm volatile("s_waitcnt vmcnt(0)" ::: "memory");
    __syncthreads();
    if (threadIdx.x == 0) {
        unsigned* bar = b.bar;
        __builtin_amdgcn_s_waitcnt(0);
        unsigned nloc = b.st[0], nx = b.st[1];
        if (nloc == 0u) { xcd_barrier_complete(bar, b.x, nloc, nx); b.st[0] = nloc; b.st[1] = nx; }
        const unsigned old = xb_add(&bar[XB_XSUB(b.x)], 1u);
        const unsigned gen = old / nloc;
        if (old + 1u == (gen + 1u) * nloc) {
            __builtin_amdgcn_fence(__ATOMIC_RELEASE, "agent");
            asm volatile("s_waitcnt vmcnt(0)" ::: "memory");
            const unsigned og = xb_add(&bar[XB_TOP], 1u);
            const unsigned tg = og / nx;
            if (og + 1u == (tg + 1u) * nx) xb_add(&bar[XB_TOPGEN], 1u);
            else XB_SPIN(xb_ld(&bar[XB_TOPGEN]) == tg, bar);
            __builtin_amdgcn_fence(__ATOMIC_ACQUIRE, "agent");
            xb_add(&bar[XB_XGEN(b.x)], 1u);
            asm volatile("s_waitcnt vmcnt(0)" ::: "memory");
        } else {
            XB_SPIN(xb_ld(&bar[XB_XGEN(b.x)]) == gen, bar);
            __builtin_amdgcn_fence(__ATOMIC_ACQUIRE, "agent");
            asm volatile("s_waitcnt vmcnt(0)" ::: "memory");
        }
    }
    __syncthreads();
}

__global__ __launch_bounds__(512, 2) void mega(Args aa) {
    extern __shared__ __attribute__((aligned(16))) unsigned char shm[];
    LAS unsigned char* lds = (LAS unsigned char*)shm;
    cg::grid_group grid = cg::this_grid();
    {
        LAS unsigned long long* tabw = (LAS unsigned long long*)(lds + 131072);
        if (threadIdx.x == 0) {
#pragma unroll
            for (int i = 0; i < 32; ++i) tabw[i] = (unsigned long long)aa.in[i];
            tabw[32] = (unsigned long long)aa.out; tabw[33] = (unsigned long long)aa.ws;
        }
        __syncthreads();
    }
    DArgs a; a.tab = (LAS const unsigned long long*)(lds + 131072); a.ph_lo = aa.ph_lo; a.ph_hi = aa.ph_hi;
    volatile LAS unsigned* xb_st = (volatile LAS unsigned*)(lds + 131072 + 448);
    if (threadIdx.x == 0) { xb_st[0] = 0u; xb_st[1] = 0u; }
    __syncthreads();
    const XcdBarrier xb = xcd_barrier_post((unsigned*)(__attribute__((address_space(1))) unsigned*)(a.wsp() + W_BAR), xb_st);
#define gn a.in(I_GNORM)
#define ws a.wsp()
    const int nM = TA / 256;
#ifndef PHMASK
#define PHMASK 0x3fffff
#endif
#ifndef DUPMASK
#define DUPMASK 0
#endif
#define PH(p) if (((PHMASK >> (p)) & 1) && a.ph_lo <= (p) && (p) < a.ph_hi) for (int rep_ = 0; rep_ < (((DUPMASK >> (p)) & 1) ? 2 : 1); ++rep_, (((DUPMASK >> (p)) & 1) && rep_ < 2 ? grid.sync() : (void)0))
#define SYNC(p) if (a.ph_lo <= (p) && (p) + 1 < a.ph_hi) xcd_barrier(xb);
    if (a.ph_lo < 0) grid.sync();
    PH(0) { phase_mod_partial(a, lds); phase_convert(a, lds); }
    SYNC(0)
    PH(1) { phase_mod_final(a); }
    SYNC(1)
    PH(2) { phase_rowwise<true, false, true>(a, nullptr, 0, 0, gn + 0 * D, 0, 1, 0); }
    SYNC(2)
    PH(3) { pg8::EpiBf16<0> E{(bf16_t*)(ws + W_P), DIN0, nullptr};
        run_gemm(lds, D, D, D, ws + W_HA, ws + W_IN0T, nM, DIN0 / 256, 0, nullptr, nullptr, 0, 0, E);
        const int c0 = (nM * (DIN0 / 256)) % (int)gridDim.x; convert_sub(a, lds, CV_OUT0, c0); convert_sub(a, lds, CV_FF1_0, c0); }
    SYNC(3)
    PH(4) { phase_prep(a); }
    SYNC(4)
    PH(5) { { pg8::EpiBf16<0> E{(bf16_t*)(ws + W_MIX), D, nullptr};
          run_gemm(lds, 256, 1280, 256, ws + W_AL, ws + W_POOLT, nM, 4, 512, nullptr, nullptr, 0, 0, E); }
        { pg8::EpiF32 E{(float*)(ws + W_L), 3072};
          run_gemm(lds, 256, 1280, 256, ws + W_AL + 2048, ws + W_LORAT, nM, 12, 0, nullptr, nullptr, 0, 0, E); } }
    SYNC(5)
    PH(6) { phase_scan_a(a, lds); }
    SYNC(6)
    PH(7) { phase_scan_b(a, lds); }
    SYNC(7)
    PH(8) { phase_scan_c(a, lds); }
    SYNC(8)
    PH(9) { pg8::Epi2<pg8::EpiBf16<0>, pg8::EpiPartF32> E{{(bf16_t*)(ws + W_O), D, nullptr}, {(float*)(ws + W_OACC), D}};
        run_gemm(lds, D, D, D, ws + W_MIX, ws + W_OUT0T, 64, 8, 0, ws + W_MIX, ws + W_OUT0T, 0, 8, E, 8, 64); }
    SYNC(9)
    PH(10) { phase_rowwise<true, true, true>(a, gn + 1 * D, 0, 2, gn + 2 * D, 0, 4, 3, 8); }
    SYNC(10)
    PH(11) { pg8::EpiBf16<1> E{(bf16_t*)(ws + W_F1), DFF, nullptr};
        run_gemm(lds, D, D, D, ws + W_HA, ws + W_FF1T, nM, DFF / 256, 0, nullptr, nullptr, 0, 0, E);
        const int c0 = (nM * (DFF / 256)) % (int)gridDim.x; convert_sub(a, lds, CV_FF2_0, c0); convert_sub(a, lds, CV_QKV, c0); }
    SYNC(11)
    PH(12) { pg8::Epi2<pg8::EpiBf16<0>, pg8::EpiPartF32> E{{(bf16_t*)(ws + W_O), D, nullptr}, {(float*)(ws + W_OACC), D}};
        run_gemm(lds, DFF, DFF, DFF, ws + W_F1, ws + W_FF2T, 64, 8, 0, ws + W_F1, ws + W_FF2T, 0, 8, E, 32, 64); }
    SYNC(12)
    PH(13) { phase_rowwise<false, true, true>(a, gn + 3 * D, 0, 5, gn + 4 * D, 1, 1, 0, 32); }
    SYNC(13)
    PH(14) { pg8::Epi2<pg8::EpiBf16<0>, pg8::EpiBf16<0>> E{{(bf16_t*)(ws + W_QK), 4096, nullptr}, {(bf16_t*)(ws + W_VT), TA, nullptr}};
        run_gemm(lds, D, D, D, ws + W_HA, ws + W_QKVT, nM, 16, 0, ws + W_QKVT + (size_t)4096 * D * 2, ws + W_HA, 8, nM, E);
        const int c0 = (nM * 24) % (int)gridDim.x; convert_sub(a, lds, CV_OUT1, c0); convert_sub(a, lds, CV_FF1_1, c0); }
    SYNC(14)
    PH(15) { phase_attn_prep(a, lds); }
    SYNC(15)
    PH(16) { phase_attn(a, lds); }
    SYNC(16)
    PH(17) { pg8::Epi2<pg8::EpiBf16<0>, pg8::EpiPartF32> E{{(bf16_t*)(ws + W_O), D, nullptr}, {(float*)(ws + W_OACC), D}};
        run_gemm(lds, D, D, D, ws + W_MIX, ws + W_OUT1T, 64, 8, 0, ws + W_MIX, ws + W_OUT1T, 0, 8, E, 8, 64); }
    SYNC(17)
    PH(18) { phase_rowwise<false, true, true>(a, gn + 5 * D, 1, 2, gn + 6 * D, 1, 4, 3, 8); }
    SYNC(18)
    PH(19) { pg8::EpiBf16<1> E{(bf16_t*)(ws + W_F1), DFF, nullptr};
        run_gemm(lds, D, D, D, ws + W_HA, ws + W_FF1T, nM, DFF / 256, 0, nullptr, nullptr, 0, 0, E);
        const int c0 = (nM * (DFF / 256)) % (int)gridDim.x; convert_sub(a, lds, CV_FF2_1, c0); }
    SYNC(19)
    PH(20) { pg8::Epi2<pg8::EpiBf16<0>, pg8::EpiPartF32> E{{(bf16_t*)(ws + W_O), D, nullptr}, {(float*)(ws + W_OACC), D}};
        run_gemm(lds, DFF, DFF, DFF, ws + W_F1, ws + W_FF2T, 64, 8, 0, ws + W_F1, ws + W_FF2T, 0, 8, E, 32, 64); }
    SYNC(20)
    PH(21) { phase_rowwise<false, true, false>(a, gn + 7 * D, 1, 5, nullptr, 0, 0, 0, 32); }
#undef PH
#undef SYNC
#undef gn
#undef ws
}

constexpr int NPHASE = 22;
#ifndef MK_MULTI
#define MK_MULTI 0
#endif
extern "C" void kernel_launch(void* const* d_in, const int* in_sizes, int n_in, void* d_out, int out_size, void* d_ws, size_t ws_size, hipStream_t stream) {
    static int grid = 0;
    constexpr int LDS_BYTES = 131072 + 512;
    if (grid == 0) {
        if (n_in != 32 || ws_size < WS_TOTAL) { fprintf(stderr, "kernel_launch: unexpected n_in %d / ws %zu (need %zu)\n", n_in, ws_size, (size_t)WS_TOTAL); grid = -1; return; }
        int dev = 0, cus = 0, per_cu = 0;
        hipGetDevice(&dev); hipDeviceGetAttribute(&cus, hipDeviceAttributeMultiprocessorCount, dev);
        if (hipFuncSetAttribute((const void*)mega, hipFuncAttributeMaxDynamicSharedMemorySize, LDS_BYTES) != hipSuccess) { fprintf(stderr, "kernel_launch: hipFuncSetAttribute failed\n"); grid = -1; return; }
        hipOccupancyMaxActiveBlocksPerMultiprocessor(&per_cu, (const void*)mega, NTHR, LDS_BYTES);
        if (per_cu < 1) { fprintf(stderr, "kernel_launch: occupancy query says %d blocks per CU\n", per_cu); per_cu = 1; }
        (void)hipGetLastError();
        grid = cus;
    }
    if (grid < 0) return;
    Args a{};
    for (int i = 0; i < 32; ++i) a.in[i] = (const float*)d_in[i];
    a.out = (float*)d_out; a.ws = (unsigned char*)d_ws;
#if MK_MULTI
    for (int p = 0; p < NPHASE; ++p) { a.ph_lo = p; a.ph_hi = p + 1; hipLaunchKernelGGL(mega, dim3(grid), dim3(NTHR), LDS_BYTES, stream, a); }
#else
    a.ph_lo = 0; a.ph_hi = NPHASE;
    if (hipMemsetAsync((char*)d_ws + W_BAR, 0, XCD_BAR_WORDS * 4, stream) != hipSuccess) { fprintf(stderr, "kernel_launch: memset of barrier words failed\n"); return; }
    void* args[] = {&a};
    hipError_t e = hipLaunchCooperativeKernel((const void*)mega, dim3(grid), dim3(NTHR), args, LDS_BYTES, stream);
    if (e != hipSuccess) fprintf(stderr, "kernel_launch: cooperative launch failed: %s (grid %d)\n", hipGetErrorString(e), grid);
#endif
}
```

```cpp
#include <hip/hip_runtime.h>
#include <hip/hip_cooperative_groups.h>
#include <cstdio>
#include <cstdint>
namespace cg = cooperative_groups;

#define LAS __attribute__((address_space(3)))
typedef unsigned short bf16_t;
typedef short bf16x8 __attribute__((ext_vector_type(8)));
typedef short bf16x4 __attribute__((ext_vector_type(4)));
typedef float f32x4 __attribute__((ext_vector_type(4)));
typedef float f32x2 __attribute__((ext_vector_type(2)));
typedef unsigned u32x4 __attribute__((ext_vector_type(4)));
typedef unsigned u32x2 __attribute__((ext_vector_type(2)));

constexpr int TP = 16384, TS = 256, TA = TP + TS;
constexpr int D = 2048, DFF = 8192, DIN0 = 4352, DPOOL = 1024, DSHIFT = 3328;
constexpr int NWAVE = 8, NTHR = 512;
constexpr int CHK = 128, NCHK = TP / CHK;
constexpr size_t O_Y = 0, O_POOLP = 34078720, O_POOLS = 34094080, O_SHIFTP = 34216960, O_SHIFTS = 34220288,
                 O_WKVP = 34246912, O_WKVS = 34312448, O_KP = 34836736, O_VP = 35885312, O_KS = 36933888, O_VS = 37458176;
constexpr size_t W_IN0T = 0, W_OUT0T = 17825792, W_QKVT = 26214400, W_OUT1T = 51380224, W_FF1T = 59768832, W_FF2T = 93323264,
                 W_POOLT = 126877696, W_LORAT = 127401984, W_MOD = 128974848, W_MODPART = 129859584,
                 W_HA = 144015360, W_MIX = 212172800, W_O = 280330240, W_R = 348487680, WS_END = 697794560;
constexpr size_t W_AL = W_HA;
constexpr size_t W_SST = W_HA;
constexpr size_t W_PC = W_O, W_UC = W_O + 33554432;
constexpr size_t W_P = W_R, W_L = W_R + 144834560;
constexpr size_t W_F1 = W_R;
constexpr size_t W_QK = W_R, W_VT = W_R + 136314880, W_KS = W_R + 204472320, W_VST = W_R + 223346688;
constexpr int KSPLIT = 16;
constexpr size_t W_BAR = WS_END, WS_TOTAL = WS_END + 16384;
constexpr size_t W_OACC = W_R + 272629760, WS_END2 = WS_END;

struct Args {
    const float* in[32];
    float* out;
    unsigned char* ws;
    int ph_lo, ph_hi;
};
struct DArgs {
    LAS const unsigned long long* tab; int ph_lo, ph_hi;
    __device__ __forceinline__ unsigned long long ld(int i) const { const unsigned long long v = tab[i];
        const unsigned lo = __builtin_amdgcn_readfirstlane((unsigned)v), hi = __builtin_amdgcn_readfirstlane((unsigned)(v >> 32)); return ((unsigned long long)hi << 32) | lo; }
    __device__ __forceinline__ const float* in(int i) const { return (const float*)(const __attribute__((address_space(1))) float*)ld(i); }
    __device__ __forceinline__ float* outp() const { return (float*)(__attribute__((address_space(1))) float*)ld(32); }
    __device__ __forceinline__ unsigned char* wsp() const { return (unsigned char*)(__attribute__((address_space(1))) unsigned char*)ld(33); }
};
enum { I_XP = 0, I_XS, I_CP, I_CS, I_SPOOL, I_SSHIFT, I_SWKV, I_CK, I_CV, I_WADA, I_BADA, I_GNORM, I_WIN0, I_WPOOL, I_PSCALE, I_MU,
       I_W0, I_W2, I_A0, I_A2, I_G2, I_KK, I_KA, I_RK, I_LNW, I_LNB, I_WOUT0, I_WQKV, I_RELB, I_WOUT1, I_WFF1, I_WFF2 };

__device__ __forceinline__ float bf2f(bf16_t b) { return __uint_as_float(((unsigned)b) << 16); }
__device__ __forceinline__ float bflo(unsigned w) { return __uint_as_float(w << 16); }
__device__ __forceinline__ float bfhi(unsigned w) { return __uint_as_float(w & 0xffff0000u); }
__device__ __forceinline__ unsigned pk2(float lo, float hi) { unsigned r; asm("v_cvt_pk_bf16_f32 %0, %1, %2" : "=v"(r) : "v"(lo), "v"(hi)); return r; }
__device__ __forceinline__ bf16_t f2bf(float f) { return (bf16_t)(pk2(f, 0.f) & 0xffffu); }
__device__ __forceinline__ float rl(float v, int l) { return __int_as_float(__builtin_amdgcn_readlane(__float_as_int(v), l)); }
template <int CTRL> __device__ __forceinline__ float dppf(float v) { return __int_as_float(__builtin_amdgcn_update_dpp(0, __float_as_int(v), CTRL, 0xf, 0xf, false)); }
__device__ __forceinline__ float wave_sum(float v) {
    v += dppf<0xB1>(v); v += dppf<0x4E>(v); v += dppf<0x141>(v); v += dppf<0x140>(v);
    return (rl(v, 0) + rl(v, 16)) + (rl(v, 32) + rl(v, 48));
}
__device__ __forceinline__ float sigmoidf_(float x) { return __builtin_amdgcn_rcpf(1.f + __expf(-x)); }
__device__ __forceinline__ int entry_of(int row) { return row < TP ? 0 : 1 + ((row - TP) >> 5); }

namespace pg8 {
constexpr int BM = 256, BK = 64, HALF = 128, HTB = HALF * BK * 2, STAGE_BYTES = 8 * HTB, NXCD = 8, WGM = 8;
__device__ __forceinline__ int lds_byte(int r, int c) { const int st = (r >> 4) * 2 + (c >> 5), rr = r & 15, cc = c & 31, ob = rr * 64 + cc * 2; return st * 1024 + (ob ^ (((ob >> 9) & 1) << 5)); }
__device__ __forceinline__ void stage_rc(int b, int& R, int& C) { const int st = b / 1024, sb = b % 1024, swz = sb ^ (((sb >> 9) & 1) << 5); R = (st >> 1) * 16 + swz / 64; C = (st & 1) * 32 + (swz % 64) / 2; }
__device__ __forceinline__ int perm32(int rho) { const int n = rho >> 4, i = rho & 15; return 8 * (i >> 2) + 4 * n + (i & 3); }

struct Unit { const char* a; const char* b; int pm, pn, g, nt, sl; };
struct GDesc { const char* A; const char* B; int nM, nN; long a_pn_off; };
struct Sched {
    GDesc g0, g1; int n0, n1, G, c; long tstepA, tstepB; int nt0, S1, nt1, pm1; long ksb;
    __device__ __forceinline__ void decode(const GDesc& g, int L, Unit& u, int gi) const {
        const int nwg = g.nM * g.nN; int wgid = L;
        { const int q = nwg / NXCD, r = nwg % NXCD, xcd = wgid % NXCD, off = wgid / NXCD; wgid = (xcd < r ? xcd * (q + 1) : r * (q + 1) + (xcd - r) * q) + off; }
        const int nig = WGM * g.nN, gid = wgid / nig, fm = gid * WGM, gsz = (g.nM - fm) < WGM ? (g.nM - fm) : WGM;
        u.pm = fm + ((wgid % nig) % gsz); u.pn = (wgid % nig) / gsz; u.g = gi;
        u.a = g.A + (long)u.pm * tstepA + (long)u.pn * g.a_pn_off; u.b = g.B + (long)u.pn * tstepB;
    }
    __device__ __forceinline__ bool next(int i, Unit& u) const {
        const long L = (long)i * G + c;
        if (L < n0) { decode(g0, (int)L, u, 0); u.nt = nt0; return true; }
        if (L < n0 + n1) {
            if (S1 == 0) { decode(g1, (int)(L - n0), u, 1); u.nt = nt0; }
            else { const int q = (int)(L - n0), sl = q / g1.nN, pn = q % g1.nN; u.pm = pm1; u.pn = pn; u.g = 1; u.nt = nt1; u.sl = sl;
                u.a = g1.A + (long)pm1 * tstepA + (long)sl * ksb; u.b = g1.B + (long)pn * tstepB + (long)sl * ksb; }
            return true; }
        return false;
    }
};

template <int ACT> struct EpiBf16 {
    bf16_t* O; int ldc; const float* cs;
    __device__ __forceinline__ void operator()(const f32x4 (&acc)[2][2][4][2], const Unit& u, int wr, int wc, int fr, int fq) const {
        const int row0 = u.pm * BM + wr * 64 + fr, col0 = u.pn * BM + wc * 32 + 8 * fq;
        f32x4 sv[2][2];
        if (ACT == 2) {
#pragma unroll
            for (int bj = 0; bj < 2; ++bj)
#pragma unroll
                for (int n = 0; n < 2; ++n) sv[bj][n] = *(const f32x4*)(cs + col0 + bj * HALF + 4 * n);
        }
#pragma unroll
        for (int ai = 0; ai < 2; ++ai)
#pragma unroll
            for (int m = 0; m < 4; ++m) { bf16_t* rowp = O + (size_t)(row0 + ai * HALF + m * 16) * ldc + col0;
#pragma unroll
                for (int bj = 0; bj < 2; ++bj) { f32x4 v0 = acc[ai][bj][m][0], v1 = acc[ai][bj][m][1];
                    if (ACT == 1) {
#pragma unroll
                        for (int j = 0; j < 4; ++j) { const float a0 = fmaxf(v0[j], 0.f), a1 = fmaxf(v1[j], 0.f); v0[j] = a0 * a0; v1[j] = a1 * a1; } }
                    if (ACT == 2) { v0 = v0 * sv[bj][0]; v1 = v1 * sv[bj][1]; }
                    u32x4 w; w.x = pk2(v0[0], v0[1]); w.y = pk2(v0[2], v0[3]); w.z = pk2(v1[0], v1[1]); w.w = pk2(v1[2], v1[3]);
                    *(u32x4*)(rowp + bj * HALF) = w; } }
    }
};
struct EpiF32 {
    float* C; int ldc;
    __device__ __forceinline__ void operator()(const f32x4 (&acc)[2][2][4][2], const Unit& u, int wr, int wc, int fr, int fq) const {
        const int row0 = u.pm * BM + wr * 64 + fr, col0 = u.pn * BM + wc * 32 + 8 * fq;
#pragma unroll
        for (int ai = 0; ai < 2; ++ai)
#pragma unroll
            for (int m = 0; m < 4; ++m) { float* rowp = C + (size_t)(row0 + ai * HALF + m * 16) * ldc + col0;
#pragma unroll
                for (int bj = 0; bj < 2; ++bj)
#pragma unroll
                    for (int n = 0; n < 2; ++n) *(f32x4*)(rowp + bj * HALF + 4 * n) = acc[ai][bj][m][n]; }
    }
};
struct EpiPartF32 {
    float* C; int ldc;
    __device__ __forceinline__ void operator()(const f32x4 (&acc)[2][2][4][2], const Unit& u, int wr, int wc, int fr, int fq) const {
        const int row0 = wr * 64 + fr, col0 = u.pn * BM + wc * 32 + 8 * fq;
        float* base = C + (size_t)u.sl * 256 * ldc;
#pragma unroll
        for (int ai = 0; ai < 2; ++ai)
#pragma unroll
            for (int m = 0; m < 4; ++m) { float* rowp = base + (size_t)(row0 + ai * HALF + m * 16) * ldc + col0;
#pragma unroll
                for (int bj = 0; bj < 2; ++bj)
#pragma unroll
                    for (int n = 0; n < 2; ++n) *(f32x4*)(rowp + bj * HALF + 4 * n) = acc[ai][bj][m][n]; }
    }
};
template <class E0, class E1> struct Epi2 {
    E0 e0; E1 e1;
    __device__ __forceinline__ void operator()(const f32x4 (&acc)[2][2][4][2], const Unit& u, int wr, int wc, int fr, int fq) const {
        if (u.g == 0) e0(acc, u, wr, wc, fr, fq); else e1(acc, u, wr, wc, fr, fq);
    }
};

template <class Epi>
__device__ __forceinline__ void gemm_phase(LAS unsigned char* lds, const int K, const int lda, const int ldb, const Sched& S, const Epi& E) {
    const int tid = threadIdx.x, wid = __builtin_amdgcn_readfirstlane(tid >> 6), lane = tid & 63, wr = wid >> 2, wc = wid & 3, fr = lane & 15, fq = lane >> 4;
    unsigned voffA[2], voffB[2];
#pragma unroll
    for (int i = 0; i < 2; ++i) { int R, C; stage_rc(tid * 16 + i * 8192, R, C); const int Rb = (R & ~31) + perm32(R & 31);
        voffA[i] = (unsigned)(R * lda + C) * 2u; voffB[i] = (unsigned)(Rb * ldb + C) * 2u; }
    const size_t kstep = (size_t)(BK * 2);
    const size_t hstepA = (size_t)HALF * lda * 2, hstepB = (size_t)HALF * ldb * 2;
    const unsigned ldsw = (unsigned)wid * 1024u;
    const int aoff = lds_byte(wr * 64 + fr, fq * 8), boff = lds_byte(wc * 32 + fr, fq * 8);
#define PG8_SA(b, h) (((b) * 2 + (h)) * HTB)
#define PG8_SB(b, h) ((4 + (b) * 2 + (h)) * HTB)
#define PG8_STAGE(bufoff, gbase, voff) do { _Pragma("unroll") for (int _i = 0; _i < 2; ++_i) \
        __builtin_amdgcn_global_load_lds((const unsigned*)((const char*)(gbase) + (voff)[_i]), (LAS unsigned*)(lds + (bufoff) + ldsw + _i * 8192), 16, 0, 0); } while (0)
#define PG8_LDA(dst, b, h) do { _Pragma("unroll") for (int m = 0; m < 4; ++m) _Pragma("unroll") for (int k = 0; k < 2; ++k) dst[m][k] = *(const LAS bf16x8*)(lds + PG8_SA(b, h) + aoff + m * 2048 + k * 1024); } while (0)
#define PG8_LDB(dst, b, h) do { _Pragma("unroll") for (int n = 0; n < 2; ++n) _Pragma("unroll") for (int k = 0; k < 2; ++k) dst[n][k] = *(const LAS bf16x8*)(lds + PG8_SB(b, h) + boff + n * 2048 + k * 1024); } while (0)
#define PG8_MMA(ai, bj, At, Bt) do { __builtin_amdgcn_s_setprio(1); _Pragma("unroll") for (int m = 0; m < 4; ++m) _Pragma("unroll") for (int n = 0; n < 2; ++n) _Pragma("unroll") for (int k = 0; k < 2; ++k) \
        acc[ai][bj][m][n] = __builtin_amdgcn_mfma_f32_16x16x32_bf16(Bt[n][k], At[m][k], acc[ai][bj][m][n], 0, 0, 0); __builtin_amdgcn_s_setprio(0); } while (0)
#define PG8_WAIT_V(n) asm volatile("s_waitcnt vmcnt(" #n ")" ::: "memory")
#define PG8_WAIT_L(n) asm volatile("s_waitcnt lgkmcnt(" #n ")" ::: "memory")
#define PG8_BAR __builtin_amdgcn_s_barrier()
#define PG8_SCHED __builtin_amdgcn_sched_barrier(0)
    Unit cur, nxt; int ui = 0;
    if (!S.next(0, cur)) return;
    f32x4 acc[2][2][4][2];
#pragma unroll
    for (int a = 0; a < 2; ++a)
#pragma unroll
        for (int b = 0; b < 2; ++b)
#pragma unroll
            for (int m = 0; m < 4; ++m)
#pragma unroll
                for (int n = 0; n < 2; ++n) acc[a][b][m][n] = (f32x4){0.f, 0.f, 0.f, 0.f};
    bf16x8 At[4][2], B0[2][2], B1[2][2];
    const char* cA = cur.a; const char* cB = cur.b;
    PG8_STAGE(PG8_SB(0, 0), cB, voffB); PG8_STAGE(PG8_SB(0, 1), cB + hstepB, voffB); PG8_STAGE(PG8_SA(0, 0), cA, voffA); PG8_STAGE(PG8_SA(0, 1), cA + hstepA, voffA);
    if (wr == 1) PG8_BAR;
    PG8_WAIT_V(2); PG8_BAR;
    PG8_STAGE(PG8_SB(1, 0), cB + kstep, voffB); PG8_STAGE(PG8_SA(1, 0), cA + kstep, voffA); PG8_STAGE(PG8_SB(1, 1), cB + hstepB + kstep, voffB);
    PG8_WAIT_V(6); PG8_BAR;
    for (;;) {
        const bool has_next = S.next(ui + 1, nxt);
        const char* nA = has_next ? nxt.a : cA; const char* nB = has_next ? nxt.b : cB;
        const int nt = cur.nt;
#pragma unroll 1
        for (int t = 0; t < nt; t += 2) {
            const bool last = (t == nt - 2);
            const char* a1 = cA + (size_t)(t + 1) * kstep;
            const char* a2 = last ? nA : cA + (size_t)(t + 2) * kstep; const char* b2 = last ? nB : cB + (size_t)(t + 2) * kstep;
            const char* a3 = a2 + kstep; const char* b3 = b2 + kstep;
            PG8_LDB(B0, 0, 0); PG8_LDB(B1, 0, 1); PG8_SCHED; PG8_LDA(At, 0, 0); PG8_STAGE(PG8_SA(1, 1), a1 + hstepA, voffA);
            PG8_WAIT_V(8); PG8_WAIT_L(0); PG8_BAR; PG8_MMA(0, 0, At, B0); PG8_MMA(0, 1, At, B1); PG8_BAR; PG8_SCHED;
            PG8_LDA(At, 0, 1); PG8_STAGE(PG8_SB(0, 0), b2, voffB); PG8_STAGE(PG8_SB(0, 1), b2 + hstepB, voffB); PG8_STAGE(PG8_SA(0, 0), a2, voffA);
            PG8_WAIT_V(8); PG8_WAIT_L(0); PG8_BAR; PG8_MMA(1, 0, At, B0); PG8_MMA(1, 1, At, B1); PG8_BAR; PG8_SCHED;
            PG8_LDB(B0, 1, 0); PG8_LDB(B1, 1, 1); PG8_SCHED; PG8_LDA(At, 1, 0); PG8_STAGE(PG8_SA(0, 1), a2 + hstepA, voffA);
            PG8_WAIT_V(8); PG8_WAIT_L(0); PG8_BAR; PG8_MMA(0, 0, At, B0); PG8_MMA(0, 1, At, B1); PG8_BAR; PG8_SCHED;
            PG8_LDA(At, 1, 1); PG8_STAGE(PG8_SB(1, 0), b3, voffB); PG8_STAGE(PG8_SB(1, 1), b3 + hstepB, voffB); PG8_STAGE(PG8_SA(1, 0), a3, voffA);
            PG8_WAIT_V(8); PG8_WAIT_L(0); PG8_BAR; PG8_MMA(1, 0, At, B0); PG8_MMA(1, 1, At, B1); PG8_BAR; PG8_SCHED;
        }
        if (wr == 0) PG8_BAR;
        E(acc, cur, wr, wc, fr, fq);
        if (!has_next) break;
#pragma unroll
        for (int a = 0; a < 2; ++a)
#pragma unroll
            for (int b = 0; b < 2; ++b)
#pragma unroll
                for (int m = 0; m < 4; ++m)
#pragma unroll
                    for (int n = 0; n < 2; ++n) acc[a][b][m][n] = (f32x4){0.f, 0.f, 0.f, 0.f};
        cur = nxt; cA = nA; cB = nB; ++ui;
        if (wr == 1) PG8_BAR;
    }
    PG8_WAIT_V(0);
    PG8_BAR;
#undef PG8_SA
#undef PG8_SB
#undef PG8_STAGE
#undef PG8_LDA
#undef PG8_LDB
#undef PG8_MMA
#undef PG8_WAIT_V
#undef PG8_WAIT_L
#undef PG8_BAR
#undef PG8_SCHED
}
}

template <class Epi>
__device__ __forceinline__ void run_gemm(LAS unsigned char* lds, int K, int lda, int ldb, const void* A0, const void* B0, int nM0, int nN0, long apn0,
                                         const void* A1, const void* B1, int nM1, int nN1, const Epi& E, int S1 = 0, int pm1 = 0) {
    pg8::Sched S;
    S.nt0 = K / 64; S.S1 = S1; S.pm1 = pm1; S.nt1 = S1 ? K / 64 / S1 : 0; S.ksb = S1 ? (long)(K / S1) * 2 : 0;
    S.g0.A = (const char*)A0; S.g0.B = (const char*)B0; S.g0.nM = nM0; S.g0.nN = nN0; S.g0.a_pn_off = apn0;
    S.g1.A = (const char*)A1; S.g1.B = (const char*)B1; S.g1.nM = nM1; S.g1.nN = nN1; S.g1.a_pn_off = 0;
    S.n0 = nM0 * nN0; S.n1 = S1 ? S1 * nN1 : nM1 * nN1; S.G = gridDim.x; S.c = blockIdx.x;
    S.tstepA = (long)256 * lda * 2; S.tstepB = (long)256 * ldb * 2;
    pg8::gemm_phase<Epi>(lds, K, lda, ldb, S, E);
    __syncthreads();
}

__device__ __forceinline__ void transpose_item(const float* W, int ldw, bf16_t* WT, int ldo, LAS float* scr, int k0, int n0, int lane, const float* rs = nullptr) {
#pragma unroll 8
    for (int i = 0; i < 32; ++i) { const int kk = 2 * i + (lane >> 5); scr[kk * 33 + (lane & 31)] = W[(size_t)(k0 + kk) * ldw + n0 + (lane & 31)]; }
    asm volatile("s_waitcnt lgkmcnt(0)" ::: "memory");
    const int c = lane & 7;
#pragma unroll
    for (int j = 0; j < 4; ++j) { const int n = (lane >> 3) + 8 * j; const LAS float* s = scr + (8 * c) * 33 + n; const float m = rs ? rs[n0 + n] : 1.f;
        u32x4 o; o.x = pk2(s[0 * 33] * m, s[1 * 33] * m); o.y = pk2(s[2 * 33] * m, s[3 * 33] * m); o.z = pk2(s[4 * 33] * m, s[5 * 33] * m); o.w = pk2(s[6 * 33] * m, s[7 * 33] * m);
        *(u32x4*)(WT + (size_t)(n0 + n) * ldo + k0 + 8 * c) = o; }
    asm volatile("s_waitcnt lgkmcnt(0)" ::: "memory");
}
__device__ __forceinline__ void transpose_matrix(const float* W, int K, int N, bf16_t* WT, int ldo, LAS float* scr, int gw, int ngw, int lane, const float* rs = nullptr) {
    const int nblk = N / 32, nitems = (K / 64) * nblk;
    for (int it = gw; it < nitems; it += ngw) { const int kb = it / nblk, nb = it % nblk; transpose_item(W, N, WT, ldo, scr, kb * 64, nb * 32, lane, rs); }
}

__device__ __forceinline__ void phase_mod_partial(const DArgs& a, LAS unsigned char* lds) {
    LAS float* sil = (LAS float*)lds;
    for (int i = threadIdx.x; i < 9 * D; i += NTHR) { const int e = i / D, d = i % D; const float c = e == 0 ? a.in(I_CP)[d] : a.in(I_CS)[(e - 1) * D + d]; sil[i] = c / (1.f + __expf(-c)); }
    __syncthreads();
    const int wave = threadIdx.x >> 6, lane = threadIdx.x & 63, gw = blockIdx.x * NWAVE + wave, ngw = gridDim.x * NWAVE;
    float* part = (float*)(a.wsp() + W_MODPART);
    constexpr int NT = 6 * D / 256;
    constexpr int KR = D / KSPLIT;
    for (int it = gw; it < 2 * NT * KSPLIT; it += ngw) {
        const int ks = it % KSPLIT, nt = (it / KSPLIT) % NT, l = it / (KSPLIT * NT);
        const float* w = a.in(I_WADA) + (size_t)l * D * 6 * D + (size_t)(ks * KR) * 6 * D + nt * 256 + lane * 4;
        f32x4 acc[9];
#pragma unroll
        for (int e = 0; e < 9; ++e) acc[e] = (f32x4){0.f, 0.f, 0.f, 0.f};
#pragma unroll 4
        for (int d = 0; d < KR; ++d) {
            const f32x4 wv = *(const f32x4*)(w + (size_t)d * 6 * D);
#pragma unroll
            for (int e = 0; e < 9; ++e) { const float s = sil[e * D + ks * KR + d]; acc[e] += wv * s; }
        }
#pragma unroll
        for (int e = 0; e < 9; ++e) *(f32x4*)(part + ((size_t)(ks * 9 + e) * 2 + l) * 6 * D + nt * 256 + lane * 4) = acc[e];
    }
    __syncthreads();
}
enum { CV_OUT0 = 0, CV_QKV, CV_OUT1, CV_FF1_0, CV_FF2_0, CV_FF1_1, CV_FF2_1 };
__device__ __forceinline__ void convert_sub(const DArgs& a, LAS unsigned char* lds, int which, int c0) {
    if ((int)blockIdx.x < c0) return;
    const int wave = threadIdx.x >> 6, lane = threadIdx.x & 63, gw = ((int)blockIdx.x - c0) * NWAVE + wave, ngw = ((int)gridDim.x - c0) * NWAVE;
    LAS float* scr = (LAS float*)(lds + wave * 8448);
    unsigned char* w = a.wsp();
    switch (which) {
    case CV_OUT0: transpose_matrix(a.in(I_WOUT0), D, D, (bf16_t*)(w + W_OUT0T), D, scr, gw, ngw, lane); break;
    case CV_QKV: transpose_matrix(a.in(I_WQKV), D, 3 * D, (bf16_t*)(w + W_QKVT), D, scr, gw, ngw, lane); break;
    case CV_OUT1: transpose_matrix(a.in(I_WOUT1), D, D, (bf16_t*)(w + W_OUT1T), D, scr, gw, ngw, lane); break;
    case CV_FF1_0: transpose_matrix(a.in(I_WFF1), D, DFF, (bf16_t*)(w + W_FF1T), D, scr, gw, ngw, lane); break;
    case CV_FF2_0: transpose_matrix(a.in(I_WFF2), DFF, D, (bf16_t*)(w + W_FF2T), DFF, scr, gw, ngw, lane); break;
    case CV_FF1_1: transpose_matrix(a.in(I_WFF1) + (size_t)D * DFF, D, DFF, (bf16_t*)(w + W_FF1T), D, scr, gw, ngw, lane); break;
    default: transpose_matrix(a.in(I_WFF2) + (size_t)DFF * D, DFF, D, (bf16_t*)(w + W_FF2T), DFF, scr, gw, ngw, lane); break;
    }
}
__device__ __forceinline__ void phase_convert(const DArgs& a, LAS unsigned char* lds) {
    const int wave = threadIdx.x >> 6, lane = threadIdx.x & 63, gw = blockIdx.x * NWAVE + wave, ngw = gridDim.x * NWAVE;
    LAS float* scr = (LAS float*)(lds + wave * 8448);
    transpose_matrix(a.in(I_WIN0), D, DIN0, (bf16_t*)(a.wsp() + W_IN0T), D, scr, gw, ngw, lane);
    for (int g = 0; g < 4; ++g) transpose_matrix(a.in(I_WPOOL) + (size_t)g * 65536, 256, 256, (bf16_t*)(a.wsp() + W_POOLT) + (size_t)g * 65536, 256, scr, gw, ngw, lane, a.in(I_PSCALE) + g * 256);
    bf16_t* lt = (bf16_t*)(a.wsp() + W_LORAT);
    for (int i = blockIdx.x * NTHR + threadIdx.x; i < 3072 * 256; i += gridDim.x * NTHR) {
        const int row = i >> 8, k = i & 255, part = row >> 10, n = row & 1023; float v = 0.f;
        if (part == 0) { if (k < 64) v = a.in(I_W2)[k * 1024 + n]; }
        else if (part == 1) { if (k >= 64 && k < 128) v = a.in(I_A2)[(k - 64) * 1024 + n]; }
        else { if (k >= 128) v = a.in(I_G2)[(k - 128) * 1024 + n]; }
        lt[i] = f2bf(v);
    }
}
__device__ __forceinline__ void phase_mod_final(const DArgs& a) {
    const float* part = (const float*)(a.wsp() + W_MODPART); float* mod = (float*)(a.wsp() + W_MOD);
    for (int i = blockIdx.x * NTHR + threadIdx.x; i < 9 * 2 * 6 * D; i += gridDim.x * NTHR) {
        const int n = i % (6 * D), l = (i / (6 * D)) & 1;
        float s = a.in(I_BADA)[l * 6 * D + n];
#pragma unroll
        for (int ks = 0; ks < KSPLIT; ++ks) s += part[(size_t)ks * 9 * 2 * 6 * D + i];
        mod[i] = s;
    }
}
__device__ __forceinline__ void zero_oacc(const DArgs& a) {
    f32x4* p = (f32x4*)(a.wsp() + W_OACC);
    for (int i = blockIdx.x * NTHR + threadIdx.x; i < TS * D / 4; i += gridDim.x * NTHR) p[i] = (f32x4){0.f, 0.f, 0.f, 0.f};
}
template <bool XIN_INPUT, bool HAS_O, bool HAS_H>
__device__ __forceinline__ void phase_rowwise(const DArgs& a, const float* g_o, int l_gt, int gt_which, const float* g_h, int l_h, int sc_which, int sh_which, int nsl = 0) {
    const int wave = threadIdx.x >> 6, lane = threadIdx.x & 63, gw = blockIdx.x * NWAVE + wave, ngw = gridDim.x * NWAVE;
    const float* mod = (const float*)(a.wsp() + W_MOD);
    float* X = a.outp() + O_Y; const bf16_t* o = (const bf16_t*)(a.wsp() + W_O); bf16_t* hA = (bf16_t*)(a.wsp() + W_HA); const float* oacc = (const float*)(a.wsp() + W_OACC);
    {
        f32x4 A1[HAS_O ? 8 : 1], A2[HAS_H ? 8 : 1], A3[HAS_H ? 8 : 1];
#pragma unroll
        for (int j = 0; j < 8; ++j) { const int c = 4 * (lane + 64 * j);
            if constexpr (HAS_O) A1[j] = *(const f32x4*)(mod + (size_t)l_gt * 6 * D + gt_which * D + c) * *(const f32x4*)(g_o + c);
            if constexpr (HAS_H) { A2[j] = *(const f32x4*)(g_h + c) * (*(const f32x4*)(mod + (size_t)l_h * 6 * D + sc_which * D + c) + 1.f); A3[j] = *(const f32x4*)(mod + (size_t)l_h * 6 * D + sh_which * D + c); } }
        for (int row = gw; row < TP; row += ngw) {
            const float* xin = XIN_INPUT ? a.in(I_XP) + (size_t)row * D : X + (size_t)row * D;
            f32x4 x[8];
#pragma unroll
            for (int j = 0; j < 8; ++j) x[j] = *(const f32x4*)(xin + 4 * (lane + 64 * j));
            if constexpr (HAS_O) {
                f32x4 ov[8]; float ss = 0.f;
#pragma unroll
                for (int j = 0; j < 8; ++j) { const u32x2 w = *(const u32x2*)(o + (size_t)row * D + 4 * (lane + 64 * j)); ov[j] = (f32x4){bflo(w.x), bfhi(w.x), bflo(w.y), bfhi(w.y)};
                    ss += (ov[j].x * ov[j].x + ov[j].y * ov[j].y) + (ov[j].z * ov[j].z + ov[j].w * ov[j].w); }
                const float rstd = rsqrtf(wave_sum(ss) * (1.f / D) + 1e-6f);
#pragma unroll
                for (int j = 0; j < 8; ++j) { x[j] += A1[j] * (ov[j] * rstd); *(f32x4*)(X + (size_t)row * D + 4 * (lane + 64 * j)) = x[j]; }
            }
            if constexpr (HAS_H) {
                float ss = 0.f;
#pragma unroll
                for (int j = 0; j < 8; ++j) ss += (x[j].x * x[j].x + x[j].y * x[j].y) + (x[j].z * x[j].z + x[j].w * x[j].w);
                const float rstd = rsqrtf(wave_sum(ss) * (1.f / D) + 1e-6f);
#pragma unroll
                for (int j = 0; j < 8; ++j) { const f32x4 h = x[j] * rstd * A2[j] + A3[j]; u32x2 w; w.x = pk2(h.x, h.y); w.y = pk2(h.z, h.w);
                    *(u32x2*)(hA + (size_t)row * D + 4 * (lane + 64 * j)) = w; }
            }
        }
    }
    for (int row = TP + gw; row < TA; row += ngw) {
        const int e = entry_of(row);
        const float* xin = XIN_INPUT ? a.in(I_XS) + (size_t)(row - TP) * D : X + (size_t)row * D;
        f32x4 x[8];
#pragma unroll
        for (int j = 0; j < 8; ++j) x[j] = *(const f32x4*)(xin + 4 * (lane + 64 * j));
        if constexpr (HAS_O) {
            f32x4 ov[8]; float ss = 0.f;
#pragma unroll
            for (int j = 0; j < 8; ++j) ov[j] = (f32x4){0.f, 0.f, 0.f, 0.f};
#pragma unroll 2
            for (int sl = 0; sl < nsl; ++sl) {
#pragma unroll
                for (int j = 0; j < 8; ++j) ov[j] += *(const f32x4*)(oacc + ((size_t)sl * TS + (row - TP)) * D + 4 * (lane + 64 * j));
            }
#pragma unroll
            for (int j = 0; j < 8; ++j) ss += (ov[j].x * ov[j].x + ov[j].y * ov[j].y) + (ov[j].z * ov[j].z + ov[j].w * ov[j].w);
            const float rstd = rsqrtf(wave_sum(ss) * (1.f / D) + 1e-6f);
            const float* gt = mod + (size_t)(e * 2 + l_gt) * 6 * D + gt_which * D;
#pragma unroll
            for (int j = 0; j < 8; ++j) { const int c = 4 * (lane + 64 * j); const f32x4 g = *(const f32x4*)(gt + c), go = *(const f32x4*)(g_o + c);
                x[j] += g * (ov[j] * rstd * go); *(f32x4*)(X + (size_t)row * D + c) = x[j]; }
        }
        if constexpr (HAS_H) {
            float ss = 0.f;
#pragma unroll
            for (int j = 0; j < 8; ++j) ss += (x[j].x * x[j].x + x[j].y * x[j].y) + (x[j].z * x[j].z + x[j].w * x[j].w);
            const float rstd = rsqrtf(wave_sum(ss) * (1.f / D) + 1e-6f);
            const float* sc = mod + (size_t)(e * 2 + l_h) * 6 * D + sc_which * D; const float* sh = mod + (size_t)(e * 2 + l_h) * 6 * D + sh_which * D;
#pragma unroll
            for (int j = 0; j < 8; ++j) { const int c = 4 * (lane + 64 * j); const f32x4 g = *(const f32x4*)(g_h + c), s1 = *(const f32x4*)(sc + c), s0 = *(const f32x4*)(sh + c);
                const f32x4 h = x[j] * rstd * g * (s1 + 1.f) + s0; u32x2 w; w.x = pk2(h.x, h.y); w.y = pk2(h.z, h.w);
                *(u32x2*)(hA + (size_t)row * D + c) = w; }
        }
    }
}
__device__ __forceinline__ void ld8bf(const bf16_t* p, float (&v)[8]) { const u32x4 w = *(const u32x4*)p; v[0] = bflo(w.x); v[1] = bfhi(w.x); v[2] = bflo(w.y); v[3] = bfhi(w.y); v[4] = bflo(w.z); v[5] = bfhi(w.z); v[6] = bflo(w.w); v[7] = bfhi(w.w); }
__device__ __forceinline__ void ld8f(const float* p, float (&v)[8]) { const f32x4 a = *(const f32x4*)p, b = *(const f32x4*)(p + 4); v[0] = a.x; v[1] = a.y; v[2] = a.z; v[3] = a.w; v[4] = b.x; v[5] = b.y; v[6] = b.z; v[7] = b.w; }
__device__ __forceinline__ void st8bf(bf16_t* p, const float (&v)[8]) { u32x4 w; w.x = pk2(v[0], v[1]); w.y = pk2(v[2], v[3]); w.z = pk2(v[4], v[5]); w.w = pk2(v[6], v[7]); *(u32x4*)p = w; }
template <int WIN> __device__ __forceinline__ void pool_sum(const bf16_t* p, float (&s)[8], float (&u)[8]) {
    u32x4 w[WIN];
#pragma unroll
    for (int sf = 0; sf < WIN; ++sf) w[sf] = *(const u32x4*)(p - (size_t)sf * DIN0);
    u[0] = bflo(w[0].x); u[1] = bfhi(w[0].x); u[2] = bflo(w[0].y); u[3] = bfhi(w[0].y); u[4] = bflo(w[0].z); u[5] = bfhi(w[0].z); u[6] = bflo(w[0].w); u[7] = bfhi(w[0].w);
#pragma unroll
    for (int i = 0; i < 8; ++i) s[i] = u[i];
#pragma unroll
    for (int sf = 1; sf < WIN; ++sf) { s[0] += bflo(w[sf].x); s[1] += bfhi(w[sf].x); s[2] += bflo(w[sf].y); s[3] += bfhi(w[sf].y); s[4] += bflo(w[sf].z); s[5] += bfhi(w[sf].z); s[6] += bflo(w[sf].w); s[7] += bfhi(w[sf].w); }
}
__device__ __forceinline__ void phase_prep(const DArgs& a) {
    const bf16_t* P = (const bf16_t*)(a.wsp() + W_P); bf16_t* AL = (bf16_t*)(a.wsp() + W_AL);
    const int gt = blockIdx.x * NTHR + threadIdx.x, ngt = gridDim.x * NTHR;
    for (int idx = gt; idx < TA * 160; idx += ngt) {
        const int row = idx / 160, it = idx % 160; const bool prompt = row < TP; const int t = prompt ? row : ((row - TP) & 31), b = prompt ? 0 : ((row - TP) >> 5);
        if (it < 128) {
            const int c0 = it * 8, gi = c0 >> 8, win = 2 << gi;
            float s[8], u[8], v[8];
            if (t >= win - 1) {
                const bf16_t* p = P + (size_t)row * DIN0 + c0;
                if (gi == 0) pool_sum<2>(p, s, u); else if (gi == 1) pool_sum<4>(p, s, u); else if (gi == 2) pool_sum<8>(p, s, u); else pool_sum<16>(p, s, u);
                const float inv = 1.f / (float)win;
#pragma unroll
                for (int i = 0; i < 8; ++i) s[i] = s[i] * inv - u[i];
            } else {
#pragma unroll
                for (int i = 0; i < 8; ++i) s[i] = 0.f;
                for (int sf = 0; sf < win; ++sf) { const int tt = t - sf;
                    if (tt >= 0) { ld8bf(P + (size_t)(row - sf) * DIN0 + c0, v);
#pragma unroll
                        for (int i = 0; i < 8; ++i) s[i] += v[i]; }
                    else if (!prompt) { ld8f(a.in(I_SPOOL) + ((size_t)b * 15 + (15 + tt)) * DPOOL + c0, v);
#pragma unroll
                        for (int i = 0; i < 8; ++i) s[i] += v[i]; } }
                const float cnt = prompt ? (float)min(win, t + 1) : (float)win, inv = 1.f / cnt;
                ld8bf(P + (size_t)row * DIN0 + c0, u);
#pragma unroll
                for (int i = 0; i < 8; ++i) s[i] = s[i] * inv - u[i];
            }
            st8bf(AL + (size_t)row * 1280 + c0, s);
        } else {
            const int q0 = (it - 128) * 8, e0 = 3072 + q0;
            float z[8], zp[8], mu[8];
            ld8bf(P + (size_t)row * DIN0 + DPOOL + e0, z);
            if (t > 0) ld8bf(P + (size_t)(row - 1) * DIN0 + DPOOL + e0, zp);
            else if (!prompt) ld8f(a.in(I_SSHIFT) + (size_t)b * DSHIFT + e0, zp);
            else {
#pragma unroll
                for (int i = 0; i < 8; ++i) zp[i] = 0.f; }
            ld8f(a.in(I_MU) + e0, mu);
#pragma unroll
            for (int i = 0; i < 8; ++i) { const float zs = z[i] + (zp[i] - z[i]) * mu[i];
                z[i] = q0 < 64 ? 1.f - 2.f / (1.f + __expf(2.f * zs)) : (q0 < 128 ? zs : sigmoidf_(zs)); }
            st8bf(AL + (size_t)row * 1280 + 1024 + q0, z);
        }
    }
    for (int i = gt; i < 15 * DPOOL; i += ngt) a.outp()[O_POOLP + i] = bf2f(P[(size_t)(TP - 15 + i / DPOOL) * DIN0 + (i % DPOOL)]);
    for (int i = gt; i < 8 * 15 * DPOOL; i += ngt) { const int b = i / (15 * DPOOL), r = (i / DPOOL) % 15, c = i % DPOOL; a.outp()[O_POOLS + i] = bf2f(P[(size_t)(TP + b * 32 + 17 + r) * DIN0 + c]); }
    for (int i = gt; i < DSHIFT; i += ngt) a.outp()[O_SHIFTP + i] = bf2f(P[(size_t)(TP - 1) * DIN0 + DPOOL + i]);
    for (int i = gt; i < 8 * DSHIFT; i += ngt) { const int b = i / DSHIFT, e = i % DSHIFT; a.outp()[O_SHIFTS + i] = bf2f(P[(size_t)(TP + b * 32 + 31) * DIN0 + DPOOL + e]); }
}

struct ScanConst { float mu_r, mu_k, mu_v, w0, a0, kkc, kac, rk, lnw, lnb; };
struct ScanRaw { bf16_t zr, zk, zv; float lw, la, lg; };
template <bool NEEDG> __device__ __forceinline__ ScanRaw scan_load(const bf16_t* P, const float* L, int row, int c) {
    ScanRaw r; const bf16_t* p = P + (size_t)row * DIN0 + DPOOL + c; r.zr = p[0]; r.zk = p[1024]; r.zv = p[2048];
    const float* l = L + (size_t)row * 3072 + c; r.lw = l[0]; r.la = l[1024]; r.lg = NEEDG ? l[2048] : 0.f; return r;
}
template <int MODE>
__device__ __forceinline__ void scan_item(const DArgs& a, LAS float* W  , int row0, int nsteps, int h, int lane, bool first_is_start, const float* shift_prev  ,
                                          const float* S_init  , float* S_final  , float* Uout, float* Pout) {
    const bf16_t* P = (const bf16_t*)(a.wsp() + W_P); const float* L = (const float*)(a.wsp() + W_L); bf16_t* mix = (bf16_t*)(a.wsp() + W_MIX);
    const int c = h * 64 + lane, ib = lane >> 4, il = lane & 15;
    ScanConst k; k.mu_r = a.in(I_MU)[c]; k.mu_k = a.in(I_MU)[1024 + c]; k.mu_v = a.in(I_MU)[2048 + c]; k.w0 = a.in(I_W0)[c]; k.a0 = a.in(I_A0)[c];
    k.kkc = a.in(I_KK)[c]; k.kac = a.in(I_KA)[c]; k.rk = a.in(I_RK)[c]; k.lnw = a.in(I_LNW)[c]; k.lnb = a.in(I_LNB)[c];
    float zr_p, zk_p, zv_p;
    if (!first_is_start) { const bf16_t* p = P + (size_t)(row0 - 1) * DIN0 + DPOOL + c; zr_p = bf2f(p[0]); zk_p = bf2f(p[1024]); zv_p = bf2f(p[2048]); }
    else if (shift_prev) { zr_p = shift_prev[c]; zk_p = shift_prev[1024 + c]; zv_p = shift_prev[2048 + c]; }
    else { zr_p = 0.f; zk_p = 0.f; zv_p = 0.f; }
    f32x2 S[4][8];
    if constexpr (MODE == 1) {
#pragma unroll
        for (int q = 0; q < 4; ++q)
#pragma unroll
            for (int m = 0; m < 4; ++m) { const f32x4 v = *(const f32x4*)(S_init + (il + 16 * q) * 64 + 16 * ib + 4 * m); S[q][2 * m] = (f32x2){v.x, v.y}; S[q][2 * m + 1] = (f32x2){v.z, v.w}; }
    } else {
#pragma unroll
        for (int q = 0; q < 4; ++q)
#pragma unroll
            for (int p = 0; p < 8; ++p) S[q][p] = MODE == 2 ? (f32x2){(q == ib && 2 * p == il) ? 1.f : 0.f, (q == ib && 2 * p + 1 == il) ? 1.f : 0.f} : (f32x2){0.f, 0.f};
    }
#define LDV(dst_, vec_) { _Pragma("unroll") for (int m = 0; m < 4; ++m) { const f32x4 t_ = *(const LAS f32x4*)(W + (vec_) * 64 + 16 * ib + 4 * m); dst_[2 * m] = (f32x2){t_.x, t_.y}; dst_[2 * m + 1] = (f32x2){t_.z, t_.w}; } }
#define XSUM(x_) { const u32x2 s16_ = __builtin_amdgcn_permlane16_swap(__float_as_uint(x_), __float_as_uint(x_), false, false); x_ = __uint_as_float(s16_.x) + __uint_as_float(s16_.y); \
                   const u32x2 s32_ = __builtin_amdgcn_permlane32_swap(__float_as_uint(x_), __float_as_uint(x_), false, false); x_ = __uint_as_float(s32_.x) + __uint_as_float(s32_.y); }
    struct Prep { float an, dec, bn, kmod, r, v, lg, bin; };
    auto prep = [&](const ScanRaw& rw) -> Prep {
        Prep o; const float zr = bf2f(rw.zr), zk = bf2f(rw.zk), zv = bf2f(rw.zv);
        const float r = zr + (zr_p - zr) * k.mu_r, kx = zk + (zk_p - zk) * k.mu_k; o.v = zv + (zv_p - zv) * k.mu_v;
        zr_p = zr; zk_p = zk; zv_p = zv;
        o.dec = __expf(-0.60653066f * sigmoidf_(k.w0 + rw.lw));
        const float ai = sigmoidf_(k.a0 + rw.la);
        const float kkr = kx * k.kkc, ssq = wave_sum(kkr * kkr), kk = kkr * rsqrtf(fmaxf(ssq, 1e-24f));
        o.kmod = kx * (1.f + (ai - 1.f) * k.kac); o.an = -kk; o.bn = kk * ai; o.r = r; o.lg = rw.lg; o.bin = r * o.kmod * k.rk; return o; };
    auto post = [&](float y, float bin, float v, float lg, int row, bool doit) {
        const float mean = wave_sum(y) * (1.f / 64.f), dy = y - mean, var = wave_sum(dy * dy) * (1.f / 64.f);
        const float yn = dy * rsqrtf(var + 64e-5f) * k.lnw + k.lnb;
        const float bonus = wave_sum(bin) * v;
        if (doit) mix[(size_t)row * D + 1024 + c] = f2bf((yn + bonus) * lg); };
    ScanRaw raw1 = scan_load<MODE == 1>(P, L, row0 + (nsteps > 1 ? 1 : 0), c);
    Prep pv = prep(scan_load<MODE == 1>(P, L, row0, c));
    float yp = 0.f, binp = 0.f, vp = 0.f, lgp = 0.f;
    for (int t = 0; t < nsteps; ++t) {
        const int row = row0 + t;
        const ScanRaw raw2 = scan_load<MODE == 1>(P, L, row0 + (t + 2 < nsteps ? t + 2 : nsteps - 1), c);
        W[lane] = pv.an; W[64 + lane] = pv.dec; W[128 + lane] = pv.bn; if constexpr (MODE != 2) { W[192 + lane] = pv.kmod; W[320 + lane] = pv.v; } if constexpr (MODE == 1) W[256 + lane] = pv.r;
        const Prep pn = prep(raw1);
        constexpr int NS = 2, PW = 8 / NS;
        float sa[4];
#pragma unroll
        for (int q = 0; q < 4; ++q) sa[q] = 0.f;
#pragma unroll
        for (int hf = 0; hf < NS; ++hf) {
            f32x2 av[PW];
#pragma unroll
            for (int m = 0; m < PW / 2; ++m) { const f32x4 t0 = *(const LAS f32x4*)(W + 16 * ib + 2 * PW * hf + 4 * m); av[2 * m] = (f32x2){t0.x, t0.y}; av[2 * m + 1] = (f32x2){t0.z, t0.w}; }
#pragma unroll
            for (int q = 0; q < 4; ++q) {
                f32x2 d = S[q][PW * hf] * av[0];
#pragma unroll
                for (int p = 1; p < PW; ++p) d += S[q][PW * hf + p] * av[p];
                sa[q] += d.x + d.y;
            }
        }
#pragma unroll
        for (int q = 0; q < 4; ++q) { XSUM(sa[q]) }
        float vq[4];
#pragma unroll
        for (int q = 0; q < 4; ++q) vq[q] = MODE == 2 ? 0.f : W[320 + il + 16 * q];
#pragma unroll
        for (int hf = 0; hf < NS; ++hf) {
            f32x2 wv[PW], bv[PW], kv[PW];
#pragma unroll
            for (int m = 0; m < PW / 2; ++m) { const int o_ = 16 * ib + 2 * PW * hf + 4 * m; const f32x4 t0 = *(const LAS f32x4*)(W + 64 + o_), t1 = *(const LAS f32x4*)(W + 128 + o_), t2 = MODE == 2 ? t1 : *(const LAS f32x4*)(W + 192 + o_);
                wv[2 * m] = (f32x2){t0.x, t0.y}; wv[2 * m + 1] = (f32x2){t0.z, t0.w}; bv[2 * m] = (f32x2){t1.x, t1.y}; bv[2 * m + 1] = (f32x2){t1.z, t1.w}; kv[2 * m] = (f32x2){t2.x, t2.y}; kv[2 * m + 1] = (f32x2){t2.z, t2.w}; }
#pragma unroll
            for (int q = 0; q < 4; ++q) {
                const f32x2 sa2 = (f32x2){sa[q], sa[q]}, v2 = (f32x2){vq[q], vq[q]};
#pragma unroll
                for (int p = 0; p < PW; ++p) { if constexpr (MODE == 2) S[q][PW * hf + p] = S[q][PW * hf + p] * wv[p] + sa2 * bv[p]; else S[q][PW * hf + p] = S[q][PW * hf + p] * wv[p] + (sa2 * bv[p] + v2 * kv[p]); }
            }
        }
        if constexpr (MODE == 1) {
            f32x2 rv[8];
            LDV(rv, 4)
            float yq[4];
#pragma unroll
            for (int q = 0; q < 4; ++q) { f32x2 d = S[q][0] * rv[0];
#pragma unroll
                for (int p = 1; p < 8; ++p) d += S[q][p] * rv[p];
                yq[q] = d.x + d.y; }
            const u32x2 s02 = __builtin_amdgcn_permlane32_swap(__float_as_uint(yq[0]), __float_as_uint(yq[2]), false, false);
            const u32x2 s13 = __builtin_amdgcn_permlane32_swap(__float_as_uint(yq[1]), __float_as_uint(yq[3]), false, false);
            const float r02 = __uint_as_float(s02.x) + __uint_as_float(s02.y), r13 = __uint_as_float(s13.x) + __uint_as_float(s13.y);
            const u32x2 sy = __builtin_amdgcn_permlane16_swap(__float_as_uint(r02), __float_as_uint(r13), false, false);
            const float y = __uint_as_float(sy.x) + __uint_as_float(sy.y);
            post(yp, binp, vp, lgp, row - 1, t > 0);
            yp = y; binp = pv.bin; vp = pv.v; lgp = pv.lg;
        }
        pv = pn; raw1 = raw2;
    }
    if constexpr (MODE == 1) post(yp, binp, vp, lgp, row0 + nsteps - 1, true);
#undef LDV
#undef XSUM
    if constexpr (MODE == 1) {
        if (S_final) {
#pragma unroll
            for (int q = 0; q < 4; ++q)
#pragma unroll
                for (int m = 0; m < 4; ++m) *(f32x4*)(S_final + (il + 16 * q) * 64 + 16 * ib + 4 * m) = (f32x4){S[q][2 * m].x, S[q][2 * m].y, S[q][2 * m + 1].x, S[q][2 * m + 1].y};
        }
    } else {
        float* dst = MODE == 0 ? Uout : Pout;
#pragma unroll
        for (int q = 0; q < 4; ++q)
#pragma unroll
            for (int m = 0; m < 4; ++m) *(f32x4*)(dst + (il + 16 * q) * 64 + 16 * ib + 4 * m) = (f32x4){S[q][2 * m].x, S[q][2 * m].y, S[q][2 * m + 1].x, S[q][2 * m + 1].y};
    }
}
__device__ __forceinline__ void phase_scan_a(const DArgs& a, LAS unsigned char* lds) {
    const int wave = threadIdx.x >> 6, lane = threadIdx.x & 63, gw = blockIdx.x * NWAVE + wave, ngw = gridDim.x * NWAVE;
    LAS float* W = (LAS float*)(lds + 8192 + wave * 2048);
    for (int it = gw; it < NCHK * 16; it += ngw) { const int ch = it >> 4, h = it & 15;
        scan_item<0>(a, W, ch * CHK, CHK, h, lane, ch == 0, nullptr, nullptr, nullptr, (float*)(a.wsp() + W_UC) + (size_t)it * 4096, nullptr);
        scan_item<2>(a, W, ch * CHK, CHK, h, lane, ch == 0, nullptr, nullptr, nullptr, nullptr, (float*)(a.wsp() + W_PC) + (size_t)it * 4096); }
}
__device__ __forceinline__ void phase_scan_c(const DArgs& a, LAS unsigned char* lds) {
    const int wave = threadIdx.x >> 6, lane = threadIdx.x & 63, gw = blockIdx.x * NWAVE + wave, ngw = gridDim.x * NWAVE;
    for (int it = gw; it < NCHK * 16; it += ngw) { const int ch = it >> 4, h = it & 15;
        scan_item<1>(a, (LAS float*)(lds + 8192 + wave * 2048), ch * CHK, CHK, h, lane, ch == 0, nullptr, (const float*)(a.wsp() + W_SST) + (size_t)it * 4096, nullptr, nullptr, nullptr); }
}
__device__ __forceinline__ void phase_scan_b(const DArgs& a, LAS unsigned char* lds) {
    const int wave = threadIdx.x >> 6, lane = threadIdx.x & 63;
    if (blockIdx.x < 64) {
        const int h = blockIdx.x >> 2, rg = blockIdx.x & 3, fr = lane & 15, g = lane >> 4;
        LAS float* Sb = (LAS float*)lds;
        const float* Pc = (const float*)(a.wsp() + W_PC); const float* Uc = (const float*)(a.wsp() + W_UC); float* Sst = (float*)(a.wsp() + W_SST);
        for (int i = threadIdx.x; i < 16 * 68; i += NTHR) Sb[i] = 0.f;
        if (wave < 4) {
#pragma unroll
            for (int r = 0; r < 4; ++r) Sst[(size_t)h * 4096 + (rg * 16 + 4 * g + r) * 64 + 16 * wave + fr] = 0.f;
        }
        float bq[16], uq[4];
        if (wave < 4) { const float* pc = Pc + (size_t)h * 4096; const float* uc = Uc + (size_t)h * 4096;
#pragma unroll
            for (int ks = 0; ks < 16; ++ks) bq[ks] = pc[(16 * g + ks) * 64 + 16 * wave + fr];
#pragma unroll
            for (int r = 0; r < 4; ++r) uq[r] = uc[(rg * 16 + 4 * g + r) * 64 + 16 * wave + fr]; }
        __syncthreads();
        for (int ch = 0; ch < NCHK; ++ch) {
            f32x4 acc0, acc1 = (f32x4){0.f, 0.f, 0.f, 0.f};
            if (wave < 4) {
                float bn[16], un[4];
                const int chn = ch + 1 < NCHK ? ch + 1 : ch;
                const float* pc = Pc + ((size_t)chn * 16 + h) * 4096; const float* uc = Uc + ((size_t)chn * 16 + h) * 4096;
#pragma unroll
                for (int ks = 0; ks < 16; ++ks) bn[ks] = pc[(16 * g + ks) * 64 + 16 * wave + fr];
#pragma unroll
                for (int r = 0; r < 4; ++r) un[r] = uc[(rg * 16 + 4 * g + r) * 64 + 16 * wave + fr];
                float aq[16];
#pragma unroll
                for (int q = 0; q < 4; ++q) { const f32x4 v = *(const LAS f32x4*)(Sb + fr * 68 + 16 * g + 4 * q); aq[4 * q] = v.x; aq[4 * q + 1] = v.y; aq[4 * q + 2] = v.z; aq[4 * q + 3] = v.w; }
                acc0 = (f32x4){uq[0], uq[1], uq[2], uq[3]};
#pragma unroll
                for (int ks = 0; ks < 16; ks += 2) { acc0 = __builtin_amdgcn_mfma_f32_16x16x4f32(aq[ks], bq[ks], acc0, 0, 0, 0); acc1 = __builtin_amdgcn_mfma_f32_16x16x4f32(aq[ks + 1], bq[ks + 1], acc1, 0, 0, 0); }
                acc0 += acc1;
#pragma unroll
                for (int ks = 0; ks < 16; ++ks) bq[ks] = bn[ks];
#pragma unroll
                for (int r = 0; r < 4; ++r) uq[r] = un[r];
            }
            __syncthreads();
            if (wave < 4) {
                float* dst = ch + 1 < NCHK ? Sst + ((size_t)(ch + 1) * 16 + h) * 4096 : a.outp() + O_WKVP + (size_t)h * 4096;
#pragma unroll
                for (int r = 0; r < 4; ++r) { Sb[(4 * g + r) * 68 + 16 * wave + fr] = acc0[r]; dst[(rg * 16 + 4 * g + r) * 64 + 16 * wave + fr] = acc0[r]; }
            }
            __syncthreads();
        }
    } else {
        const int it = (blockIdx.x - 64) * NWAVE + wave;
        if (it < 128) { const int b = it >> 4, h = it & 15;
            scan_item<1>(a, (LAS float*)(lds + 8192 + wave * 2048), TP + b * 32, 32, h, lane, true, a.in(I_SSHIFT) + (size_t)b * DSHIFT, a.in(I_SWKV) + ((size_t)b * 16 + h) * 4096,
                         a.outp() + O_WKVS + ((size_t)b * 16 + h) * 4096, nullptr, nullptr); }
    }
}

__device__ __forceinline__ void phase_attn_prep(const DArgs& a, LAS unsigned char* lds) {
    const int wave = threadIdx.x >> 6, lane = threadIdx.x & 63, gw = blockIdx.x * NWAVE + wave, ngw = gridDim.x * NWAVE;
    const int gt = blockIdx.x * NTHR + threadIdx.x, ngt = gridDim.x * NTHR;
    const bf16_t* qk = (const bf16_t*)(a.wsp() + W_QK); const bf16_t* vT = (const bf16_t*)(a.wsp() + W_VT);
    bf16_t* Ks = (bf16_t*)(a.wsp() + W_KS); bf16_t* VsT = (bf16_t*)(a.wsp() + W_VST);
    for (int i = gt; i < 8 * 576 * 256; i += ngt) {
        const int c8 = i & 255, kk = (i >> 8) % 576, b = i / (576 * 256);
        u32x4 w = (u32x4){0u, 0u, 0u, 0u};
        if (kk < 512) { float v[8]; ld8f(a.in(I_CK) + ((size_t)b * 512 + kk) * D + c8 * 8, v); w.x = pk2(v[0], v[1]); w.y = pk2(v[2], v[3]); w.z = pk2(v[4], v[5]); w.w = pk2(v[6], v[7]); }
        else if (kk < 544) w = *(const u32x4*)(qk + (size_t)(TP + b * 32 + kk - 512) * 4096 + 2048 + c8 * 8);
        *(u32x4*)(Ks + ((size_t)b * 576 + kk) * D + c8 * 8) = w;
    }
    LAS float* scr = (LAS float*)(lds + wave * 8448);
    for (int it = gw; it < 8 * 512; it += ngw) { const int b = it >> 9, r = it & 511, kb = r >> 6, nb = r & 63;
        transpose_item(a.in(I_CV) + (size_t)b * 512 * D, D, VsT + (size_t)b * D * 576, 576, scr, kb * 64, nb * 32, lane); }
    for (int i = gt; i < 8 * D * 8; i += ngt) {
        const int g8 = i & 7, c = (i >> 3) & (D - 1), b = i >> 14;
        u32x4 w = (u32x4){0u, 0u, 0u, 0u};
        if (g8 < 4) w = *(const u32x4*)(vT + (size_t)c * TA + TP + b * 32 + g8 * 8);
        *(u32x4*)(VsT + ((size_t)b * D + c) * 576 + 512 + g8 * 8) = w;
    }
    for (int i = gt; i < 512 * D; i += ngt) { const int r = i >> 11, c = i & (D - 1);
        a.outp()[O_KP + i] = bf2f(qk[(size_t)(TP - 512 + r) * 4096 + 2048 + c]); a.outp()[O_VP + i] = bf2f(vT[(size_t)c * TA + TP - 512 + r]); }
    for (int i = gt; i < TS * D; i += ngt) { const int r = i >> 11, c = i & (D - 1);
        a.outp()[O_KS + i] = bf2f(qk[(size_t)(TP + r) * 4096 + 2048 + c]); a.outp()[O_VS + i] = bf2f(vT[(size_t)c * TA + TP + r]); }
}
constexpr int KT_LD = 272, VT_LD = 144;
constexpr int A_K = 0, A_V = 64 * KT_LD, A_B = A_V + 128 * VT_LD;
__device__ __forceinline__ void phase_attn(const DArgs& a, LAS unsigned char* lds) {
    const int tid = threadIdx.x, wave = tid >> 6, lane = tid & 63, fr = lane & 15, g = lane >> 4;
    const bf16_t* qk = (const bf16_t*)(a.wsp() + W_QK); const bf16_t* vT = (const bf16_t*)(a.wsp() + W_VT);
    const bf16_t* Ks = (const bf16_t*)(a.wsp() + W_KS); const bf16_t* VsT = (const bf16_t*)(a.wsp() + W_VST);
    const float* relb = a.in(I_RELB);
    bf16_t* oatt = (bf16_t*)(a.wsp() + W_MIX);
    LAS float* biasT = (LAS float*)(lds + A_B);
    const float scale = 0.08838834764831845f;
    constexpr int NITEMS = 2048 + 128;
    struct Item { int h, qrow, qpos, tile_lo, tile_hi, qc, nkeys, ldk, ldv, kpos_base; const bf16_t* Kb; const bf16_t* Vb; bool wact, prompt; };
    auto setup = [&](int it) -> Item { Item I; I.prompt = it < 2048; I.qc = 0;
        if (I.prompt) { const int pi = it >> 4; I.h = it & 15; I.qc = 2 * pi + (wave >> 2); I.qrow = I.qc * 64 + (wave & 3) * 16 + fr; I.qpos = I.qrow;
            I.tile_lo = 2 * pi - 8 < 0 ? 0 : 2 * pi - 8; I.tile_hi = 2 * pi + 1; I.nkeys = 1 << 30; I.ldk = 4096; I.ldv = TA; I.kpos_base = 0;
            I.Kb = qk + 2048 + I.h * 128; I.Vb = vT + (size_t)(I.h * 128) * TA; I.wact = true; }
        else { const int s_ = it - 2048, b = s_ >> 4; I.h = s_ & 15; const int w2 = wave & 1; I.qrow = TP + b * 32 + w2 * 16 + fr; I.qpos = 2048 + w2 * 16 + fr;
            I.tile_lo = 0; I.tile_hi = 8; I.nkeys = 544; I.ldk = D; I.ldv = 576; I.kpos_base = 1536;
            I.Kb = Ks + (size_t)b * 576 * D + I.h * 128; I.Vb = VsT + ((size_t)b * D + I.h * 128) * 576; I.wact = wave < 2; }
        return I; };
    u32x4 kreg[2], vreg[2];
    const int kr = tid >> 4, kc = tid & 15, vr = tid >> 3, vc = tid & 7;
#define ATT_LOAD(I_, tile) do { _Pragma("unroll") for (int p_ = 0; p_ < 2; ++p_) { \
        kreg[p_] = *(const u32x4*)((I_).Kb + (size_t)((tile) * 64 + kr + 32 * p_) * (I_).ldk + kc * 8); \
        vreg[p_] = *(const u32x4*)((I_).Vb + (size_t)(vr + 64 * p_) * (I_).ldv + (tile) * 64 + vc * 8); } } while (0)
#define ATT_STORE() do { _Pragma("unroll") for (int p_ = 0; p_ < 2; ++p_) { \
        *(LAS u32x4*)(lds + A_K + (kr + 32 * p_) * KT_LD + kc * 16) = kreg[p_]; \
        *(LAS u32x4*)(lds + A_V + (vr + 64 * p_) * VT_LD + vc * 16) = vreg[p_]; } } while (0)
#define ATT_LOADQ(dst_, I_) do { _Pragma("unroll") for (int ks = 0; ks < 4; ++ks) dst_[ks] = *(const bf16x8*)(qk + (size_t)(I_).qrow * 4096 + (I_).h * 128 + 32 * ks + 8 * g); } while (0)
    if ((int)blockIdx.x >= NITEMS) return;
    Item cur = setup(blockIdx.x);
    bf16x8 qf[4], qfn[4];
    float biasn = tid < 257 ? relb[cur.h * 257 + tid] : 0.f;
    ATT_LOADQ(qf, cur);
    ATT_LOAD(cur, cur.tile_lo);
    for (int it = blockIdx.x; it < NITEMS; it += gridDim.x) {
        const bool has_next = it + (int)gridDim.x < NITEMS;
        const Item nxt = setup(has_next ? it + (int)gridDim.x : it);
        f32x4 oacc[8];
#pragma unroll
        for (int n = 0; n < 8; ++n) oacc[n] = (f32x4){0.f, 0.f, 0.f, 0.f};
        float mrun = -1e30f, lrun = 0.f;
        __syncthreads();
        ATT_STORE();
        if (tid < 257) biasT[tid] = biasn;
        __syncthreads();
        for (int tile = cur.tile_lo; tile <= cur.tile_hi; ++tile) {
            if (tile < cur.tile_hi) ATT_LOAD(cur, tile + 1);
            else if (has_next) { ATT_LOAD(nxt, nxt.tile_lo); ATT_LOADQ(qfn, nxt); biasn = tid < 257 ? relb[nxt.h * 257 + tid] : 0.f; }
            const bool act = cur.wact && (!cur.prompt || (tile >= cur.qc - 8 && tile <= cur.qc));
            if (act) {
                f32x4 sacc[4];
#pragma unroll
                for (int kt = 0; kt < 4; ++kt) { sacc[kt] = (f32x4){0.f, 0.f, 0.f, 0.f};
#pragma unroll
                    for (int ks = 0; ks < 4; ++ks) { const bf16x8 kf = *(const LAS bf16x8*)(lds + A_K + (16 * kt + fr) * KT_LD + (32 * ks + 8 * g) * 2);
                        sacc[kt] = __builtin_amdgcn_mfma_f32_16x16x32_bf16(kf, qf[ks], sacc[kt], 0, 0, 0); } }
                const int kpos0 = cur.kpos_base + tile * 64, kidx0 = tile * 64;
                float tmax = -1e30f;
#pragma unroll
                for (int kt = 0; kt < 4; ++kt)
#pragma unroll
                    for (int r = 0; r < 4; ++r) { const int key = 16 * kt + 4 * g + r; float bias;
                        { int rel = cur.qpos - (kpos0 + key); rel = rel < -128 ? -128 : (rel > 128 ? 128 : rel); bias = biasT[rel + 128]; }
                        float s_ = sacc[kt][r] * scale + bias; if (kidx0 + key >= cur.nkeys) s_ = -1e30f; sacc[kt][r] = s_; tmax = fmaxf(tmax, s_); }
                tmax = fmaxf(tmax, __shfl_xor(tmax, 16)); tmax = fmaxf(tmax, __shfl_xor(tmax, 32));
                const float mnew = fmaxf(mrun, tmax), alpha = __expf(mrun - mnew); mrun = mnew;
                float psum = 0.f;
#pragma unroll
                for (int kt = 0; kt < 4; ++kt)
#pragma unroll
                    for (int r = 0; r < 4; ++r) { const float p_ = __expf(sacc[kt][r] - mnew); sacc[kt][r] = p_; psum += p_; }
                lrun = lrun * alpha + psum;
#pragma unroll
                for (int n = 0; n < 8; ++n) oacc[n] = oacc[n] * alpha;
#pragma unroll
                for (int j = 0; j < 2; ++j) {
                    u32x4 pw; pw.x = pk2(sacc[2 * j][0], sacc[2 * j][1]); pw.y = pk2(sacc[2 * j][2], sacc[2 * j][3]); pw.z = pk2(sacc[2 * j + 1][0], sacc[2 * j + 1][1]); pw.w = pk2(sacc[2 * j + 1][2], sacc[2 * j + 1][3]);
                    const bf16x8 pf = __builtin_bit_cast(bf16x8, pw);
#pragma unroll
                    for (int n = 0; n < 8; ++n) {
                        const u32x2 v0 = *(const LAS u32x2*)(lds + A_V + (16 * n + fr) * VT_LD + (32 * j + 4 * g) * 2);
                        const u32x2 v1 = *(const LAS u32x2*)(lds + A_V + (16 * n + fr) * VT_LD + (32 * j + 16 + 4 * g) * 2);
                        const bf16x8 vf = __builtin_bit_cast(bf16x8, (u32x4){v0.x, v0.y, v1.x, v1.y});
                        oacc[n] = __builtin_amdgcn_mfma_f32_16x16x32_bf16(vf, pf, oacc[n], 0, 0, 0);
                    }
                }
            }
            if (tile < cur.tile_hi) { __syncthreads(); ATT_STORE(); __syncthreads(); }
        }
        if (cur.wact) {
            float l = lrun; l += __shfl_xor(l, 16); l += __shfl_xor(l, 32);
            const float inv = 1.f / l;
#pragma unroll
            for (int n = 0; n < 8; ++n) { u32x2 w; w.x = pk2(oacc[n][0] * inv, oacc[n][1] * inv); w.y = pk2(oacc[n][2] * inv, oacc[n][3] * inv);
                *(u32x2*)(oatt + (size_t)cur.qrow * D + cur.h * 128 + 16 * n + 4 * g) = w; }
        }
        cur = nxt;
#pragma unroll
        for (int ks = 0; ks < 4; ++ks) qf[ks] = qfn[ks];
    }
    __syncthreads();
#undef ATT_LOAD
#undef ATT_STORE
#undef ATT_LOADQ
}


#define XB_TMO      128
#define XB_XCNT(j)  (256  + 64 * (j))
#define XB_XSUB(j)  (1280 + 64 * (j))
#define XB_XGEN(j)  (2304 + 64 * (j))
#define XB_TOP      3328
#define XB_TOPGEN   3392
#define XCD_BAR_WORDS 3456
#define XB_SPIN_CAP (1u << 18)
__device__ __forceinline__ unsigned xb_ld(unsigned* p)              { return __hip_atomic_load(p, __ATOMIC_RELAXED, __HIP_MEMORY_SCOPE_AGENT); }
__device__ __forceinline__ unsigned xb_add(unsigned* p, unsigned v) { return __hip_atomic_fetch_add(p, v, __ATOMIC_RELAXED, __HIP_MEMORY_SCOPE_AGENT); }
__device__ __forceinline__ unsigned xb_xcc_id() { return (unsigned)__builtin_amdgcn_s_getreg((3 << 11) | 20) & 0xFu; }
#define XB_SPIN(cond, bar) do { unsigned _sp = 0; while (cond) { __builtin_amdgcn_s_sleep(1); \
    if ((++_sp & 255u) == 0u) { if (xb_ld(&(bar)[XB_TMO])) break; if (_sp > XB_SPIN_CAP) { atomicAdd(&(bar)[XB_TMO], 1u); break; } } } } while (0)
struct XcdBarrier { unsigned* bar; unsigned x; volatile LAS unsigned* st; };
__device__ __forceinline__ XcdBarrier xcd_barrier_post(unsigned* bar, volatile LAS unsigned* st) {
    XcdBarrier b; b.bar = bar; b.x = xb_xcc_id(); b.st = st;
    if (threadIdx.x == 0) (void)xb_add(&bar[XB_XCNT(b.x)], 1u);
    return b;
}
__device__ __forceinline__ void xcd_barrier_complete(unsigned* bar, unsigned x, unsigned& nloc, unsigned& nx) {
    const unsigned G = gridDim.x * gridDim.y * gridDim.z;
    unsigned sum, cnt, mine, sp = 0u;
    for (;;) {
        sum = 0u; cnt = 0u; mine = 0u;
#pragma unroll
        for (unsigned j = 0; j < 16; ++j) { const unsigned c = xb_ld(&bar[XB_XCNT(j)]); sum += c; cnt += (c > 0u) ? 1u : 0u; mine = (j == x) ? c : mine; }
        if (sum == G) break;
        __builtin_amdgcn_s_sleep(1);
        if ((++sp & 255u) == 0u) { if (xb_ld(&bar[XB_TMO])) break; if (sp > XB_SPIN_CAP) { atomicAdd(&bar[XB_TMO], 1u); break; } }
    }
    nloc = mine > 0u ? mine : 1u; nx = cnt > 0u ? cnt : 1u;
}
__device__ __forceinline__ void xcd_barrier(const XcdBarrier& b) {
    asm volatile("s_waitcnt vmcnt(0)" ::: "memory");
    __syncthreads();
    if (threadIdx.x == 0) {
        unsigned* bar = b.bar;
        __builtin_amdgcn_s_waitcnt(0);
        unsigned nloc = b.st[0], nx = b.st[1];
        if (nloc == 0u) { xcd_barrier_complete(bar, b.x, nloc, nx); b.st[0] = nloc; b.st[1] = nx; }
        const unsigned old = xb_add(&bar[XB_XSUB(b.x)], 1u);
        const unsigned gen = old / nloc;
        if (old + 1u == (gen + 1u) * nloc) {
            __builtin_amdgcn_fence(__ATOMIC_RELEASE, "agent");
            asm volatile("s_waitcnt vmcnt(0)" ::: "memory");
            const unsigned og = xb_add(&bar[XB_TOP], 1u);
            const unsigned tg = og / nx;
            if (og + 1u == (tg + 1u) * nx) xb_add(&bar[XB_TOPGEN], 1u);
            else XB_SPIN(xb_ld(&bar[XB_TOPGEN]) == tg, bar);
            __builtin_amdgcn_fence(__ATOMIC_ACQUIRE, "agent");
            xb_add(&bar[XB_XGEN(b.x)], 1u);
            asm volatile("s_waitcnt vmcnt(0)" ::: "memory");
        } else {
            XB_SPIN(xb_ld(&bar[XB_XGEN(b.x)]) == gen, bar);
            __builtin_amdgcn_fence(__ATOMIC_ACQUIRE, "agent");
            asm volatile("s_waitcnt vmcnt(0)" ::: "memory");
        }
    }
    __syncthreads();
}

__global__ __launch_bounds__(512, 2) void mega(Args aa) {
    extern __shared__ __attribute__((aligned(16))) unsigned char shm[];
    LAS unsigned char* lds = (LAS unsigned char*)shm;
    cg::grid_group grid = cg::this_grid();
    {
        LAS unsigned long long* tabw = (LAS unsigned long long*)(lds + 131072);
        if (threadIdx.x == 0) {
#pragma unroll
            for (int i = 0; i < 32; ++i) tabw[i] = (unsigned long long)aa.in[i];
            tabw[32] = (unsigned long long)aa.out; tabw[33] = (unsigned long long)aa.ws;
        }
        __syncthreads();
    }
    DArgs a; a.tab = (LAS const unsigned long long*)(lds + 131072); a.ph_lo = aa.ph_lo; a.ph_hi = aa.ph_hi;
    volatile LAS unsigned* xb_st = (volatile LAS unsigned*)(lds + 131072 + 448);
    if (threadIdx.x == 0) { xb_st[0] = 0u; xb_st[1] = 0u; }
    __syncthreads();
    const XcdBarrier xb = xcd_barrier_post((unsigned*)(__attribute__((address_space(1))) unsigned*)(a.wsp() + W_BAR), xb_st);
#define gn a.in(I_GNORM)
#define ws a.wsp()
    const int nM = TA / 256;
#ifndef PHMASK
#define PHMASK 0x3fffff
#endif
#ifndef DUPMASK
#define DUPMASK 0
#endif
#define PH(p) if (((PHMASK >> (p)) & 1) && a.ph_lo <= (p) && (p) < a.ph_hi) for (int rep_ = 0; rep_ < (((DUPMASK >> (p)) & 1) ? 2 : 1); ++rep_, (((DUPMASK >> (p)) & 1) && rep_ < 2 ? grid.sync() : (void)0))
#define SYNC(p) if (a.ph_lo <= (p) && (p) + 1 < a.ph_hi) xcd_barrier(xb);
    if (a.ph_lo < 0) grid.sync();
    PH(0) { phase_mod_partial(a, lds); phase_convert(a, lds); }
    SYNC(0)
    PH(1) { phase_mod_final(a); }
    SYNC(1)
    PH(2) { phase_rowwise<true, false, true>(a, nullptr, 0, 0, gn + 0 * D, 0, 1, 0); }
    SYNC(2)
    PH(3) { pg8::EpiBf16<0> E{(bf16_t*)(ws + W_P), DIN0, nullptr};
        run_gemm(lds, D, D, D, ws + W_HA, ws + W_IN0T, nM, DIN0 / 256, 0, nullptr, nullptr, 0, 0, E);
        const int c0 = (nM * (DIN0 / 256)) % (int)gridDim.x; convert_sub(a, lds, CV_OUT0, c0); convert_sub(a, lds, CV_FF1_0, c0); }
    SYNC(3)
    PH(4) { phase_prep(a); }
    SYNC(4)
    PH(5) { { pg8::EpiBf16<0> E{(bf16_t*)(ws + W_MIX), D, nullptr};
          run_gemm(lds, 256, 1280, 256, ws + W_AL, ws + W_POOLT, nM, 4, 512, nullptr, nullptr, 0, 0, E); }
        { pg8::EpiF32 E{(float*)(ws + W_L), 3072};
          run_gemm(lds, 256, 1280, 256, ws + W_AL + 2048, ws + W_LORAT, nM, 12, 0, nullptr, nullptr, 0, 0, E); } }
    SYNC(5)
    PH(6) { phase_scan_a(a, lds); }
    SYNC(6)
    PH(7) { phase_scan_b(a, lds); }
    SYNC(7)
    PH(8) { phase_scan_c(a, lds); }
    SYNC(8)
    PH(9) { pg8::Epi2<pg8::EpiBf16<0>, pg8::EpiPartF32> E{{(bf16_t*)(ws + W_O), D, nullptr}, {(float*)(ws + W_OACC), D}};
        run_gemm(lds, D, D, D, ws + W_MIX, ws + W_OUT0T, 64, 8, 0, ws + W_MIX, ws + W_OUT0T, 0, 8, E, 8, 64); }
    SYNC(9)
    PH(10) { phase_rowwise<true, true, true>(a, gn + 1 * D, 0, 2, gn + 2 * D, 0, 4, 3, 8); }
    SYNC(10)
    PH(11) { pg8::EpiBf16<1> E{(bf16_t*)(ws + W_F1), DFF, nullptr};
        run_gemm(lds, D, D, D, ws + W_HA, ws + W_FF1T, nM, DFF / 256, 0, nullptr, nullptr, 0, 0, E);
        const int c0 = (nM * (DFF / 256)) % (int)gridDim.x; convert_sub(a, lds, CV_FF2_0, c0); convert_sub(a, lds, CV_QKV, c0); }
    SYNC(11)
    PH(12) { pg8::Epi2<pg8::EpiBf16<0>, pg8::EpiPartF32> E{{(bf16_t*)(ws + W_O), D, nullptr}, {(float*)(ws + W_OACC), D}};
        run_gemm(lds, DFF, DFF, DFF, ws + W_F1, ws + W_FF2T, 64, 8, 0, ws + W_F1, ws + W_FF2T, 0, 8, E, 32, 64); }
    SYNC(12)
    PH(13) { phase_rowwise<false, true, true>(a, gn + 3 * D, 0, 5, gn + 4 * D, 1, 1, 0, 32); }
    SYNC(13)
    PH(14) { pg8::Epi2<pg8::EpiBf16<0>, pg8::EpiBf16<0>> E{{(bf16_t*)(ws + W_QK), 4096, nullptr}, {(bf16_t*)(ws + W_VT), TA, nullptr}};
        run_gemm(lds, D, D, D, ws + W_HA, ws + W_QKVT, nM, 16, 0, ws + W_QKVT + (size_t)4096 * D * 2, ws + W_HA, 8, nM, E);
        const int c0 = (nM * 24) % (int)gridDim.x; convert_sub(a, lds, CV_OUT1, c0); convert_sub(a, lds, CV_FF1_1, c0); }
    SYNC(14)
    PH(15) { phase_attn_prep(a, lds); }
    SYNC(15)
    PH(16) { phase_attn(a, lds); }
    SYNC(16)
    PH(17) { pg8::Epi2<pg8::EpiBf16<0>, pg8::EpiPartF32> E{{(bf16_t*)(ws + W_O), D, nullptr}, {(float*)(ws + W_OACC), D}};
        run_gemm(lds, D, D, D, ws + W_MIX, ws + W_OUT1T, 64, 8, 0, ws + W_MIX, ws + W_OUT1T, 0, 8, E, 8, 64); }
    SYNC(17)
    PH(18) { phase_rowwise<false, true, true>(a, gn + 5 * D, 1, 2, gn + 6 * D, 1, 4, 3, 8); }
    SYNC(18)
    PH(19) { pg8::EpiBf16<1> E{(bf16_t*)(ws + W_F1), DFF, nullptr};
        run_gemm(lds, D, D, D, ws + W_HA, ws + W_FF1T, nM, DFF / 256, 0, nullptr, nullptr, 0, 0, E);
        const int c0 = (nM * (DFF / 256)) % (int)gridDim.x; convert_sub(a, lds, CV_FF2_1, c0); }
    SYNC(19)
    PH(20) { pg8::Epi2<pg8::EpiBf16<0>, pg8::EpiPartF32> E{{(bf16_t*)(ws + W_O), D, nullptr}, {(float*)(ws + W_OACC), D}};
        run_gemm(lds, DFF, DFF, DFF, ws + W_F1, ws + W_FF2T, 64, 8, 0, ws + W_F1, ws + W_FF2T, 0, 8, E, 32, 64); }
    SYNC(20)
    PH(21) { phase_rowwise<false, true, false>(a, gn + 7 * D, 1, 5, nullptr, 0, 0, 0, 32); }
#undef PH
#undef SYNC
#undef gn
#undef ws
}

constexpr int NPHASE = 22;
#ifndef MK_MULTI
#define MK_MULTI 0
#endif
extern "C" void kernel_launch(void* const* d_in, const int* in_sizes, int n_in, void* d_out, int out_size, void* d_ws, size_t ws_size, hipStream_t stream) {
    static int grid = 0;
    constexpr int LDS_BYTES = 131072 + 512;
    if (grid == 0) {
        if (n_in != 32 || ws_size < WS_TOTAL) { fprintf(stderr, "kernel_launch: unexpected n_in %d / ws %zu (need %zu)\n", n_in, ws_size, (size_t)WS_TOTAL); grid = -1; return; }
        int dev = 0, cus = 0, per_cu = 0;
        hipGetDevice(&dev); hipDeviceGetAttribute(&cus, hipDeviceAttributeMultiprocessorCount, dev);
        if (hipFuncSetAttribute((const void*)mega, hipFuncAttributeMaxDynamicSharedMemorySize, LDS_BYTES) != hipSuccess) { fprintf(stderr, "kernel_launch: hipFuncSetAttribute failed\n"); grid = -1; return; }
        hipOccupancyMaxActiveBlocksPerMultiprocessor(&per_cu, (const void*)mega, NTHR, LDS_BYTES);
        if (per_cu < 1) { fprintf(stderr, "kernel_launch: occupancy query says %d blocks per CU\n", per_cu); per_cu = 1; }
        (void)hipGetLastError();
        grid = cus;
    }
    if (grid < 0) return;
    Args a{};
    for (int i = 0; i < 32; ++i) a.in[i] = (const float*)d_in[i];
    a.out = (float*)d_out; a.ws = (unsigned char*)d_ws;
#if MK_MULTI
    for (int p = 0; p < NPHASE; ++p) { a.ph_lo = p; a.ph_hi = p + 1; hipLaunchKernelGGL(mega, dim3(grid), dim3(NTHR), LDS_BYTES, stream, a); }
#else
    a.ph_lo = 0; a.ph_hi = NPHASE;
    if (hipMemsetAsync((char*)d_ws + W_BAR, 0, XCD_BAR_WORDS * 4, stream) != hipSuccess) { fprintf(stderr, "kernel_launch: memset of barrier words failed\n"); return; }
    void* args[] = {&a};
    hipError_t e = hipLaunchCooperativeKernel((const void*)mega, dim3(grid), dim3(NTHR), args, LDS_BYTES, stream);
    if (e != hipSuccess) fprintf(stderr, "kernel_launch: cooperative launch failed: %s (grid %d)\n", hipGetErrorString(e), grid);
#endif
}
```

```cpp
#include <hip/hip_runtime.h>
#include <hip/hip_cooperative_groups.h>
#include <cstdio>
#include <cstdint>
namespace cg = cooperative_groups;

#define LAS __attribute__((address_space(3)))
typedef unsigned short bf16_t;
typedef short bf16x8 __attribute__((ext_vector_type(8)));
typedef short bf16x4 __attribute__((ext_vector_type(4)));
typedef float f32x4 __attribute__((ext_vector_type(4)));
typedef float f32x2 __attribute__((ext_vector_type(2)));
typedef unsigned u32x4 __attribute__((ext_vector_type(4)));
typedef unsigned u32x2 __attribute__((ext_vector_type(2)));

constexpr int TP = 16384, TS = 256, TA = TP + TS;
constexpr int D = 2048, DFF = 8192, DIN0 = 4352, DPOOL = 1024, DSHIFT = 3328;
constexpr int NWAVE = 8, NTHR = 512;
constexpr int CHK = 128, NCHK = TP / CHK;
constexpr size_t O_Y = 0, O_POOLP = 34078720, O_POOLS = 34094080, O_SHIFTP = 34216960, O_SHIFTS = 34220288,
                 O_WKVP = 34246912, O_WKVS = 34312448, O_KP = 34836736, O_VP = 35885312, O_KS = 36933888, O_VS = 37458176;
constexpr size_t W_IN0T = 0, W_OUT0T = 17825792, W_QKVT = 26214400, W_OUT1T = 51380224, W_FF1T = 59768832, W_FF2T = 93323264,
                 W_POOLT = 126877696, W_LORAT = 127401984, W_MOD = 128974848, W_MODPART = 129859584,
                 W_HA = 144015360, W_MIX = 212172800, W_O = 280330240, W_R = 348487680, WS_END = 697794560;
constexpr size_t W_AL = W_HA;
constexpr size_t W_SST = W_HA;
constexpr size_t W_PC = W_O, W_UC = W_O + 33554432;
constexpr size_t W_P = W_R, W_L = W_R + 144834560;
constexpr size_t W_F1 = W_R;
constexpr size_t W_QK = W_R, W_VT = W_R + 136314880, W_KS = W_R + 204472320, W_VST = W_R + 223346688;
constexpr int KSPLIT = 16;
constexpr size_t W_BAR = WS_END, WS_TOTAL = WS_END + 16384;
constexpr size_t W_OACC = W_R + 272629760, WS_END2 = WS_END;

struct Args {
    const float* in[32];
    float* out;
    unsigned char* ws;
    int ph_lo, ph_hi;
};
struct DArgs {
    LAS const unsigned long long* tab; int ph_lo, ph_hi;
    __device__ __forceinline__ unsigned long long ld(int i) const { const unsigned long long v = tab[i];
        const unsigned lo = __builtin_amdgcn_readfirstlane((unsigned)v), hi = __builtin_amdgcn_readfirstlane((unsigned)(v >> 32)); return ((unsigned long long)hi << 32) | lo; }
    __device__ __forceinline__ const float* in(int i) const { return (const float*)(const __attribute__((address_space(1))) float*)ld(i); }
    __device__ __forceinline__ float* outp() const { return (float*)(__attribute__((address_space(1))) float*)ld(32); }
    __device__ __forceinline__ unsigned char* wsp() const { return (unsigned char*)(__attribute__((address_space(1))) unsigned char*)ld(33); }
};
enum { I_XP = 0, I_XS, I_CP, I_CS, I_SPOOL, I_SSHIFT, I_SWKV, I_CK, I_CV, I_WADA, I_BADA, I_GNORM, I_WIN0, I_WPOOL, I_PSCALE, I_MU,
       I_W0, I_W2, I_A0, I_A2, I_G2, I_KK, I_KA, I_RK, I_LNW, I_LNB, I_WOUT0, I_WQKV, I_RELB, I_WOUT1, I_WFF1, I_WFF2 };

__device__ __forceinline__ float bf2f(bf16_t b) { return __uint_as_float(((unsigned)b) << 16); }
__device__ __forceinline__ float bflo(unsigned w) { return __uint_as_float(w << 16); }
__device__ __forceinline__ float bfhi(unsigned w) { return __uint_as_float(w & 0xffff0000u); }
__device__ __forceinline__ unsigned pk2(float lo, float hi) { unsigned r; asm("v_cvt_pk_bf16_f32 %0, %1, %2" : "=v"(r) : "v"(lo), "v"(hi)); return r; }
__device__ __forceinline__ bf16_t f2bf(float f) { return (bf16_t)(pk2(f, 0.f) & 0xffffu); }
__device__ __forceinline__ float rl(float v, int l) { return __int_as_float(__builtin_amdgcn_readlane(__float_as_int(v), l)); }
template <int CTRL> __device__ __forceinline__ float dppf(float v) { return __int_as_float(__builtin_amdgcn_update_dpp(0, __float_as_int(v), CTRL, 0xf, 0xf, false)); }
__device__ __forceinline__ float wave_sum(float v) {
    v += dppf<0xB1>(v); v += dppf<0x4E>(v); v += dppf<0x141>(v); v += dppf<0x140>(v);
    return (rl(v, 0) + rl(v, 16)) + (rl(v, 32) + rl(v, 48));
}
__device__ __forceinline__ float sigmoidf_(float x) { return __builtin_amdgcn_rcpf(1.f + __expf(-x)); }
__device__ __forceinline__ int entry_of(int row) { return row < TP ? 0 : 1 + ((row - TP) >> 5); }

namespace pg8 {
constexpr int BM = 256, BK = 64, HALF = 128, HTB = HALF * BK * 2, STAGE_BYTES = 8 * HTB, NXCD = 8, WGM = 8;
__device__ __forceinline__ int lds_byte(int r, int c) { const int st = (r >> 4) * 2 + (c >> 5), rr = r & 15, cc = c & 31, ob = rr * 64 + cc * 2; return st * 1024 + (ob ^ (((ob >> 9) & 1) << 5)); }
__device__ __forceinline__ void stage_rc(int b, int& R, int& C) { const int st = b / 1024, sb = b % 1024, swz = sb ^ (((sb >> 9) & 1) << 5); R = (st >> 1) * 16 + swz / 64; C = (st & 1) * 32 + (swz % 64) / 2; }
__device__ __forceinline__ int perm32(int rho) { const int n = rho >> 4, i = rho & 15; return 8 * (i >> 2) + 4 * n + (i & 3); }

struct Unit { const char* a; const char* b; int pm, pn, g, nt, sl; };
struct GDesc { const char* A; const char* B; int nM, nN; long a_pn_off; };
struct Sched {
    GDesc g0, g1; int n0, n1, G, c; long tstepA, tstepB; int nt0, S1, nt1, pm1; long ksb;
    __device__ __forceinline__ void decode(const GDesc& g, int L, Unit& u, int gi) const {
        const int nwg = g.nM * g.nN; int wgid = L;
        { const int q = nwg / NXCD, r = nwg % NXCD, xcd = wgid % NXCD, off = wgid / NXCD; wgid = (xcd < r ? xcd * (q + 1) : r * (q + 1) + (xcd - r) * q) + off; }
        const int nig = WGM * g.nN, gid = wgid / nig, fm = gid * WGM, gsz = (g.nM - fm) < WGM ? (g.nM - fm) : WGM;
        u.pm = fm + ((wgid % nig) % gsz); u.pn = (wgid % nig) / gsz; u.g = gi;
        u.a = g.A + (long)u.pm * tstepA + (long)u.pn * g.a_pn_off; u.b = g.B + (long)u.pn * tstepB;
    }
    __device__ __forceinline__ bool next(int i, Unit& u) const {
        const long L = (long)i * G + c;
        if (L < n0) { decode(g0, (int)L, u, 0); u.nt = nt0; return true; }
        if (L < n0 + n1) {
            if (S1 == 0) { decode(g1, (int)(L - n0), u, 1); u.nt = nt0; }
            else { const int q = (int)(L - n0), sl = q / g1.nN, pn = q % g1.nN; u.pm = pm1; u.pn = pn; u.g = 1; u.nt = nt1; u.sl = sl;
                u.a = g1.A + (long)pm1 * tstepA + (long)sl * ksb; u.b = g1.B + (long)pn * tstepB + (long)sl * ksb; }
            return true; }
        return false;
    }
};

template <int ACT> struct EpiBf16 {
    bf16_t* O; int ldc; const float* cs;
    __device__ __forceinline__ void operator()(const f32x4 (&acc)[2][2][4][2], const Unit& u, int wr, int wc, int fr, int fq) const {
        const int row0 = u.pm * BM + wr * 64 + fr, col0 = u.pn * BM + wc * 32 + 8 * fq;
        f32x4 sv[2][2];
        if (ACT == 2) {
#pragma unroll
            for (int bj = 0; bj < 2; ++bj)
#pragma unroll
                for (int n = 0; n < 2; ++n) sv[bj][n] = *(const f32x4*)(cs + col0 + bj * HALF + 4 * n);
        }
#pragma unroll
        for (int ai = 0; ai < 2; ++ai)
#pragma unroll
            for (int m = 0; m < 4; ++m) { bf16_t* rowp = O + (size_t)(row0 + ai * HALF + m * 16) * ldc + col0;
#pragma unroll
                for (int bj = 0; bj < 2; ++bj) { f32x4 v0 = acc[ai][bj][m][0], v1 = acc[ai][bj][m][1];
                    if (ACT == 1) {
#pragma unroll
                        for (int j = 0; j < 4; ++j) { const float a0 = fmaxf(v0[j], 0.f), a1 = fmaxf(v1[j], 0.f); v0[j] = a0 * a0; v1[j] = a1 * a1; } }
                    if (ACT == 2) { v0 = v0 * sv[bj][0]; v1 = v1 * sv[bj][1]; }
                    u32x4 w; w.x = pk2(v0[0], v0[1]); w.y = pk2(v0[2], v0[3]); w.z = pk2(v1[0], v1[1]); w.w = pk2(v1[2], v1[3]);
                    *(u32x4*)(rowp + bj * HALF) = w; } }
    }
};
struct EpiF32 {
    float* C; int ldc;
    __device__ __forceinline__ void operator()(const f32x4 (&acc)[2][2][4][2], const Unit& u, int wr, int wc, int fr, int fq) const {
        const int row0 = u.pm * BM + wr * 64 + fr, col0 = u.pn * BM + wc * 32 + 8 * fq;
#pragma unroll
        for (int ai = 0; ai < 2; ++ai)
#pragma unroll
            for (int m = 0; m < 4; ++m) { float* rowp = C + (size_t)(row0 + ai * HALF + m * 16) * ldc + col0;
#pragma unroll
                for (int bj = 0; bj < 2; ++bj)
#pragma unroll
                    for (int n = 0; n < 2; ++n) *(f32x4*)(rowp + bj * HALF + 4 * n) = acc[ai][bj][m][n]; }
    }
};
struct EpiPartF32 {
    float* C; int ldc;
    __device__ __forceinline__ void operator()(const f32x4 (&acc)[2][2][4][2], const Unit& u, int wr, int wc, int fr, int fq) const {
        const int row0 = wr * 64 + fr, col0 = u.pn * BM + wc * 32 + 8 * fq;
        float* base = C + (size_t)u.sl * 256 * ldc;
#pragma unroll
        for (int ai = 0; ai < 2; ++ai)
#pragma unroll
            for (int m = 0; m < 4; ++m) { float* rowp = base + (size_t)(row0 + ai * HALF + m * 16) * ldc + col0;
#pragma unroll
                for (int bj = 0; bj < 2; ++bj)
#pragma unroll
                    for (int n = 0; n < 2; ++n) *(f32x4*)(rowp + bj * HALF + 4 * n) = acc[ai][bj][m][n]; }
    }
};
template <class E0, class E1> struct Epi2 {
    E0 e0; E1 e1;
    __device__ __forceinline__ void operator()(const f32x4 (&acc)[2][2][4][2], const Unit& u, int wr, int wc, int fr, int fq) const {
        if (u.g == 0) e0(acc, u, wr, wc, fr, fq); else e1(acc, u, wr, wc, fr, fq);
    }
};

template <class Epi>
__device__ __forceinline__ void gemm_phase(LAS unsigned char* lds, const int K, const int lda, const int ldb, const Sched& S, const Epi& E) {
    const int tid = threadIdx.x, wid = __builtin_amdgcn_readfirstlane(tid >> 6), lane = tid & 63, wr = wid >> 2, wc = wid & 3, fr = lane & 15, fq = lane >> 4;
    unsigned voffA[2], voffB[2];
#pragma unroll
    for (int i = 0; i < 2; ++i) { int R, C; stage_rc(tid * 16 + i * 8192, R, C); const int Rb = (R & ~31) + perm32(R & 31);
        voffA[i] = (unsigned)(R * lda + C) * 2u; voffB[i] = (unsigned)(Rb * ldb + C) * 2u; }
    const size_t kstep = (size_t)(BK * 2);
    const size_t hstepA = (size_t)HALF * lda * 2, hstepB = (size_t)HALF * ldb * 2;
    const unsigned ldsw = (unsigned)wid * 1024u;
    const int aoff = lds_byte(wr * 64 + fr, fq * 8), boff = lds_byte(wc * 32 + fr, fq * 8);
#define PG8_SA(b, h) (((b) * 2 + (h)) * HTB)
#define PG8_SB(b, h) ((4 + (b) * 2 + (h)) * HTB)
#define PG8_STAGE(bufoff, gbase, voff) do { _Pragma("unroll") for (int _i = 0; _i < 2; ++_i) \
        __builtin_amdgcn_global_load_lds((const unsigned*)((const char*)(gbase) + (voff)[_i]), (LAS unsigned*)(lds + (bufoff) + ldsw + _i * 8192), 16, 0, 0); } while (0)
#define PG8_LDA(dst, b, h) do { _Pragma("unroll") for (int m = 0; m < 4; ++m) _Pragma("unroll") for (int k = 0; k < 2; ++k) dst[m][k] = *(const LAS bf16x8*)(lds + PG8_SA(b, h) + aoff + m * 2048 + k * 1024); } while (0)
#define PG8_LDB(dst, b, h) do { _Pragma("unroll") for (int n = 0; n < 2; ++n) _Pragma("unroll") for (int k = 0; k < 2; ++k) dst[n][k] = *(const LAS bf16x8*)(lds + PG8_SB(b, h) + boff + n * 2048 + k * 1024); } while (0)
#define PG8_MMA(ai, bj, At, Bt) do { __builtin_amdgcn_s_setprio(1); _Pragma("unroll") for (int m = 0; m < 4; ++m) _Pragma("unroll") for (int n = 0; n < 2; ++n) _Pragma("unroll") for (int k = 0; k < 2; ++k) \
        acc[ai][bj][m][n] = __builtin_amdgcn_mfma_f32_16x16x32_bf16(Bt[n][k], At[m][k], acc[ai][bj][m][n], 0, 0, 0); __builtin_amdgcn_s_setprio(0); } while (0)
#define PG8_WAIT_V(n) asm volatile("s_waitcnt vmcnt(" #n ")" ::: "memory")
#define PG8_WAIT_L(n) asm volatile("s_waitcnt lgkmcnt(" #n ")" ::: "memory")
#define PG8_BAR __builtin_amdgcn_s_barrier()
#define PG8_SCHED __builtin_amdgcn_sched_barrier(0)
    Unit cur, nxt; int ui = 0;
    if (!S.next(0, cur)) return;
    f32x4 acc[2][2][4][2];
#pragma unroll
    for (int a = 0; a < 2; ++a)
#pragma unroll
        for (int b = 0; b < 2; ++b)
#pragma unroll
            for (int m = 0; m < 4; ++m)
#pragma unroll
                for (int n = 0; n < 2; ++n) acc[a][b][m][n] = (f32x4){0.f, 0.f, 0.f, 0.f};
    bf16x8 At[4][2], B0[2][2], B1[2][2];
    const char* cA = cur.a; const char* cB = cur.b;
    PG8_STAGE(PG8_SB(0, 0), cB, voffB); PG8_STAGE(PG8_SB(0, 1), cB + hstepB, voffB); PG8_STAGE(PG8_SA(0, 0), cA, voffA); PG8_STAGE(PG8_SA(0, 1), cA + hstepA, voffA);
    if (wr == 1) PG8_BAR;
    PG8_WAIT_V(2); PG8_BAR;
    PG8_STAGE(PG8_SB(1, 0), cB + kstep, voffB); PG8_STAGE(PG8_SA(1, 0), cA + kstep, voffA); PG8_STAGE(PG8_SB(1, 1), cB + hstepB + kstep, voffB);
    PG8_WAIT_V(6); PG8_BAR;
    for (;;) {
        const bool has_next = S.next(ui + 1, nxt);
        const char* nA = has_next ? nxt.a : cA; const char* nB = has_next ? nxt.b : cB;
        const int nt = cur.nt;
#pragma unroll 1
        for (int t = 0; t < nt; t += 2) {
            const bool last = (t == nt - 2);
            const char* a1 = cA + (size_t)(t + 1) * kstep;
            const char* a2 = last ? nA : cA + (size_t)(t + 2) * kstep; const char* b2 = last ? nB : cB + (size_t)(t + 2) * kstep;
            const char* a3 = a2 + kstep; const char* b3 = b2 + kstep;
            PG8_LDB(B0, 0, 0); PG8_LDB(B1, 0, 1); PG8_SCHED; PG8_LDA(At, 0, 0); PG8_STAGE(PG8_SA(1, 1), a1 + hstepA, voffA);
            PG8_WAIT_V(8); PG8_WAIT_L(0); PG8_BAR; PG8_MMA(0, 0, At, B0); PG8_MMA(0, 1, At, B1); PG8_BAR; PG8_SCHED;
            PG8_LDA(At, 0, 1); PG8_STAGE(PG8_SB(0, 0), b2, voffB); PG8_STAGE(PG8_SB(0, 1), b2 + hstepB, voffB); PG8_STAGE(PG8_SA(0, 0), a2, voffA);
            PG8_WAIT_V(8); PG8_WAIT_L(0); PG8_BAR; PG8_MMA(1, 0, At, B0); PG8_MMA(1, 1, At, B1); PG8_BAR; PG8_SCHED;
            PG8_LDB(B0, 1, 0); PG8_LDB(B1, 1, 1); PG8_SCHED; PG8_LDA(At, 1, 0); PG8_STAGE(PG8_SA(0, 1), a2 + hstepA, voffA);
            PG8_WAIT_V(8); PG8_WAIT_L(0); PG8_BAR; PG8_MMA(0, 0, At, B0); PG8_MMA(0, 1, At, B1); PG8_BAR; PG8_SCHED;
            PG8_LDA(At, 1, 1); PG8_STAGE(PG8_SB(1, 0), b3, voffB); PG8_STAGE(PG8_SB(1, 1), b3 + hstepB, voffB); PG8_STAGE(PG8_SA(1, 0), a3, voffA);
            PG8_WAIT_V(8); PG8_WAIT_L(0); PG8_BAR; PG8_MMA(1, 0, At, B0); PG8_MMA(1, 1, At, B1); PG8_BAR; PG8_SCHED;
        }
        if (wr == 0) PG8_BAR;
        E(acc, cur, wr, wc, fr, fq);
        if (!has_next) break;
#pragma unroll
        for (int a = 0; a < 2; ++a)
#pragma unroll
            for (int b = 0; b < 2; ++b)
#pragma unroll
                for (int m = 0; m < 4; ++m)
#pragma unroll
                    for (int n = 0; n < 2; ++n) acc[a][b][m][n] = (f32x4){0.f, 0.f, 0.f, 0.f};
        cur = nxt; cA = nA; cB = nB; ++ui;
        if (wr == 1) PG8_BAR;
    }
    PG8_WAIT_V(0);
    PG8_BAR;
#undef PG8_SA
#undef PG8_SB
#undef PG8_STAGE
#undef PG8_LDA
#undef PG8_LDB
#undef PG8_MMA
#undef PG8_WAIT_V
#undef PG8_WAIT_L
#undef PG8_BAR
#undef PG8_SCHED
}
}

template <class Epi>
__device__ __forceinline__ void run_gemm(LAS unsigned char* lds, int K, int lda, int ldb, const void* A0, const void* B0, int nM0, int nN0, long apn0,
                                         const void* A1, const void* B1, int nM1, int nN1, const Epi& E, int S1 = 0, int pm1 = 0) {
    pg8::Sched S;
    S.nt0 = K / 64; S.S1 = S1; S.pm1 = pm1; S.nt1 = S1 ? K / 64 / S1 : 0; S.ksb = S1 ? (long)(K / S1) * 2 : 0;
    S.g0.A = (const char*)A0; S.g0.B = (const char*)B0; S.g0.nM = nM0; S.g0.nN = nN0; S.g0.a_pn_off = apn0;
    S.g1.A = (const char*)A1; S.g1.B = (const char*)B1; S.g1.nM = nM1; S.g1.nN = nN1; S.g1.a_pn_off = 0;
    S.n0 = nM0 * nN0; S.n1 = S1 ? S1 * nN1 : nM1 * nN1; S.G = gridDim.x; S.c = blockIdx.x;
    S.tstepA = (long)256 * lda * 2; S.tstepB = (long)256 * ldb * 2;
    pg8::gemm_phase<Epi>(lds, K, lda, ldb, S, E);
    __syncthreads();
}

__device__ __forceinline__ void transpose_item(const float* W, int ldw, bf16_t* WT, int ldo, LAS float* scr, int k0, int n0, int lane, const float* rs = nullptr) {
#pragma unroll 8
    for (int i = 0; i < 32; ++i) { const int kk = 2 * i + (lane >> 5); scr[kk * 33 + (lane & 31)] = W[(size_t)(k0 + kk) * ldw + n0 + (lane & 31)]; }
    asm volatile("s_waitcnt lgkmcnt(0)" ::: "memory");
    const int c = lane & 7;
#pragma unroll
    for (int j = 0; j < 4; ++j) { const int n = (lane >> 3) + 8 * j; const LAS float* s = scr + (8 * c) * 33 + n; const float m = rs ? rs[n0 + n] : 1.f;
        u32x4 o; o.x = pk2(s[0 * 33] * m, s[1 * 33] * m); o.y = pk2(s[2 * 33] * m, s[3 * 33] * m); o.z = pk2(s[4 * 33] * m, s[5 * 33] * m); o.w = pk2(s[6 * 33] * m, s[7 * 33] * m);
        *(u32x4*)(WT + (size_t)(n0 + n) * ldo + k0 + 8 * c) = o; }
    asm volatile("s_waitcnt lgkmcnt(0)" ::: "memory");
}
__device__ __forceinline__ void transpose_matrix(const float* W, int K, int N, bf16_t* WT, int ldo, LAS float* scr, int gw, int ngw, int lane, const float* rs = nullptr) {
    const int nblk = N / 32, nitems = (K / 64) * nblk;
    for (int it = gw; it < nitems; it += ngw) { const int kb = it / nblk, nb = it % nblk; transpose_item(W, N, WT, ldo, scr, kb * 64, nb * 32, lane, rs); }
}

__device__ __forceinline__ void phase_mod_partial(const DArgs& a, LAS unsigned char* lds) {
    LAS float* sil = (LAS float*)lds;
    for (int i = threadIdx.x; i < 9 * D; i += NTHR) { const int e = i / D, d = i % D; const float c = e == 0 ? a.in(I_CP)[d] : a.in(I_CS)[(e - 1) * D + d]; sil[i] = c / (1.f + __expf(-c)); }
    __syncthreads();
    const int wave = threadIdx.x >> 6, lane = threadIdx.x & 63, gw = blockIdx.x * NWAVE + wave, ngw = gridDim.x * NWAVE;
    float* part = (float*)(a.wsp() + W_MODPART);
    constexpr int NT = 6 * D / 256;
    constexpr int KR = D / KSPLIT;
    for (int it = gw; it < 2 * NT * KSPLIT; it += ngw) {
        const int ks = it % KSPLIT, nt = (it / KSPLIT) % NT, l = it / (KSPLIT * NT);
        const float* w = a.in(I_WADA) + (size_t)l * D * 6 * D + (size_t)(ks * KR) * 6 * D + nt * 256 + lane * 4;
        f32x4 acc[9];
#pragma unroll
        for (int e = 0; e < 9; ++e) acc[e] = (f32x4){0.f, 0.f, 0.f, 0.f};
#pragma unroll 4
        for (int d = 0; d < KR; ++d) {
            const f32x4 wv = *(const f32x4*)(w + (size_t)d * 6 * D);
#pragma unroll
            for (int e = 0; e < 9; ++e) { const float s = sil[e * D + ks * KR + d]; acc[e] += wv * s; }
        }
#pragma unroll
        for (int e = 0; e < 9; ++e) *(f32x4*)(part + ((size_t)(ks * 9 + e) * 2 + l) * 6 * D + nt * 256 + lane * 4) = acc[e];
    }
    __syncthreads();
}
enum { CV_OUT0 = 0, CV_QKV, CV_OUT1, CV_FF1_0, CV_FF2_0, CV_FF1_1, CV_FF2_1 };
__device__ __forceinline__ void convert_sub(const DArgs& a, LAS unsigned char* lds, int which, int c0) {
    if ((int)blockIdx.x < c0) return;
    const int wave = threadIdx.x >> 6, lane = threadIdx.x & 63, gw = ((int)blockIdx.x - c0) * NWAVE + wave, ngw = ((int)gridDim.x - c0) * NWAVE;
    LAS float* scr = (LAS float*)(lds + wave * 8448);
    unsigned char* w = a.wsp();
    switch (which) {
    case CV_OUT0: transpose_matrix(a.in(I_WOUT0), D, D, (bf16_t*)(w + W_OUT0T), D, scr, gw, ngw, lane); break;
    case CV_QKV: transpose_matrix(a.in(I_WQKV), D, 3 * D, (bf16_t*)(w + W_QKVT), D, scr, gw, ngw, lane); break;
    case CV_OUT1: transpose_matrix(a.in(I_WOUT1), D, D, (bf16_t*)(w + W_OUT1T), D, scr, gw, ngw, lane); break;
    case CV_FF1_0: transpose_matrix(a.in(I_WFF1), D, DFF, (bf16_t*)(w + W_FF1T), D, scr, gw, ngw, lane); break;
    case CV_FF2_0: transpose_matrix(a.in(I_WFF2), DFF, D, (bf16_t*)(w + W_FF2T), DFF, scr, gw, ngw, lane); break;
    case CV_FF1_1: transpose_matrix(a.in(I_WFF1) + (size_t)D * DFF, D, DFF, (bf16_t*)(w + W_FF1T), D, scr, gw, ngw, lane); break;
    default: transpose_matrix(a.in(I_WFF2) + (size_t)DFF * D, DFF, D, (bf16_t*)(w + W_FF2T), DFF, scr, gw, ngw, lane); break;
    }
}
__device__ __forceinline__ void phase_convert(const DArgs& a, LAS unsigned char* lds) {
    const int wave = threadIdx.x >> 6, lane = threadIdx.x & 63, gw = blockIdx.x * NWAVE + wave, ngw = gridDim.x * NWAVE;
    LAS float* scr = (LAS float*)(lds + wave * 8448);
    transpose_matrix(a.in(I_WIN0), D, DIN0, (bf16_t*)(a.wsp() + W_IN0T), D, scr, gw, ngw, lane);
    for (int g = 0; g < 4; ++g) transpose_matrix(a.in(I_WPOOL) + (size_t)g * 65536, 256, 256, (bf16_t*)(a.wsp() + W_POOLT) + (size_t)g * 65536, 256, scr, gw, ngw, lane, a.in(I_PSCALE) + g * 256);
    bf16_t* lt = (bf16_t*)(a.wsp() + W_LORAT);
    for (int i = blockIdx.x * NTHR + threadIdx.x; i < 3072 * 256; i += gridDim.x * NTHR) {
        const int row = i >> 8, k = i & 255, part = row >> 10, n = row & 1023; float v = 0.f;
        if (part == 0) { if (k < 64) v = a.in(I_W2)[k * 1024 + n]; }
        else if (part == 1) { if (k >= 64 && k < 128) v = a.in(I_A2)[(k - 64) * 1024 + n]; }
        else { if (k >= 128) v = a.in(I_G2)[(k - 128) * 1024 + n]; }
        lt[i] = f2bf(v);
    }
}
__device__ __forceinline__ void phase_mod_final(const DArgs& a) {
    const float* part = (const float*)(a.wsp() + W_MODPART); float* mod = (float*)(a.wsp() + W_MOD);
    for (int i = blockIdx.x * NTHR + threadIdx.x; i < 9 * 2 * 6 * D; i += gridDim.x * NTHR) {
        const int n = i % (6 * D), l = (i / (6 * D)) & 1;
        float s = a.in(I_BADA)[l * 6 * D + n];
#pragma unroll
        for (int ks = 0; ks < KSPLIT; ++ks) s += part[(size_t)ks * 9 * 2 * 6 * D + i];
        mod[i] = s;
    }
}
__device__ __forceinline__ void zero_oacc(const DArgs& a) {
    f32x4* p = (f32x4*)(a.wsp() + W_OACC);
    for (int i = blockIdx.x * NTHR + threadIdx.x; i < TS * D / 4; i += gridDim.x * NTHR) p[i] = (f32x4){0.f, 0.f, 0.f, 0.f};
}
template <bool XIN_INPUT, bool HAS_O, bool HAS_H>
__device__ __forceinline__ void phase_rowwise(const DArgs& a, LAS unsigned char* lds, const float* g_o, int l_gt, int gt_which, const float* g_h, int l_h, int sc_which, int sh_which, int nsl = 0) {
    const int wave = threadIdx.x >> 6, lane = threadIdx.x & 63, gw = blockIdx.x * NWAVE + wave, ngw = gridDim.x * NWAVE;
    const float* mod = (const float*)(a.wsp() + W_MOD);
    float* X = a.outp() + O_Y; const bf16_t* o = (const bf16_t*)(a.wsp() + W_O); bf16_t* hA = (bf16_t*)(a.wsp() + W_HA); const float* oacc = (const float*)(a.wsp() + W_OACC);
    {
        f32x4 A1[HAS_O ? 8 : 1], A2[HAS_H ? 8 : 1], A3[HAS_H ? 8 : 1];
#pragma unroll
        for (int j = 0; j < 8; ++j) { const int c = 4 * (lane + 64 * j);
            if constexpr (HAS_O) A1[j] = *(const f32x4*)(mod + (size_t)l_gt * 6 * D + gt_which * D + c) * *(const f32x4*)(g_o + c);
            if constexpr (HAS_H) { A2[j] = *(const f32x4*)(g_h + c) * (*(const f32x4*)(mod + (size_t)l_h * 6 * D + sc_which * D + c) + 1.f); A3[j] = *(const f32x4*)(mod + (size_t)l_h * 6 * D + sh_which * D + c); } }
        for (int row = gw; row < TP; row += ngw) {
            const float* xin = XIN_INPUT ? a.in(I_XP) + (size_t)row * D : X + (size_t)row * D;
            f32x4 x[8];
#pragma unroll
            for (int j = 0; j < 8; ++j) x[j] = *(const f32x4*)(xin + 4 * (lane + 64 * j));
            if constexpr (HAS_O) {
                f32x4 ov[8]; float ss = 0.f;
#pragma unroll
                for (int j = 0; j < 8; ++j) { const u32x2 w = *(const u32x2*)(o + (size_t)row * D + 4 * (lane + 64 * j)); ov[j] = (f32x4){bflo(w.x), bfhi(w.x), bflo(w.y), bfhi(w.y)};
                    ss += (ov[j].x * ov[j].x + ov[j].y * ov[j].y) + (ov[j].z * ov[j].z + ov[j].w * ov[j].w); }
                const float rstd = rsqrtf(wave_sum(ss) * (1.f / D) + 1e-6f);
#pragma unroll
                for (int j = 0; j < 8; ++j) { x[j] += A1[j] * (ov[j] * rstd); *(f32x4*)(X + (size_t)row * D + 4 * (lane + 64 * j)) = x[j]; }
            }
            if constexpr (HAS_H) {
                float ss = 0.f;
#pragma unroll
                for (int j = 0; j < 8; ++j) ss += (x[j].x * x[j].x + x[j].y * x[j].y) + (x[j].z * x[j].z + x[j].w * x[j].w);
                const float rstd = rsqrtf(wave_sum(ss) * (1.f / D) + 1e-6f);
#pragma unroll
                for (int j = 0; j < 8; ++j) { const f32x4 h = x[j] * rstd * A2[j] + A3[j]; u32x2 w; w.x = pk2(h.x, h.y); w.y = pk2(h.z, h.w);
                    *(u32x2*)(hA + (size_t)row * D + 4 * (lane + 64 * j)) = w; }
            }
        }
    }
    LAS float* red = (LAS float*)lds;
    for (int r = blockIdx.x; r < TS; r += gridDim.x) {
        const int row = TP + r, e = entry_of(row), c = wave * 256 + lane * 4;
        const float* xin = XIN_INPUT ? a.in(I_XS) + (size_t)r * D : X + (size_t)row * D;
        f32x4 x = *(const f32x4*)(xin + c);
        if constexpr (HAS_O) {
            f32x4 ov = (f32x4){0.f, 0.f, 0.f, 0.f};
#pragma unroll 8
            for (int sl = 0; sl < nsl; ++sl) ov += *(const f32x4*)(oacc + ((size_t)sl * TS + r) * D + c);
            const float ss = wave_sum((ov.x * ov.x + ov.y * ov.y) + (ov.z * ov.z + ov.w * ov.w));
            if (lane == 0) red[wave] = ss;
            __syncthreads();
            float tot = 0.f;
#pragma unroll
            for (int w = 0; w < 8; ++w) tot += red[w];
            const float rstd = rsqrtf(tot * (1.f / D) + 1e-6f);
            const f32x4 g = *(const f32x4*)(mod + (size_t)(e * 2 + l_gt) * 6 * D + gt_which * D + c), go = *(const f32x4*)(g_o + c);
            x += g * (ov * rstd * go); *(f32x4*)(X + (size_t)row * D + c) = x;
        }
        if constexpr (HAS_H) {
            const float ss = wave_sum((x.x * x.x + x.y * x.y) + (x.z * x.z + x.w * x.w));
            if (lane == 0) red[8 + wave] = ss;
            __syncthreads();
            float tot = 0.f;
#pragma unroll
            for (int w = 0; w < 8; ++w) tot += red[8 + w];
            const float rstd = rsqrtf(tot * (1.f / D) + 1e-6f);
            const float* mb = mod + (size_t)(e * 2 + l_h) * 6 * D;
            const f32x4 g = *(const f32x4*)(g_h + c), s1 = *(const f32x4*)(mb + sc_which * D + c), s0 = *(const f32x4*)(mb + sh_which * D + c);
            const f32x4 h = x * rstd * g * (s1 + 1.f) + s0; u32x2 w; w.x = pk2(h.x, h.y); w.y = pk2(h.z, h.w);
            *(u32x2*)(hA + (size_t)row * D + c) = w;
        }
        __syncthreads();
    }
}
__device__ __forceinline__ void ld8bf(const bf16_t* p, float (&v)[8]) { const u32x4 w = *(const u32x4*)p; v[0] = bflo(w.x); v[1] = bfhi(w.x); v[2] = bflo(w.y); v[3] = bfhi(w.y); v[4] = bflo(w.z); v[5] = bfhi(w.z); v[6] = bflo(w.w); v[7] = bfhi(w.w); }
__device__ __forceinline__ void ld8f(const float* p, float (&v)[8]) { const f32x4 a = *(const f32x4*)p, b = *(const f32x4*)(p + 4); v[0] = a.x; v[1] = a.y; v[2] = a.z; v[3] = a.w; v[4] = b.x; v[5] = b.y; v[6] = b.z; v[7] = b.w; }
__device__ __forceinline__ void st8bf(bf16_t* p, const float (&v)[8]) { u32x4 w; w.x = pk2(v[0], v[1]); w.y = pk2(v[2], v[3]); w.z = pk2(v[4], v[5]); w.w = pk2(v[6], v[7]); *(u32x4*)p = w; }
template <int WIN> __device__ __forceinline__ void pool_sum(const bf16_t* p, float (&s)[8], float (&u)[8]) {
    u32x4 w[WIN];
#pragma unroll
    for (int sf = 0; sf < WIN; ++sf) w[sf] = *(const u32x4*)(p - (size_t)sf * DIN0);
    u[0] = bflo(w[0].x); u[1] = bfhi(w[0].x); u[2] = bflo(w[0].y); u[3] = bfhi(w[0].y); u[4] = bflo(w[0].z); u[5] = bfhi(w[0].z); u[6] = bflo(w[0].w); u[7] = bfhi(w[0].w);
#pragma unroll
    for (int i = 0; i < 8; ++i) s[i] = u[i];
#pragma unroll
    for (int sf = 1; sf < WIN; ++sf) { s[0] += bflo(w[sf].x); s[1] += bfhi(w[sf].x); s[2] += bflo(w[sf].y); s[3] += bfhi(w[sf].y); s[4] += bflo(w[sf].z); s[5] += bfhi(w[sf].z); s[6] += bflo(w[sf].w); s[7] += bfhi(w[sf].w); }
}
__device__ __forceinline__ void phase_prep(const DArgs& a) {
    const bf16_t* P = (const bf16_t*)(a.wsp() + W_P); bf16_t* AL = (bf16_t*)(a.wsp() + W_AL);
    const int gt = blockIdx.x * NTHR + threadIdx.x, ngt = gridDim.x * NTHR;
    for (int idx = gt; idx < TA * 160; idx += ngt) {
        const int row = idx / 160, it = idx % 160; const bool prompt = row < TP; const int t = prompt ? row : ((row - TP) & 31), b = prompt ? 0 : ((row - TP) >> 5);
        if (it < 128) {
            const int c0 = it * 8, gi = c0 >> 8, win = 2 << gi;
            float s[8], u[8], v[8];
            if (t >= win - 1) {
                const bf16_t* p = P + (size_t)row * DIN0 + c0;
                if (gi == 0) pool_sum<2>(p, s, u); else if (gi == 1) pool_sum<4>(p, s, u); else if (gi == 2) pool_sum<8>(p, s, u); else pool_sum<16>(p, s, u);
                const float inv = 1.f / (float)win;
#pragma unroll
                for (int i = 0; i < 8; ++i) s[i] = s[i] * inv - u[i];
            } else {
#pragma unroll
                for (int i = 0; i < 8; ++i) s[i] = 0.f;
                for (int sf = 0; sf < win; ++sf) { const int tt = t - sf;
                    if (tt >= 0) { ld8bf(P + (size_t)(row - sf) * DIN0 + c0, v);
#pragma unroll
                        for (int i = 0; i < 8; ++i) s[i] += v[i]; }
                    else if (!prompt) { ld8f(a.in(I_SPOOL) + ((size_t)b * 15 + (15 + tt)) * DPOOL + c0, v);
#pragma unroll
                        for (int i = 0; i < 8; ++i) s[i] += v[i]; } }
                const float cnt = prompt ? (float)min(win, t + 1) : (float)win, inv = 1.f / cnt;
                ld8bf(P + (size_t)row * DIN0 + c0, u);
#pragma unroll
                for (int i = 0; i < 8; ++i) s[i] = s[i] * inv - u[i];
            }
            st8bf(AL + (size_t)row * 1280 + c0, s);
        } else {
            const int q0 = (it - 128) * 8, e0 = 3072 + q0;
            float z[8], zp[8], mu[8];
            ld8bf(P + (size_t)row * DIN0 + DPOOL + e0, z);
            if (t > 0) ld8bf(P + (size_t)(row - 1) * DIN0 + DPOOL + e0, zp);
            else if (!prompt) ld8f(a.in(I_SSHIFT) + (size_t)b * DSHIFT + e0, zp);
            else {
#pragma unroll
                for (int i = 0; i < 8; ++i) zp[i] = 0.f; }
            ld8f(a.in(I_MU) + e0, mu);
#pragma unroll
            for (int i = 0; i < 8; ++i) { const float zs = z[i] + (zp[i] - z[i]) * mu[i];
                z[i] = q0 < 64 ? 1.f - 2.f / (1.f + __expf(2.f * zs)) : (q0 < 128 ? zs : sigmoidf_(zs)); }
            st8bf(AL + (size_t)row * 1280 + 1024 + q0, z);
        }
    }
    for (int i = gt; i < 15 * DPOOL; i += ngt) a.outp()[O_POOLP + i] = bf2f(P[(size_t)(TP - 15 + i / DPOOL) * DIN0 + (i % DPOOL)]);
    for (int i = gt; i < 8 * 15 * DPOOL; i += ngt) { const int b = i / (15 * DPOOL), r = (i / DPOOL) % 15, c = i % DPOOL; a.outp()[O_POOLS + i] = bf2f(P[(size_t)(TP + b * 32 + 17 + r) * DIN0 + c]); }
    for (int i = gt; i < DSHIFT; i += ngt) a.outp()[O_SHIFTP + i] = bf2f(P[(size_t)(TP - 1) * DIN0 + DPOOL + i]);
    for (int i = gt; i < 8 * DSHIFT; i += ngt) { const int b = i / DSHIFT, e = i % DSHIFT; a.outp()[O_SHIFTS + i] = bf2f(P[(size_t)(TP + b * 32 + 31) * DIN0 + DPOOL + e]); }
}

struct ScanConst { float mu_r, mu_k, mu_v, w0, a0, kkc, kac, rk, lnw, lnb; };
struct ScanRaw { bf16_t zr, zk, zv; float lw, la, lg; };
template <bool NEEDG> __device__ __forceinline__ ScanRaw scan_load(const bf16_t* P, const float* L, int row, int c) {
    ScanRaw r; const bf16_t* p = P + (size_t)row * DIN0 + DPOOL + c; r.zr = p[0]; r.zk = p[1024]; r.zv = p[2048];
    const float* l = L + (size_t)row * 3072 + c; r.lw = l[0]; r.la = l[1024]; r.lg = NEEDG ? l[2048] : 0.f; return r;
}
template <int MODE>
__device__ __forceinline__ void scan_item(const DArgs& a, LAS float* W  , int row0, int nsteps, int h, int lane, bool first_is_start, const float* shift_prev  ,
                                          const float* S_init  , float* S_final  , float* Uout, float* Pout) {
    const bf16_t* P = (const bf16_t*)(a.wsp() + W_P); const float* L = (const float*)(a.wsp() + W_L); bf16_t* mix = (bf16_t*)(a.wsp() + W_MIX);
    const int c = h * 64 + lane, ib = lane >> 4, il = lane & 15;
    ScanConst k; k.mu_r = a.in(I_MU)[c]; k.mu_k = a.in(I_MU)[1024 + c]; k.mu_v = a.in(I_MU)[2048 + c]; k.w0 = a.in(I_W0)[c]; k.a0 = a.in(I_A0)[c];
    k.kkc = a.in(I_KK)[c]; k.kac = a.in(I_KA)[c]; k.rk = a.in(I_RK)[c]; k.lnw = a.in(I_LNW)[c]; k.lnb = a.in(I_LNB)[c];
    float zr_p, zk_p, zv_p;
    if (!first_is_start) { const bf16_t* p = P + (size_t)(row0 - 1) * DIN0 + DPOOL + c; zr_p = bf2f(p[0]); zk_p = bf2f(p[1024]); zv_p = bf2f(p[2048]); }
    else if (shift_prev) { zr_p = shift_prev[c]; zk_p = shift_prev[1024 + c]; zv_p = shift_prev[2048 + c]; }
    else { zr_p = 0.f; zk_p = 0.f; zv_p = 0.f; }
    f32x2 S[4][8];
    if constexpr (MODE == 1) {
#pragma unroll
        for (int q = 0; q < 4; ++q)
#pragma unroll
            for (int m = 0; m < 4; ++m) { const f32x4 v = *(const f32x4*)(S_init + (il + 16 * q) * 64 + 16 * ib + 4 * m); S[q][2 * m] = (f32x2){v.x, v.y}; S[q][2 * m + 1] = (f32x2){v.z, v.w}; }
    } else {
#pragma unroll
        for (int q = 0; q < 4; ++q)
#pragma unroll
            for (int p = 0; p < 8; ++p) S[q][p] = MODE == 2 ? (f32x2){(q == ib && 2 * p == il) ? 1.f : 0.f, (q == ib && 2 * p + 1 == il) ? 1.f : 0.f} : (f32x2){0.f, 0.f};
    }
#define LDV(dst_, vec_) { _Pragma("unroll") for (int m = 0; m < 4; ++m) { const f32x4 t_ = *(const LAS f32x4*)(W + (vec_) * 64 + 16 * ib + 4 * m); dst_[2 * m] = (f32x2){t_.x, t_.y}; dst_[2 * m + 1] = (f32x2){t_.z, t_.w}; } }
#define XSUM(x_) { const u32x2 s16_ = __builtin_amdgcn_permlane16_swap(__float_as_uint(x_), __float_as_uint(x_), false, false); x_ = __uint_as_float(s16_.x) + __uint_as_float(s16_.y); \
                   const u32x2 s32_ = __builtin_amdgcn_permlane32_swap(__float_as_uint(x_), __float_as_uint(x_), false, false); x_ = __uint_as_float(s32_.x) + __uint_as_float(s32_.y); }
    struct Prep { float an, dec, bn, kmod, r, v, lg, bin; };
    auto prep = [&](const ScanRaw& rw) -> Prep {
        Prep o; const float zr = bf2f(rw.zr), zk = bf2f(rw.zk), zv = bf2f(rw.zv);
        const float r = zr + (zr_p - zr) * k.mu_r, kx = zk + (zk_p - zk) * k.mu_k; o.v = zv + (zv_p - zv) * k.mu_v;
        zr_p = zr; zk_p = zk; zv_p = zv;
        o.dec = __expf(-0.60653066f * sigmoidf_(k.w0 + rw.lw));
        const float ai = sigmoidf_(k.a0 + rw.la);
        const float kkr = kx * k.kkc, ssq = wave_sum(kkr * kkr), kk = kkr * rsqrtf(fmaxf(ssq, 1e-24f));
        o.kmod = kx * (1.f + (ai - 1.f) * k.kac); o.an = -kk; o.bn = kk * ai; o.r = r; o.lg = rw.lg; o.bin = r * o.kmod * k.rk; return o; };
    auto post = [&](float y, float bin, float v, float lg, int row, bool doit) {
        const float mean = wave_sum(y) * (1.f / 64.f), dy = y - mean, var = wave_sum(dy * dy) * (1.f / 64.f);
        const float yn = dy * rsqrtf(var + 64e-5f) * k.lnw + k.lnb;
        const float bonus = wave_sum(bin) * v;
        if (doit) mix[(size_t)row * D + 1024 + c] = f2bf((yn + bonus) * lg); };
    ScanRaw raw1 = scan_load<MODE == 1>(P, L, row0 + (nsteps > 1 ? 1 : 0), c);
    Prep pv = prep(scan_load<MODE == 1>(P, L, row0, c));
    float yp = 0.f, binp = 0.f, vp = 0.f, lgp = 0.f;
    for (int t = 0; t < nsteps; ++t) {
        const int row = row0 + t;
        const ScanRaw raw2 = scan_load<MODE == 1>(P, L, row0 + (t + 2 < nsteps ? t + 2 : nsteps - 1), c);
        W[lane] = pv.an; W[64 + lane] = pv.dec; W[128 + lane] = pv.bn; if constexpr (MODE != 2) { W[192 + lane] = pv.kmod; W[320 + lane] = pv.v; } if constexpr (MODE == 1) W[256 + lane] = pv.r;
        const Prep pn = prep(raw1);
        constexpr int NS = 2, PW = 8 / NS;
        float sa[4];
#pragma unroll
        for (int q = 0; q < 4; ++q) sa[q] = 0.f;
#pragma unroll
        for (int hf = 0; hf < NS; ++hf) {
            f32x2 av[PW];
#pragma unroll
            for (int m = 0; m < PW / 2; ++m) { const f32x4 t0 = *(const LAS f32x4*)(W + 16 * ib + 2 * PW * hf + 4 * m); av[2 * m] = (f32x2){t0.x, t0.y}; av[2 * m + 1] = (f32x2){t0.z, t0.w}; }
#pragma unroll
            for (int q = 0; q < 4; ++q) {
                f32x2 d = S[q][PW * hf] * av[0];
#pragma unroll
                for (int p = 1; p < PW; ++p) d += S[q][PW * hf + p] * av[p];
                sa[q] += d.x + d.y;
            }
        }
#pragma unroll
        for (int q = 0; q < 4; ++q) { XSUM(sa[q]) }
        float vq[4];
#pragma unroll
        for (int q = 0; q < 4; ++q) vq[q] = MODE == 2 ? 0.f : W[320 + il + 16 * q];
#pragma unroll
        for (int hf = 0; hf < NS; ++hf) {
            f32x2 wv[PW], bv[PW], kv[PW];
#pragma unroll
            for (int m = 0; m < PW / 2; ++m) { const int o_ = 16 * ib + 2 * PW * hf + 4 * m; const f32x4 t0 = *(const LAS f32x4*)(W + 64 + o_), t1 = *(const LAS f32x4*)(W + 128 + o_), t2 = MODE == 2 ? t1 : *(const LAS f32x4*)(W + 192 + o_);
                wv[2 * m] = (f32x2){t0.x, t0.y}; wv[2 * m + 1] = (f32x2){t0.z, t0.w}; bv[2 * m] = (f32x2){t1.x, t1.y}; bv[2 * m + 1] = (f32x2){t1.z, t1.w}; kv[2 * m] = (f32x2){t2.x, t2.y}; kv[2 * m + 1] = (f32x2){t2.z, t2.w}; }
#pragma unroll
            for (int q = 0; q < 4; ++q) {
                const f32x2 sa2 = (f32x2){sa[q], sa[q]}, v2 = (f32x2){vq[q], vq[q]};
#pragma unroll
                for (int p = 0; p < PW; ++p) { if constexpr (MODE == 2) S[q][PW * hf + p] = S[q][PW * hf + p] * wv[p] + sa2 * bv[p]; else S[q][PW * hf + p] = S[q][PW * hf + p] * wv[p] + (sa2 * bv[p] + v2 * kv[p]); }
            }
        }
        if constexpr (MODE == 1) {
            f32x2 rv[8];
            LDV(rv, 4)
            float yq[4];
#pragma unroll
            for (int q = 0; q < 4; ++q) { f32x2 d = S[q][0] * rv[0];
#pragma unroll
                for (int p = 1; p < 8; ++p) d += S[q][p] * rv[p];
                yq[q] = d.x + d.y; }
            const u32x2 s02 = __builtin_amdgcn_permlane32_swap(__float_as_uint(yq[0]), __float_as_uint(yq[2]), false, false);
            const u32x2 s13 = __builtin_amdgcn_permlane32_swap(__float_as_uint(yq[1]), __float_as_uint(yq[3]), false, false);
            const float r02 = __uint_as_float(s02.x) + __uint_as_float(s02.y), r13 = __uint_as_float(s13.x) + __uint_as_float(s13.y);
            const u32x2 sy = __builtin_amdgcn_permlane16_swap(__float_as_uint(r02), __float_as_uint(r13), false, false);
            const float y = __uint_as_float(sy.x) + __uint_as_float(sy.y);
            post(yp, binp, vp, lgp, row - 1, t > 0);
            yp = y; binp = pv.bin; vp = pv.v; lgp = pv.lg;
        }
        pv = pn; raw1 = raw2;
    }
    if constexpr (MODE == 1) post(yp, binp, vp, lgp, row0 + nsteps - 1, true);
#undef LDV
#undef XSUM
    if constexpr (MODE == 1) {
        if (S_final) {
#pragma unroll
            for (int q = 0; q < 4; ++q)
#pragma unroll
                for (int m = 0; m < 4; ++m) *(f32x4*)(S_final + (il + 16 * q) * 64 + 16 * ib + 4 * m) = (f32x4){S[q][2 * m].x, S[q][2 * m].y, S[q][2 * m + 1].x, S[q][2 * m + 1].y};
        }
    } else {
        float* dst = MODE == 0 ? Uout : Pout;
#pragma unroll
        for (int q = 0; q < 4; ++q)
#pragma unroll
            for (int m = 0; m < 4; ++m) *(f32x4*)(dst + (il + 16 * q) * 64 + 16 * ib + 4 * m) = (f32x4){S[q][2 * m].x, S[q][2 * m].y, S[q][2 * m + 1].x, S[q][2 * m + 1].y};
    }
}
__device__ __forceinline__ void phase_scan_a(const DArgs& a, LAS unsigned char* lds) {
    const int wave = threadIdx.x >> 6, lane = threadIdx.x & 63, gw = blockIdx.x * NWAVE + wave, ngw = gridDim.x * NWAVE;
    LAS float* W = (LAS float*)(lds + 8192 + wave * 2048);
    for (int it = gw; it < NCHK * 16; it += ngw) { const int ch = it >> 4, h = it & 15;
        scan_item<0>(a, W, ch * CHK, CHK, h, lane, ch == 0, nullptr, nullptr, nullptr, (float*)(a.wsp() + W_UC) + (size_t)it * 4096, nullptr);
        scan_item<2>(a, W, ch * CHK, CHK, h, lane, ch == 0, nullptr, nullptr, nullptr, nullptr, (float*)(a.wsp() + W_PC) + (size_t)it * 4096); }
}
__device__ __forceinline__ void phase_scan_c(const DArgs& a, LAS unsigned char* lds) {
    const int wave = threadIdx.x >> 6, lane = threadIdx.x & 63, gw = blockIdx.x * NWAVE + wave, ngw = gridDim.x * NWAVE;
    for (int it = gw; it < NCHK * 16; it += ngw) { const int ch = it >> 4, h = it & 15;
        scan_item<1>(a, (LAS float*)(lds + 8192 + wave * 2048), ch * CHK, CHK, h, lane, ch == 0, nullptr, (const float*)(a.wsp() + W_SST) + (size_t)it * 4096, nullptr, nullptr, nullptr); }
}
__device__ __forceinline__ void phase_scan_b(const DArgs& a, LAS unsigned char* lds) {
    const int wave = threadIdx.x >> 6, lane = threadIdx.x & 63;
    if (blockIdx.x < 64) {
        const int h = blockIdx.x >> 2, rg = blockIdx.x & 3, fr = lane & 15, g = lane >> 4;
        LAS float* Sb = (LAS float*)lds;
        const float* Pc = (const float*)(a.wsp() + W_PC); const float* Uc = (const float*)(a.wsp() + W_UC); float* Sst = (float*)(a.wsp() + W_SST);
        for (int i = threadIdx.x; i < 16 * 68; i += NTHR) Sb[i] = 0.f;
        if (wave < 4) {
#pragma unroll
            for (int r = 0; r < 4; ++r) Sst[(size_t)h * 4096 + (rg * 16 + 4 * g + r) * 64 + 16 * wave + fr] = 0.f;
        }
        float bq[16], uq[4];
        if (wave < 4) { const float* pc = Pc + (size_t)h * 4096; const float* uc = Uc + (size_t)h * 4096;
#pragma unroll
            for (int ks = 0; ks < 16; ++ks) bq[ks] = pc[(16 * g + ks) * 64 + 16 * wave + fr];
#pragma unroll
            for (int r = 0; r < 4; ++r) uq[r] = uc[(rg * 16 + 4 * g + r) * 64 + 16 * wave + fr]; }
        __syncthreads();
        for (int ch = 0; ch < NCHK; ++ch) {
            f32x4 acc0, acc1 = (f32x4){0.f, 0.f, 0.f, 0.f};
            if (wave < 4) {
                float bn[16], un[4];
                const int chn = ch + 1 < NCHK ? ch + 1 : ch;
                const float* pc = Pc + ((size_t)chn * 16 + h) * 4096; const float* uc = Uc + ((size_t)chn * 16 + h) * 4096;
#pragma unroll
                for (int ks = 0; ks < 16; ++ks) bn[ks] = pc[(16 * g + ks) * 64 + 16 * wave + fr];
#pragma unroll
                for (int r = 0; r < 4; ++r) un[r] = uc[(rg * 16 + 4 * g + r) * 64 + 16 * wave + fr];
                float aq[16];
#pragma unroll
                for (int q = 0; q < 4; ++q) { const f32x4 v = *(const LAS f32x4*)(Sb + fr * 68 + 16 * g + 4 * q); aq[4 * q] = v.x; aq[4 * q + 1] = v.y; aq[4 * q + 2] = v.z; aq[4 * q + 3] = v.w; }
                acc0 = (f32x4){uq[0], uq[1], uq[2], uq[3]};
#pragma unroll
                for (int ks = 0; ks < 16; ks += 2) { acc0 = __builtin_amdgcn_mfma_f32_16x16x4f32(aq[ks], bq[ks], acc0, 0, 0, 0); acc1 = __builtin_amdgcn_mfma_f32_16x16x4f32(aq[ks + 1], bq[ks + 1], acc1, 0, 0, 0); }
                acc0 += acc1;
#pragma unroll
                for (int ks = 0; ks < 16; ++ks) bq[ks] = bn[ks];
#pragma unroll
                for (int r = 0; r < 4; ++r) uq[r] = un[r];
            }
            __syncthreads();
            if (wave < 4) {
                float* dst = ch + 1 < NCHK ? Sst + ((size_t)(ch + 1) * 16 + h) * 4096 : a.outp() + O_WKVP + (size_t)h * 4096;
#pragma unroll
                for (int r = 0; r < 4; ++r) { Sb[(4 * g + r) * 68 + 16 * wave + fr] = acc0[r]; dst[(rg * 16 + 4 * g + r) * 64 + 16 * wave + fr] = acc0[r]; }
            }
            __syncthreads();
        }
    } else {
        const int it = (blockIdx.x - 64) * NWAVE + wave;
        if (it < 128) { const int b = it >> 4, h = it & 15;
            scan_item<1>(a, (LAS float*)(lds + 8192 + wave * 2048), TP + b * 32, 32, h, lane, true, a.in(I_SSHIFT) + (size_t)b * DSHIFT, a.in(I_SWKV) + ((size_t)b * 16 + h) * 4096,
                         a.outp() + O_WKVS + ((size_t)b * 16 + h) * 4096, nullptr, nullptr); }
    }
}

__device__ __forceinline__ void phase_attn_prep(const DArgs& a, LAS unsigned char* lds) {
    const int wave = threadIdx.x >> 6, lane = threadIdx.x & 63, gw = blockIdx.x * NWAVE + wave, ngw = gridDim.x * NWAVE;
    const int gt = blockIdx.x * NTHR + threadIdx.x, ngt = gridDim.x * NTHR;
    const bf16_t* qk = (const bf16_t*)(a.wsp() + W_QK); const bf16_t* vT = (const bf16_t*)(a.wsp() + W_VT);
    bf16_t* Ks = (bf16_t*)(a.wsp() + W_KS); bf16_t* VsT = (bf16_t*)(a.wsp() + W_VST);
    for (int i = gt; i < 8 * 576 * 256; i += ngt) {
        const int c8 = i & 255, kk = (i >> 8) % 576, b = i / (576 * 256);
        u32x4 w = (u32x4){0u, 0u, 0u, 0u};
        if (kk < 512) { float v[8]; ld8f(a.in(I_CK) + ((size_t)b * 512 + kk) * D + c8 * 8, v); w.x = pk2(v[0], v[1]); w.y = pk2(v[2], v[3]); w.z = pk2(v[4], v[5]); w.w = pk2(v[6], v[7]); }
        else if (kk < 544) w = *(const u32x4*)(qk + (size_t)(TP + b * 32 + kk - 512) * 4096 + 2048 + c8 * 8);
        *(u32x4*)(Ks + ((size_t)b * 576 + kk) * D + c8 * 8) = w;
    }
    LAS float* scr = (LAS float*)(lds + wave * 8448);
    for (int it = gw; it < 8 * 512; it += ngw) { const int b = it >> 9, r = it & 511, kb = r >> 6, nb = r & 63;
        transpose_item(a.in(I_CV) + (size_t)b * 512 * D, D, VsT + (size_t)b * D * 576, 576, scr, kb * 64, nb * 32, lane); }
    for (int i = gt; i < 8 * D * 8; i += ngt) {
        const int g8 = i & 7, c = (i >> 3) & (D - 1), b = i >> 14;
        u32x4 w = (u32x4){0u, 0u, 0u, 0u};
        if (g8 < 4) w = *(const u32x4*)(vT + (size_t)c * TA + TP + b * 32 + g8 * 8);
        *(u32x4*)(VsT + ((size_t)b * D + c) * 576 + 512 + g8 * 8) = w;
    }
    for (int i = gt; i < 512 * D; i += ngt) { const int r = i >> 11, c = i & (D - 1);
        a.outp()[O_KP + i] = bf2f(qk[(size_t)(TP - 512 + r) * 4096 + 2048 + c]); a.outp()[O_VP + i] = bf2f(vT[(size_t)c * TA + TP - 512 + r]); }
    for (int i = gt; i < TS * D; i += ngt) { const int r = i >> 11, c = i & (D - 1);
        a.outp()[O_KS + i] = bf2f(qk[(size_t)(TP + r) * 4096 + 2048 + c]); a.outp()[O_VS + i] = bf2f(vT[(size_t)c * TA + TP + r]); }
}
constexpr int KT_LD = 272, VT_LD = 144;
constexpr int A_K = 0, A_V = 64 * KT_LD, A_B = A_V + 128 * VT_LD;
__device__ __forceinline__ void phase_attn(const DArgs& a, LAS unsigned char* lds) {
    const int tid = threadIdx.x, wave = tid >> 6, lane = tid & 63, fr = lane & 15, g = lane >> 4;
    const bf16_t* qk = (const bf16_t*)(a.wsp() + W_QK); const bf16_t* vT = (const bf16_t*)(a.wsp() + W_VT);
    const bf16_t* Ks = (const bf16_t*)(a.wsp() + W_KS); const bf16_t* VsT = (const bf16_t*)(a.wsp() + W_VST);
    const float* relb = a.in(I_RELB);
    bf16_t* oatt = (bf16_t*)(a.wsp() + W_MIX);
    LAS float* biasT = (LAS float*)(lds + A_B);
    const float scale = 0.08838834764831845f;
    constexpr int NITEMS = 2048 + 128;
    struct Item { int h, qrow, qpos, tile_lo, tile_hi, qc, nkeys, ldk, ldv, kpos_base; const bf16_t* Kb; const bf16_t* Vb; bool wact, prompt; };
    auto setup = [&](int it) -> Item { Item I; I.prompt = it < 2048; I.qc = 0;
        if (I.prompt) { const int pi = it >> 4; I.h = it & 15; I.qc = 2 * pi + (wave >> 2); I.qrow = I.qc * 64 + (wave & 3) * 16 + fr; I.qpos = I.qrow;
            I.tile_lo = 2 * pi - 8 < 0 ? 0 : 2 * pi - 8; I.tile_hi = 2 * pi + 1; I.nkeys = 1 << 30; I.ldk = 4096; I.ldv = TA; I.kpos_base = 0;
            I.Kb = qk + 2048 + I.h * 128; I.Vb = vT + (size_t)(I.h * 128) * TA; I.wact = true; }
        else { const int s_ = it - 2048, b = s_ >> 4; I.h = s_ & 15; const int w2 = wave & 1; I.qrow = TP + b * 32 + w2 * 16 + fr; I.qpos = 2048 + w2 * 16 + fr;
            I.tile_lo = 0; I.tile_hi = 8; I.nkeys = 544; I.ldk = D; I.ldv = 576; I.kpos_base = 1536;
            I.Kb = Ks + (size_t)b * 576 * D + I.h * 128; I.Vb = VsT + ((size_t)b * D + I.h * 128) * 576; I.wact = wave < 2; }
        return I; };
    u32x4 kreg[2], vreg[2];
    const int kr = tid >> 4, kc = tid & 15, vr = tid >> 3, vc = tid & 7;
#define ATT_LOAD(I_, tile) do { _Pragma("unroll") for (int p_ = 0; p_ < 2; ++p_) { \
        kreg[p_] = *(const u32x4*)((I_).Kb + (size_t)((tile) * 64 + kr + 32 * p_) * (I_).ldk + kc * 8); \
        vreg[p_] = *(const u32x4*)((I_).Vb + (size_t)(vr + 64 * p_) * (I_).ldv + (tile) * 64 + vc * 8); } } while (0)
#define ATT_STORE() do { _Pragma("unroll") for (int p_ = 0; p_ < 2; ++p_) { \
        *(LAS u32x4*)(lds + A_K + (kr + 32 * p_) * KT_LD + kc * 16) = kreg[p_]; \
        *(LAS u32x4*)(lds + A_V + (vr + 64 * p_) * VT_LD + vc * 16) = vreg[p_]; } } while (0)
#define ATT_LOADQ(dst_, I_) do { _Pragma("unroll") for (int ks = 0; ks < 4; ++ks) dst_[ks] = *(const bf16x8*)(qk + (size_t)(I_).qrow * 4096 + (I_).h * 128 + 32 * ks + 8 * g); } while (0)
    if ((int)blockIdx.x >= NITEMS) return;
    Item cur = setup(blockIdx.x);
    bf16x8 qf[4], qfn[4];
    float biasn = tid < 257 ? relb[cur.h * 257 + tid] : 0.f;
    ATT_LOADQ(qf, cur);
    ATT_LOAD(cur, cur.tile_lo);
    for (int it = blockIdx.x; it < NITEMS; it += gridDim.x) {
        const bool has_next = it + (int)gridDim.x < NITEMS;
        const Item nxt = setup(has_next ? it + (int)gridDim.x : it);
        f32x4 oacc[8];
#pragma unroll
        for (int n = 0; n < 8; ++n) oacc[n] = (f32x4){0.f, 0.f, 0.f, 0.f};
        float mrun = -1e30f, lrun = 0.f;
        __syncthreads();
        ATT_STORE();
        if (tid < 257) biasT[tid] = biasn;
        __syncthreads();
        for (int tile = cur.tile_lo; tile <= cur.tile_hi; ++tile) {
            if (tile < cur.tile_hi) ATT_LOAD(cur, tile + 1);
            else if (has_next) { ATT_LOAD(nxt, nxt.tile_lo); ATT_LOADQ(qfn, nxt); biasn = tid < 257 ? relb[nxt.h * 257 + tid] : 0.f; }
            const bool act = cur.wact && (!cur.prompt || (tile >= cur.qc - 8 && tile <= cur.qc));
            if (act) {
                f32x4 sacc[4];
#pragma unroll
                for (int kt = 0; kt < 4; ++kt) { sacc[kt] = (f32x4){0.f, 0.f, 0.f, 0.f};
#pragma unroll
                    for (int ks = 0; ks < 4; ++ks) { const bf16x8 kf = *(const LAS bf16x8*)(lds + A_K + (16 * kt + fr) * KT_LD + (32 * ks + 8 * g) * 2);
                        sacc[kt] = __builtin_amdgcn_mfma_f32_16x16x32_bf16(kf, qf[ks], sacc[kt], 0, 0, 0); } }
                const int kpos0 = cur.kpos_base + tile * 64, kidx0 = tile * 64;
                float tmax = -1e30f;
#pragma unroll
                for (int kt = 0; kt < 4; ++kt)
#pragma unroll
                    for (int r = 0; r < 4; ++r) { const int key = 16 * kt + 4 * g + r; float bias;
                        { int rel = cur.qpos - (kpos0 + key); rel = rel < -128 ? -128 : (rel > 128 ? 128 : rel); bias = biasT[rel + 128]; }
                        float s_ = sacc[kt][r] * scale + bias; if (kidx0 + key >= cur.nkeys) s_ = -1e30f; sacc[kt][r] = s_; tmax = fmaxf(tmax, s_); }
                tmax = fmaxf(tmax, __shfl_xor(tmax, 16)); tmax = fmaxf(tmax, __shfl_xor(tmax, 32));
                const float mnew = fmaxf(mrun, tmax), alpha = __expf(mrun - mnew); mrun = mnew;
                float psum = 0.f;
#pragma unroll
                for (int kt = 0; kt < 4; ++kt)
#pragma unroll
                    for (int r = 0; r < 4; ++r) { const float p_ = __expf(sacc[kt][r] - mnew); sacc[kt][r] = p_; psum += p_; }
                lrun = lrun * alpha + psum;
#pragma unroll
                for (int n = 0; n < 8; ++n) oacc[n] = oacc[n] * alpha;
#pragma unroll
                for (int j = 0; j < 2; ++j) {
                    u32x4 pw; pw.x = pk2(sacc[2 * j][0], sacc[2 * j][1]); pw.y = pk2(sacc[2 * j][2], sacc[2 * j][3]); pw.z = pk2(sacc[2 * j + 1][0], sacc[2 * j + 1][1]); pw.w = pk2(sacc[2 * j + 1][2], sacc[2 * j + 1][3]);
                    const bf16x8 pf = __builtin_bit_cast(bf16x8, pw);
#pragma unroll
                    for (int n = 0; n < 8; ++n) {
                        const u32x2 v0 = *(const LAS u32x2*)(lds + A_V + (16 * n + fr) * VT_LD + (32 * j + 4 * g) * 2);
                        const u32x2 v1 = *(const LAS u32x2*)(lds + A_V + (16 * n + fr) * VT_LD + (32 * j + 16 + 4 * g) * 2);
                        const bf16x8 vf = __builtin_bit_cast(bf16x8, (u32x4){v0.x, v0.y, v1.x, v1.y});
                        oacc[n] = __builtin_amdgcn_mfma_f32_16x16x32_bf16(vf, pf, oacc[n], 0, 0, 0);
                    }
                }
            }
            if (tile < cur.tile_hi) { __syncthreads(); ATT_STORE(); __syncthreads(); }
        }
        if (cur.wact) {
            float l = lrun; l += __shfl_xor(l, 16); l += __shfl_xor(l, 32);
            const float inv = 1.f / l;
#pragma unroll
            for (int n = 0; n < 8; ++n) { u32x2 w; w.x = pk2(oacc[n][0] * inv, oacc[n][1] * inv); w.y = pk2(oacc[n][2] * inv, oacc[n][3] * inv);
                *(u32x2*)(oatt + (size_t)cur.qrow * D + cur.h * 128 + 16 * n + 4 * g) = w; }
        }
        cur = nxt;
#pragma unroll
        for (int ks = 0; ks < 4; ++ks) qf[ks] = qfn[ks];
    }
    __syncthreads();
#undef ATT_LOAD
#undef ATT_STORE
#undef ATT_LOADQ
}


#define XB_TMO      128
#define XB_XCNT(j)  (256  + 64 * (j))
#define XB_XSUB(j)  (1280 + 64 * (j))
#define XB_XGEN(j)  (2304 + 64 * (j))
#define XB_TOP      3328
#define XB_TOPGEN   3392
#define XCD_BAR_WORDS 3456
#define XB_SPIN_CAP (1u << 18)
__device__ __forceinline__ unsigned xb_ld(unsigned* p)              { return __hip_atomic_load(p, __ATOMIC_RELAXED, __HIP_MEMORY_SCOPE_AGENT); }
__device__ __forceinline__ unsigned xb_add(unsigned* p, unsigned v) { return __hip_atomic_fetch_add(p, v, __ATOMIC_RELAXED, __HIP_MEMORY_SCOPE_AGENT); }
__device__ __forceinline__ unsigned xb_xcc_id() { return (unsigned)__builtin_amdgcn_s_getreg((3 << 11) | 20) & 0xFu; }
#define XB_SPIN(cond, bar) do { unsigned _sp = 0; while (cond) { __builtin_amdgcn_s_sleep(1); \
    if ((++_sp & 255u) == 0u) { if (xb_ld(&(bar)[XB_TMO])) break; if (_sp > XB_SPIN_CAP) { atomicAdd(&(bar)[XB_TMO], 1u); break; } } } } while (0)
struct XcdBarrier { unsigned* bar; unsigned x; volatile LAS unsigned* st; };
__device__ __forceinline__ XcdBarrier xcd_barrier_post(unsigned* bar, volatile LAS unsigned* st) {
    XcdBarrier b; b.bar = bar; b.x = xb_xcc_id(); b.st = st;
    if (threadIdx.x == 0) (void)xb_add(&bar[XB_XCNT(b.x)], 1u);
    return b;
}
__device__ __forceinline__ void xcd_barrier_complete(unsigned* bar, unsigned x, unsigned& nloc, unsigned& nx) {
    const unsigned G = gridDim.x * gridDim.y * gridDim.z;
    unsigned sum, cnt, mine, sp = 0u;
    for (;;) {
        sum = 0u; cnt = 0u; mine = 0u;
#pragma unroll
        for (unsigned j = 0; j < 16; ++j) { const unsigned c = xb_ld(&bar[XB_XCNT(j)]); sum += c; cnt += (c > 0u) ? 1u : 0u; mine = (j == x) ? c : mine; }
        if (sum == G) break;
        __builtin_amdgcn_s_sleep(1);
        if ((++sp & 255u) == 0u) { if (xb_ld(&bar[XB_TMO])) break; if (sp > XB_SPIN_CAP) { atomicAdd(&bar[XB_TMO], 1u); break; } }
    }
    nloc = mine > 0u ? mine : 1u; nx = cnt > 0u ? cnt : 1u;
}
__device__ __forceinline__ void xcd_barrier(const XcdBarrier& b) {
    asm volatile("s_waitcnt vmcnt(0)" ::: "memory");
    __syncthreads();
    if (threadIdx.x == 0) {
        unsigned* bar = b.bar;
        __builtin_amdgcn_s_waitcnt(0);
        unsigned nloc = b.st[0], nx = b.st[1];
        if (nloc == 0u) { xcd_barrier_complete(bar, b.x, nloc, nx); b.st[0] = nloc; b.st[1] = nx; }
        const unsigned old = xb_add(&bar[XB_XSUB(b.x)], 1u);
        const unsigned gen = old / nloc;
        if (old + 1u == (gen + 1u) * nloc) {
            __builtin_amdgcn_fence(__ATOMIC_RELEASE, "agent");
            asm volatile("s_waitcnt vmcnt(0)" ::: "memory");
            const unsigned og = xb_add(&bar[XB_TOP], 1u);
            const unsigned tg = og / nx;
            if (og + 1u == (tg + 1u) * nx) xb_add(&bar[XB_TOPGEN], 1u);
            else XB_SPIN(xb_ld(&bar[XB_TOPGEN]) == tg, bar);
            __builtin_amdgcn_fence(__ATOMIC_ACQUIRE, "agent");
            xb_add(&bar[XB_XGEN(b.x)], 1u);
            asm volatile("s_waitcnt vmcnt(0)" ::: "memory");
        } else {
            XB_SPIN(xb_ld(&bar[XB_XGEN(b.x)]) == gen, bar);
            __builtin_amdgcn_fence(__ATOMIC_ACQUIRE, "agent");
            asm volatile("s_waitcnt vmcnt(0)" ::: "memory");
        }
    }
    __syncthreads();
}

__global__ __launch_bounds__(512, 2) void mega(Args aa) {
    extern __shared__ __attribute__((aligned(16))) unsigned char shm[];
    LAS unsigned char* lds = (LAS unsigned char*)shm;
    cg::grid_group grid = cg::this_grid();
    {
        LAS unsigned long long* tabw = (LAS unsigned long long*)(lds + 131072);
        if (threadIdx.x == 0) {
#pragma unroll
            for (int i = 0; i < 32; ++i) tabw[i] = (unsigned long long)aa.in[i];
            tabw[32] = (unsigned long long)aa.out; tabw[33] = (unsigned long long)aa.ws;
        }
        __syncthreads();
    }
    DArgs a; a.tab = (LAS const unsigned long long*)(lds + 131072); a.ph_lo = aa.ph_lo; a.ph_hi = aa.ph_hi;
    volatile LAS unsigned* xb_st = (volatile LAS unsigned*)(lds + 131072 + 448);
    if (threadIdx.x == 0) { xb_st[0] = 0u; xb_st[1] = 0u; }
    __syncthreads();
    const XcdBarrier xb = xcd_barrier_post((unsigned*)(__attribute__((address_space(1))) unsigned*)(a.wsp() + W_BAR), xb_st);
#define gn a.in(I_GNORM)
#define ws a.wsp()
    const int nM = TA / 256;
#ifndef PHMASK
#define PHMASK 0x3fffff
#endif
#ifndef DUPMASK
#define DUPMASK 0
#endif
#define PH(p) if (((PHMASK >> (p)) & 1) && a.ph_lo <= (p) && (p) < a.ph_hi) for (int rep_ = 0; rep_ < (((DUPMASK >> (p)) & 1) ? 2 : 1); ++rep_, (((DUPMASK >> (p)) & 1) && rep_ < 2 ? grid.sync() : (void)0))
#define SYNC(p) if (a.ph_lo <= (p) && (p) + 1 < a.ph_hi) xcd_barrier(xb);
    if (a.ph_lo < 0) grid.sync();
    PH(0) { phase_mod_partial(a, lds); phase_convert(a, lds); }
    SYNC(0)
    PH(1) { phase_mod_final(a); }
    SYNC(1)
    PH(2) { phase_rowwise<true, false, true>(a, lds, nullptr, 0, 0, gn + 0 * D, 0, 1, 0); }
    SYNC(2)
    PH(3) { pg8::EpiBf16<0> E{(bf16_t*)(ws + W_P), DIN0, nullptr};
        run_gemm(lds, D, D, D, ws + W_HA, ws + W_IN0T, nM, DIN0 / 256, 0, nullptr, nullptr, 0, 0, E);
        const int c0 = (nM * (DIN0 / 256)) % (int)gridDim.x; convert_sub(a, lds, CV_OUT0, c0); convert_sub(a, lds, CV_FF1_0, c0); }
    SYNC(3)
    PH(4) { phase_prep(a); }
    SYNC(4)
    PH(5) { { pg8::EpiBf16<0> E{(bf16_t*)(ws + W_MIX), D, nullptr};
          run_gemm(lds, 256, 1280, 256, ws + W_AL, ws + W_POOLT, nM, 4, 512, nullptr, nullptr, 0, 0, E); }
        { pg8::EpiF32 E{(float*)(ws + W_L), 3072};
          run_gemm(lds, 256, 1280, 256, ws + W_AL + 2048, ws + W_LORAT, nM, 12, 0, nullptr, nullptr, 0, 0, E); } }
    SYNC(5)
    PH(6) { phase_scan_a(a, lds); }
    SYNC(6)
    PH(7) { phase_scan_b(a, lds); }
    SYNC(7)
    PH(8) { phase_scan_c(a, lds); }
    SYNC(8)
    PH(9) { pg8::Epi2<pg8::EpiBf16<0>, pg8::EpiPartF32> E{{(bf16_t*)(ws + W_O), D, nullptr}, {(float*)(ws + W_OACC), D}};
        run_gemm(lds, D, D, D, ws + W_MIX, ws + W_OUT0T, 64, 8, 0, ws + W_MIX, ws + W_OUT0T, 0, 8, E, 8, 64); }
    SYNC(9)
    PH(10) { phase_rowwise<true, true, true>(a, lds, gn + 1 * D, 0, 2, gn + 2 * D, 0, 4, 3, 8); }
    SYNC(10)
    PH(11) { pg8::EpiBf16<1> E{(bf16_t*)(ws + W_F1), DFF, nullptr};
        run_gemm(lds, D, D, D, ws + W_HA, ws + W_FF1T, nM, DFF / 256, 0, nullptr, nullptr, 0, 0, E);
        const int c0 = (nM * (DFF / 256)) % (int)gridDim.x; convert_sub(a, lds, CV_FF2_0, c0); convert_sub(a, lds, CV_QKV, c0); }
    SYNC(11)
    PH(12) { pg8::Epi2<pg8::EpiBf16<0>, pg8::EpiPartF32> E{{(bf16_t*)(ws + W_O), D, nullptr}, {(float*)(ws + W_OACC), D}};
        run_gemm(lds, DFF, DFF, DFF, ws + W_F1, ws + W_FF2T, 64, 8, 0, ws + W_F1, ws + W_FF2T, 0, 8, E, 32, 64); }
    SYNC(12)
    PH(13) { phase_rowwise<false, true, true>(a, lds, gn + 3 * D, 0, 5, gn + 4 * D, 1, 1, 0, 32); }
    SYNC(13)
    PH(14) { pg8::Epi2<pg8::EpiBf16<0>, pg8::EpiBf16<0>> E{{(bf16_t*)(ws + W_QK), 4096, nullptr}, {(bf16_t*)(ws + W_VT), TA, nullptr}};
        run_gemm(lds, D, D, D, ws + W_HA, ws + W_QKVT, nM, 16, 0, ws + W_QKVT + (size_t)4096 * D * 2, ws + W_HA, 8, nM, E);
        const int c0 = (nM * 24) % (int)gridDim.x; convert_sub(a, lds, CV_OUT1, c0); convert_sub(a, lds, CV_FF1_1, c0); }
    SYNC(14)
    PH(15) { phase_attn_prep(a, lds); }
    SYNC(15)
    PH(16) { phase_attn(a, lds); }
    SYNC(16)
    PH(17) { pg8::Epi2<pg8::EpiBf16<0>, pg8::EpiPartF32> E{{(bf16_t*)(ws + W_O), D, nullptr}, {(float*)(ws + W_OACC), D}};
        run_gemm(lds, D, D, D, ws + W_MIX, ws + W_OUT1T, 64, 8, 0, ws + W_MIX, ws + W_OUT1T, 0, 8, E, 8, 64); }
    SYNC(17)
    PH(18) { phase_rowwise<false, true, true>(a, lds, gn + 5 * D, 1, 2, gn + 6 * D, 1, 4, 3, 8); }
    SYNC(18)
    PH(19) { pg8::EpiBf16<1> E{(bf16_t*)(ws + W_F1), DFF, nullptr};
        run_gemm(lds, D, D, D, ws + W_HA, ws + W_FF1T, nM, DFF / 256, 0, nullptr, nullptr, 0, 0, E);
        const int c0 = (nM * (DFF / 256)) % (int)gridDim.x; convert_sub(a, lds, CV_FF2_1, c0); }
    SYNC(19)
    PH(20) { pg8::Epi2<pg8::EpiBf16<0>, pg8::EpiPartF32> E{{(bf16_t*)(ws + W_O), D, nullptr}, {(float*)(ws + W_OACC), D}};
        run_gemm(lds, DFF, DFF, DFF, ws + W_F1, ws + W_FF2T, 64, 8, 0, ws + W_F1, ws + W_FF2T, 0, 8, E, 32, 64); }
    SYNC(20)
    PH(21) { phase_rowwise<false, true, false>(a, lds, gn + 7 * D, 1, 5, nullptr, 0, 0, 0, 32); }
#undef PH
#undef SYNC
#undef gn
#undef ws
}

constexpr int NPHASE = 22;
#ifndef MK_MULTI
#define MK_MULTI 0
#endif
extern "C" void kernel_launch(void* const* d_in, const int* in_sizes, int n_in, void* d_out, int out_size, void* d_ws, size_t ws_size, hipStream_t stream) {
    static int grid = 0;
    constexpr int LDS_BYTES = 131072 + 512;
    if (grid == 0) {
        if (n_in != 32 || ws_size < WS_TOTAL) { fprintf(stderr, "kernel_launch: unexpected n_in %d / ws %zu (need %zu)\n", n_in, ws_size, (size_t)WS_TOTAL); grid = -1; return; }
        int dev = 0, cus = 0, per_cu = 0;
        hipGetDevice(&dev); hipDeviceGetAttribute(&cus, hipDeviceAttributeMultiprocessorCount, dev);
        if (hipFuncSetAttribute((const void*)mega, hipFuncAttributeMaxDynamicSharedMemorySize, LDS_BYTES) != hipSuccess) { fprintf(stderr, "kernel_launch: hipFuncSetAttribute failed\n"); grid = -1; return; }
        hipOccupancyMaxActiveBlocksPerMultiprocessor(&per_cu, (const void*)mega, NTHR, LDS_BYTES);
        if (per_cu < 1) { fprintf(stderr, "kernel_launch: occupancy query says %d blocks per CU\n", per_cu); per_cu = 1; }
        (void)hipGetLastError();
        grid = cus;
    }
    if (grid < 0) return;
    Args a{};
    for (int i = 0; i < 32; ++i) a.in[i] = (const float*)d_in[i];
    a.out = (float*)d_out; a.ws = (unsigned char*)d_ws;
#if MK_MULTI
    for (int p = 0; p < NPHASE; ++p) { a.ph_lo = p; a.ph_hi = p + 1; hipLaunchKernelGGL(mega, dim3(grid), dim3(NTHR), LDS_BYTES, stream, a); }
#else
    a.ph_lo = 0; a.ph_hi = NPHASE;
    if (hipMemsetAsync((char*)d_ws + W_BAR, 0, XCD_BAR_WORDS * 4, stream) != hipSuccess) { fprintf(stderr, "kernel_launch: memset of barrier words failed\n"); return; }
    void* args[] = {&a};
    hipError_t e = hipLaunchCooperativeKernel((const void*)mega, dim3(grid), dim3(NTHR), args, LDS_BYTES, stream);
    if (e != hipSuccess) fprintf(stderr, "kernel_launch: cooperative launch failed: %s (grid %d)\n", hipGetErrorString(e), grid);
#endif
}
```

```cpp
#include <hip/hip_runtime.h>
#include <hip/hip_cooperative_groups.h>
#include <cstdio>
#include <cstdint>
namespace cg = cooperative_groups;

#define LAS __attribute__((address_space(3)))
typedef unsigned short bf16_t;
typedef short bf16x8 __attribute__((ext_vector_type(8)));
typedef short bf16x4 __attribute__((ext_vector_type(4)));
typedef float f32x4 __attribute__((ext_vector_type(4)));
typedef float f32x2 __attribute__((ext_vector_type(2)));
typedef unsigned u32x4 __attribute__((ext_vector_type(4)));
typedef unsigned u32x2 __attribute__((ext_vector_type(2)));

constexpr int TP = 16384, TS = 256, TA = TP + TS;
constexpr int D = 2048, DFF = 8192, DIN0 = 4352, DPOOL = 1024, DSHIFT = 3328;
constexpr int NWAVE = 8, NTHR = 512;
constexpr int CHK = 128, NCHK = TP / CHK;
constexpr size_t O_Y = 0, O_POOLP = 34078720, O_POOLS = 34094080, O_SHIFTP = 34216960, O_SHIFTS = 34220288,
                 O_WKVP = 34246912, O_WKVS = 34312448, O_KP = 34836736, O_VP = 35885312, O_KS = 36933888, O_VS = 37458176;
constexpr size_t W_IN0T = 0, W_OUT0T = 17825792, W_QKVT = 26214400, W_OUT1T = 51380224, W_FF1T = 59768832, W_FF2T = 93323264,
                 W_POOLT = 126877696, W_LORAT = 127401984, W_MOD = 128974848, W_MODPART = 129859584,
                 W_HA = 144015360, W_MIX = 212172800, W_O = 280330240, W_R = 348487680, WS_END = 697794560;
constexpr size_t W_AL = W_HA;
constexpr size_t W_SST = W_HA;
constexpr size_t W_PC = W_O, W_UC = W_O + 33554432;
constexpr size_t W_P = W_R, W_L = W_R + 144834560;
constexpr size_t W_F1 = W_R;
constexpr size_t W_QK = W_R, W_VT = W_R + 136314880, W_KS = W_R + 204472320, W_VST = W_R + 223346688;
constexpr int KSPLIT = 16;
constexpr size_t W_BAR = WS_END, WS_TOTAL = WS_END + 16384;
constexpr size_t W_OACC = W_R + 272629760, WS_END2 = WS_END;

struct Args {
    const float* in[32];
    float* out;
    unsigned char* ws;
    int ph_lo, ph_hi;
};
struct DArgs {
    LAS const unsigned long long* tab; int ph_lo, ph_hi;
    __device__ __forceinline__ unsigned long long ld(int i) const { const unsigned long long v = tab[i];
        const unsigned lo = __builtin_amdgcn_readfirstlane((unsigned)v), hi = __builtin_amdgcn_readfirstlane((unsigned)(v >> 32)); return ((unsigned long long)hi << 32) | lo; }
    __device__ __forceinline__ const float* in(int i) const { return (const float*)(const __attribute__((address_space(1))) float*)ld(i); }
    __device__ __forceinline__ float* outp() const { return (float*)(__attribute__((address_space(1))) float*)ld(32); }
    __device__ __forceinline__ unsigned char* wsp() const { return (unsigned char*)(__attribute__((address_space(1))) unsigned char*)ld(33); }
};
enum { I_XP = 0, I_XS, I_CP, I_CS, I_SPOOL, I_SSHIFT, I_SWKV, I_CK, I_CV, I_WADA, I_BADA, I_GNORM, I_WIN0, I_WPOOL, I_PSCALE, I_MU,
       I_W0, I_W2, I_A0, I_A2, I_G2, I_KK, I_KA, I_RK, I_LNW, I_LNB, I_WOUT0, I_WQKV, I_RELB, I_WOUT1, I_WFF1, I_WFF2 };

__device__ __forceinline__ float bf2f(bf16_t b) { return __uint_as_float(((unsigned)b) << 16); }
__device__ __forceinline__ float bflo(unsigned w) { return __uint_as_float(w << 16); }
__device__ __forceinline__ float bfhi(unsigned w) { return __uint_as_float(w & 0xffff0000u); }
__device__ __forceinline__ unsigned pk2(float lo, float hi) { unsigned r; asm("v_cvt_pk_bf16_f32 %0, %1, %2" : "=v"(r) : "v"(lo), "v"(hi)); return r; }
__device__ __forceinline__ bf16_t f2bf(float f) { return (bf16_t)(pk2(f, 0.f) & 0xffffu); }
__device__ __forceinline__ float rl(float v, int l) { return __int_as_float(__builtin_amdgcn_readlane(__float_as_int(v), l)); }
template <int CTRL> __device__ __forceinline__ float dppf(float v) { return __int_as_float(__builtin_amdgcn_update_dpp(0, __float_as_int(v), CTRL, 0xf, 0xf, false)); }
__device__ __forceinline__ float wave_sum(float v) {
    v += dppf<0xB1>(v); v += dppf<0x4E>(v); v += dppf<0x141>(v); v += dppf<0x140>(v);
    return (rl(v, 0) + rl(v, 16)) + (rl(v, 32) + rl(v, 48));
}
__device__ __forceinline__ float sigmoidf_(float x) { return __builtin_amdgcn_rcpf(1.f + __expf(-x)); }
__device__ __forceinline__ int entry_of(int row) { return row < TP ? 0 : 1 + ((row - TP) >> 5); }

namespace pg8 {
constexpr int BM = 256, BK = 64, HALF = 128, HTB = HALF * BK * 2, STAGE_BYTES = 8 * HTB, NXCD = 8, WGM = 8;
__device__ __forceinline__ int lds_byte(int r, int c) { const int st = (r >> 4) * 2 + (c >> 5), rr = r & 15, cc = c & 31, ob = rr * 64 + cc * 2; return st * 1024 + (ob ^ (((ob >> 9) & 1) << 5)); }
__device__ __forceinline__ void stage_rc(int b, int& R, int& C) { const int st = b / 1024, sb = b % 1024, swz = sb ^ (((sb >> 9) & 1) << 5); R = (st >> 1) * 16 + swz / 64; C = (st & 1) * 32 + (swz % 64) / 2; }
__device__ __forceinline__ int perm32(int rho) { const int n = rho >> 4, i = rho & 15; return 8 * (i >> 2) + 4 * n + (i & 3); }

struct Unit { const char* a; const char* b; int pm, pn, g, nt, sl; };
struct GDesc { const char* A; const char* B; int nM, nN; long a_pn_off; };
struct Sched {
    GDesc g0, g1; int n0, n1, G, c; long tstepA, tstepB; int nt0, S1, nt1, pm1; long ksb;
    __device__ __forceinline__ void decode(const GDesc& g, int L, Unit& u, int gi) const {
        const int nwg = g.nM * g.nN; int wgid = L;
        { const int q = nwg / NXCD, r = nwg % NXCD, xcd = wgid % NXCD, off = wgid / NXCD; wgid = (xcd < r ? xcd * (q + 1) : r * (q + 1) + (xcd - r) * q) + off; }
        const int nig = WGM * g.nN, gid = wgid / nig, fm = gid * WGM, gsz = (g.nM - fm) < WGM ? (g.nM - fm) : WGM;
        u.pm = fm + ((wgid % nig) % gsz); u.pn = (wgid % nig) / gsz; u.g = gi;
        u.a = g.A + (long)u.pm * tstepA + (long)u.pn * g.a_pn_off; u.b = g.B + (long)u.pn * tstepB;
    }
    __device__ __forceinline__ bool next(int i, Unit& u) const {
        const long L = (long)i * G + c;
        if (L < n0) { decode(g0, (int)L, u, 0); u.nt = nt0; return true; }
        if (L < n0 + n1) {
            if (S1 == 0) { decode(g1, (int)(L - n0), u, 1); u.nt = nt0; }
            else { const int q = (int)(L - n0), sl = q / g1.nN, pn = q % g1.nN; u.pm = pm1; u.pn = pn; u.g = 1; u.nt = nt1; u.sl = sl;
                u.a = g1.A + (long)pm1 * tstepA + (long)sl * ksb; u.b = g1.B + (long)pn * tstepB + (long)sl * ksb; }
            return true; }
        return false;
    }
};

template <int ACT> struct EpiBf16 {
    bf16_t* O; int ldc; const float* cs;
    __device__ __forceinline__ void operator()(const f32x4 (&acc)[2][2][4][2], const Unit& u, int wr, int wc, int fr, int fq) const {
        const int row0 = u.pm * BM + wr * 64 + fr, col0 = u.pn * BM + wc * 32 + 8 * fq;
        f32x4 sv[2][2];
        if (ACT == 2) {
#pragma unroll
            for (int bj = 0; bj < 2; ++bj)
#pragma unroll
                for (int n = 0; n < 2; ++n) sv[bj][n] = *(const f32x4*)(cs + col0 + bj * HALF + 4 * n);
        }
#pragma unroll
        for (int ai = 0; ai < 2; ++ai)
#pragma unroll
            for (int m = 0; m < 4; ++m) { bf16_t* rowp = O + (size_t)(row0 + ai * HALF + m * 16) * ldc + col0;
#pragma unroll
                for (int bj = 0; bj < 2; ++bj) { f32x4 v0 = acc[ai][bj][m][0], v1 = acc[ai][bj][m][1];
                    if (ACT == 1) {
#pragma unroll
                        for (int j = 0; j < 4; ++j) { const float a0 = fmaxf(v0[j], 0.f), a1 = fmaxf(v1[j], 0.f); v0[j] = a0 * a0; v1[j] = a1 * a1; } }
                    if (ACT == 2) { v0 = v0 * sv[bj][0]; v1 = v1 * sv[bj][1]; }
                    u32x4 w; w.x = pk2(v0[0], v0[1]); w.y = pk2(v0[2], v0[3]); w.z = pk2(v1[0], v1[1]); w.w = pk2(v1[2], v1[3]);
                    *(u32x4*)(rowp + bj * HALF) = w; } }
    }
};
struct EpiF32 {
    float* C; int ldc;
    __device__ __forceinline__ void operator()(const f32x4 (&acc)[2][2][4][2], const Unit& u, int wr, int wc, int fr, int fq) const {
        const int row0 = u.pm * BM + wr * 64 + fr, col0 = u.pn * BM + wc * 32 + 8 * fq;
#pragma unroll
        for (int ai = 0; ai < 2; ++ai)
#pragma unroll
            for (int m = 0; m < 4; ++m) { float* rowp = C + (size_t)(row0 + ai * HALF + m * 16) * ldc + col0;
#pragma unroll
                for (int bj = 0; bj < 2; ++bj)
#pragma unroll
                    for (int n = 0; n < 2; ++n) *(f32x4*)(rowp + bj * HALF + 4 * n) = acc[ai][bj][m][n]; }
    }
};
struct EpiPartF32 {
    float* C; int ldc;
    __device__ __forceinline__ void operator()(const f32x4 (&acc)[2][2][4][2], const Unit& u, int wr, int wc, int fr, int fq) const {
        const int row0 = wr * 64 + fr, col0 = u.pn * BM + wc * 32 + 8 * fq;
        float* base = C + (size_t)u.sl * 256 * ldc;
#pragma unroll
        for (int ai = 0; ai < 2; ++ai)
#pragma unroll
            for (int m = 0; m < 4; ++m) { float* rowp = base + (size_t)(row0 + ai * HALF + m * 16) * ldc + col0;
#pragma unroll
                for (int bj = 0; bj < 2; ++bj)
#pragma unroll
                    for (int n = 0; n < 2; ++n) *(f32x4*)(rowp + bj * HALF + 4 * n) = acc[ai][bj][m][n]; }
    }
};
template <class E0, class E1> struct Epi2 {
    E0 e0; E1 e1;
    __device__ __forceinline__ void operator()(const f32x4 (&acc)[2][2][4][2], const Unit& u, int wr, int wc, int fr, int fq) const {
        if (u.g == 0) e0(acc, u, wr, wc, fr, fq); else e1(acc, u, wr, wc, fr, fq);
    }
};

template <class Epi>
__device__ __forceinline__ void gemm_phase(LAS unsigned char* lds, const int K, const int lda, const int ldb, const Sched& S, const Epi& E) {
    const int tid = threadIdx.x, wid = __builtin_amdgcn_readfirstlane(tid >> 6), lane = tid & 63, wr = wid >> 2, wc = wid & 3, fr = lane & 15, fq = lane >> 4;
    unsigned voffA[2], voffB[2];
#pragma unroll
    for (int i = 0; i < 2; ++i) { int R, C; stage_rc(tid * 16 + i * 8192, R, C); const int Rb = (R & ~31) + perm32(R & 31);
        voffA[i] = (unsigned)(R * lda + C) * 2u; voffB[i] = (unsigned)(Rb * ldb + C) * 2u; }
    const size_t kstep = (size_t)(BK * 2);
    const size_t hstepA = (size_t)HALF * lda * 2, hstepB = (size_t)HALF * ldb * 2;
    const unsigned ldsw = (unsigned)wid * 1024u;
    const int aoff = lds_byte(wr * 64 + fr, fq * 8), boff = lds_byte(wc * 32 + fr, fq * 8);
#define PG8_SA(b, h) (((b) * 2 + (h)) * HTB)
#define PG8_SB(b, h) ((4 + (b) * 2 + (h)) * HTB)
#define PG8_STAGE(bufoff, gbase, voff) do { _Pragma("unroll") for (int _i = 0; _i < 2; ++_i) \
        __builtin_amdgcn_global_load_lds((const unsigned*)((const char*)(gbase) + (voff)[_i]), (LAS unsigned*)(lds + (bufoff) + ldsw + _i * 8192), 16, 0, 0); } while (0)
#define PG8_LDA(dst, b, h) do { _Pragma("unroll") for (int m = 0; m < 4; ++m) _Pragma("unroll") for (int k = 0; k < 2; ++k) dst[m][k] = *(const LAS bf16x8*)(lds + PG8_SA(b, h) + aoff + m * 2048 + k * 1024); } while (0)
#define PG8_LDB(dst, b, h) do { _Pragma("unroll") for (int n = 0; n < 2; ++n) _Pragma("unroll") for (int k = 0; k < 2; ++k) dst[n][k] = *(const LAS bf16x8*)(lds + PG8_SB(b, h) + boff + n * 2048 + k * 1024); } while (0)
#define PG8_MMA(ai, bj, At, Bt) do { __builtin_amdgcn_s_setprio(1); _Pragma("unroll") for (int m = 0; m < 4; ++m) _Pragma("unroll") for (int n = 0; n < 2; ++n) _Pragma("unroll") for (int k = 0; k < 2; ++k) \
        acc[ai][bj][m][n] = __builtin_amdgcn_mfma_f32_16x16x32_bf16(Bt[n][k], At[m][k], acc[ai][bj][m][n], 0, 0, 0); __builtin_amdgcn_s_setprio(0); } while (0)
#define PG8_WAIT_V(n) asm volatile("s_waitcnt vmcnt(" #n ")" ::: "memory")
#define PG8_WAIT_L(n) asm volatile("s_waitcnt lgkmcnt(" #n ")" ::: "memory")
#define PG8_BAR __builtin_amdgcn_s_barrier()
#define PG8_SCHED __builtin_amdgcn_sched_barrier(0)
    Unit cur, nxt; int ui = 0;
    if (!S.next(0, cur)) return;
    f32x4 acc[2][2][4][2];
#pragma unroll
    for (int a = 0; a < 2; ++a)
#pragma unroll
        for (int b = 0; b < 2; ++b)
#pragma unroll
            for (int m = 0; m < 4; ++m)
#pragma unroll
                for (int n = 0; n < 2; ++n) acc[a][b][m][n] = (f32x4){0.f, 0.f, 0.f, 0.f};
    bf16x8 At[4][2], B0[2][2], B1[2][2];
    const char* cA = cur.a; const char* cB = cur.b;
    PG8_STAGE(PG8_SB(0, 0), cB, voffB); PG8_STAGE(PG8_SB(0, 1), cB + hstepB, voffB); PG8_STAGE(PG8_SA(0, 0), cA, voffA); PG8_STAGE(PG8_SA(0, 1), cA + hstepA, voffA);
    if (wr == 1) PG8_BAR;
    PG8_WAIT_V(2); PG8_BAR;
    PG8_STAGE(PG8_SB(1, 0), cB + kstep, voffB); PG8_STAGE(PG8_SA(1, 0), cA + kstep, voffA); PG8_STAGE(PG8_SB(1, 1), cB + hstepB + kstep, voffB);
    PG8_WAIT_V(6); PG8_BAR;
    for (;;) {
        const bool has_next = S.next(ui + 1, nxt);
        const char* nA = has_next ? nxt.a : cA; const char* nB = has_next ? nxt.b : cB;
        const int nt = cur.nt;
#pragma unroll 1
        for (int t = 0; t < nt; t += 2) {
            const bool last = (t == nt - 2);
            const char* a1 = cA + (size_t)(t + 1) * kstep;
            const char* a2 = last ? nA : cA + (size_t)(t + 2) * kstep; const char* b2 = last ? nB : cB + (size_t)(t + 2) * kstep;
            const char* a3 = a2 + kstep; const char* b3 = b2 + kstep;
            PG8_LDB(B0, 0, 0); PG8_LDB(B1, 0, 1); PG8_SCHED; PG8_LDA(At, 0, 0); PG8_STAGE(PG8_SA(1, 1), a1 + hstepA, voffA);
            PG8_WAIT_V(8); PG8_WAIT_L(0); PG8_BAR; PG8_MMA(0, 0, At, B0); PG8_MMA(0, 1, At, B1); PG8_BAR; PG8_SCHED;
            PG8_LDA(At, 0, 1); PG8_STAGE(PG8_SB(0, 0), b2, voffB); PG8_STAGE(PG8_SB(0, 1), b2 + hstepB, voffB); PG8_STAGE(PG8_SA(0, 0), a2, voffA);
            PG8_WAIT_V(8); PG8_WAIT_L(0); PG8_BAR; PG8_MMA(1, 0, At, B0); PG8_MMA(1, 1, At, B1); PG8_BAR; PG8_SCHED;
            PG8_LDB(B0, 1, 0); PG8_LDB(B1, 1, 1); PG8_SCHED; PG8_LDA(At, 1, 0); PG8_STAGE(PG8_SA(0, 1), a2 + hstepA, voffA);
            PG8_WAIT_V(8); PG8_WAIT_L(0); PG8_BAR; PG8_MMA(0, 0, At, B0); PG8_MMA(0, 1, At, B1); PG8_BAR; PG8_SCHED;
            PG8_LDA(At, 1, 1); PG8_STAGE(PG8_SB(1, 0), b3, voffB); PG8_STAGE(PG8_SB(1, 1), b3 + hstepB, voffB); PG8_STAGE(PG8_SA(1, 0), a3, voffA);
            PG8_WAIT_V(8); PG8_WAIT_L(0); PG8_BAR; PG8_MMA(1, 0, At, B0); PG8_MMA(1, 1, At, B1); PG8_BAR; PG8_SCHED;
        }
        if (wr == 0) PG8_BAR;
        E(acc, cur, wr, wc, fr, fq);
        if (!has_next) break;
#pragma unroll
        for (int a = 0; a < 2; ++a)
#pragma unroll
            for (int b = 0; b < 2; ++b)
#pragma unroll
                for (int m = 0; m < 4; ++m)
#pragma unroll
                    for (int n = 0; n < 2; ++n) acc[a][b][m][n] = (f32x4){0.f, 0.f, 0.f, 0.f};
        cur = nxt; cA = nA; cB = nB; ++ui;
        if (wr == 1) PG8_BAR;
    }
    PG8_WAIT_V(0);
    PG8_BAR;
#undef PG8_SA
#undef PG8_SB
#undef PG8_STAGE
#undef PG8_LDA
#undef PG8_LDB
#undef PG8_MMA
#undef PG8_WAIT_V
#undef PG8_WAIT_L
#undef PG8_BAR
#undef PG8_SCHED
}
}

template <class Epi>
__device__ __forceinline__ void run_gemm(LAS unsigned char* lds, int K, int lda, int ldb, const void* A0, const void* B0, int nM0, int nN0, long apn0,
                                         const void* A1, const void* B1, int nM1, int nN1, const Epi& E, int S1 = 0, int pm1 = 0) {
    pg8::Sched S;
    S.nt0 = K / 64; S.S1 = S1; S.pm1 = pm1; S.nt1 = S1 ? K / 64 / S1 : 0; S.ksb = S1 ? (long)(K / S1) * 2 : 0;
    S.g0.A = (const char*)A0; S.g0.B = (const char*)B0; S.g0.nM = nM0; S.g0.nN = nN0; S.g0.a_pn_off = apn0;
    S.g1.A = (const char*)A1; S.g1.B = (const char*)B1; S.g1.nM = nM1; S.g1.nN = nN1; S.g1.a_pn_off = 0;
    S.n0 = nM0 * nN0; S.n1 = S1 ? S1 * nN1 : nM1 * nN1; S.G = gridDim.x; S.c = blockIdx.x;
    S.tstepA = (long)256 * lda * 2; S.tstepB = (long)256 * ldb * 2;
    pg8::gemm_phase<Epi>(lds, K, lda, ldb, S, E);
    __syncthreads();
}

__device__ __forceinline__ void transpose_item(const float* W, int ldw, bf16_t* WT, int ldo, LAS float* scr, int k0, int n0, int lane, const float* rs = nullptr) {
#pragma unroll 8
    for (int i = 0; i < 32; ++i) { const int kk = 2 * i + (lane >> 5); scr[kk * 33 + (lane & 31)] = W[(size_t)(k0 + kk) * ldw + n0 + (lane & 31)]; }
    asm volatile("s_waitcnt lgkmcnt(0)" ::: "memory");
    const int c = lane & 7;
#pragma unroll
    for (int j = 0; j < 4; ++j) { const int n = (lane >> 3) + 8 * j; const LAS float* s = scr + (8 * c) * 33 + n; const float m = rs ? rs[n0 + n] : 1.f;
        u32x4 o; o.x = pk2(s[0 * 33] * m, s[1 * 33] * m); o.y = pk2(s[2 * 33] * m, s[3 * 33] * m); o.z = pk2(s[4 * 33] * m, s[5 * 33] * m); o.w = pk2(s[6 * 33] * m, s[7 * 33] * m);
        *(u32x4*)(WT + (size_t)(n0 + n) * ldo + k0 + 8 * c) = o; }
    asm volatile("s_waitcnt lgkmcnt(0)" ::: "memory");
}
__device__ __forceinline__ void transpose_matrix(const float* W, int K, int N, bf16_t* WT, int ldo, LAS float* scr, int gw, int ngw, int lane, const float* rs = nullptr) {
    const int nblk = N / 32, nitems = (K / 64) * nblk;
    for (int it = gw; it < nitems; it += ngw) { const int kb = it / nblk, nb = it % nblk; transpose_item(W, N, WT, ldo, scr, kb * 64, nb * 32, lane, rs); }
}

__device__ __forceinline__ void phase_mod_partial(const DArgs& a, LAS unsigned char* lds) {
    LAS float* sil = (LAS float*)lds;
    for (int i = threadIdx.x; i < 9 * D; i += NTHR) { const int e = i / D, d = i % D; const float c = e == 0 ? a.in(I_CP)[d] : a.in(I_CS)[(e - 1) * D + d]; sil[i] = c / (1.f + __expf(-c)); }
    __syncthreads();
    const int wave = threadIdx.x >> 6, lane = threadIdx.x & 63, gw = blockIdx.x * NWAVE + wave, ngw = gridDim.x * NWAVE;
    float* part = (float*)(a.wsp() + W_MODPART);
    constexpr int NT = 6 * D / 256;
    constexpr int KR = D / KSPLIT;
    for (int it = gw; it < 2 * NT * KSPLIT; it += ngw) {
        const int ks = it % KSPLIT, nt = (it / KSPLIT) % NT, l = it / (KSPLIT * NT);
        const float* w = a.in(I_WADA) + (size_t)l * D * 6 * D + (size_t)(ks * KR) * 6 * D + nt * 256 + lane * 4;
        f32x4 acc[9];
#pragma unroll
        for (int e = 0; e < 9; ++e) acc[e] = (f32x4){0.f, 0.f, 0.f, 0.f};
#pragma unroll 4
        for (int d = 0; d < KR; ++d) {
            const f32x4 wv = *(const f32x4*)(w + (size_t)d * 6 * D);
#pragma unroll
            for (int e = 0; e < 9; ++e) { const float s = sil[e * D + ks * KR + d]; acc[e] += wv * s; }
        }
#pragma unroll
        for (int e = 0; e < 9; ++e) *(f32x4*)(part + ((size_t)(ks * 9 + e) * 2 + l) * 6 * D + nt * 256 + lane * 4) = acc[e];
    }
    __syncthreads();
}
enum { CV_OUT0 = 0, CV_QKV, CV_OUT1, CV_FF1_0, CV_FF2_0, CV_FF1_1, CV_FF2_1 };
__device__ __forceinline__ void convert_sub(const DArgs& a, LAS unsigned char* lds, int which, int c0) {
    if ((int)blockIdx.x < c0) return;
    const int wave = threadIdx.x >> 6, lane = threadIdx.x & 63, gw = ((int)blockIdx.x - c0) * NWAVE + wave, ngw = ((int)gridDim.x - c0) * NWAVE;
    LAS float* scr = (LAS float*)(lds + wave * 8448);
    unsigned char* w = a.wsp();
    switch (which) {
    case CV_OUT0: transpose_matrix(a.in(I_WOUT0), D, D, (bf16_t*)(w + W_OUT0T), D, scr, gw, ngw, lane); break;
    case CV_QKV: transpose_matrix(a.in(I_WQKV), D, 3 * D, (bf16_t*)(w + W_QKVT), D, scr, gw, ngw, lane); break;
    case CV_OUT1: transpose_matrix(a.in(I_WOUT1), D, D, (bf16_t*)(w + W_OUT1T), D, scr, gw, ngw, lane); break;
    case CV_FF1_0: transpose_matrix(a.in(I_WFF1), D, DFF, (bf16_t*)(w + W_FF1T), D, scr, gw, ngw, lane); break;
    case CV_FF2_0: transpose_matrix(a.in(I_WFF2), DFF, D, (bf16_t*)(w + W_FF2T), DFF, scr, gw, ngw, lane); break;
    case CV_FF1_1: transpose_matrix(a.in(I_WFF1) + (size_t)D * DFF, D, DFF, (bf16_t*)(w + W_FF1T), D, scr, gw, ngw, lane); break;
    default: transpose_matrix(a.in(I_WFF2) + (size_t)DFF * D, DFF, D, (bf16_t*)(w + W_FF2T), DFF, scr, gw, ngw, lane); break;
    }
}
__device__ __forceinline__ void phase_convert(const DArgs& a, LAS unsigned char* lds) {
    const int wave = threadIdx.x >> 6, lane = threadIdx.x & 63, gw = blockIdx.x * NWAVE + wave, ngw = gridDim.x * NWAVE;
    LAS float* scr = (LAS float*)(lds + wave * 8448);
    transpose_matrix(a.in(I_WIN0), D, DIN0, (bf16_t*)(a.wsp() + W_IN0T), D, scr, gw, ngw, lane);
    for (int g = 0; g < 4; ++g) transpose_matrix(a.in(I_WPOOL) + (size_t)g * 65536, 256, 256, (bf16_t*)(a.wsp() + W_POOLT) + (size_t)g * 65536, 256, scr, gw, ngw, lane, a.in(I_PSCALE) + g * 256);
    bf16_t* lt = (bf16_t*)(a.wsp() + W_LORAT);
    for (int i = blockIdx.x * NTHR + threadIdx.x; i < 3072 * 256; i += gridDim.x * NTHR) {
        const int row = i >> 8, k = i & 255, part = row >> 10, n = row & 1023; float v = 0.f;
        if (part == 0) { if (k < 64) v = a.in(I_W2)[k * 1024 + n]; }
        else if (part == 1) { if (k >= 64 && k < 128) v = a.in(I_A2)[(k - 64) * 1024 + n]; }
        else { if (k >= 128) v = a.in(I_G2)[(k - 128) * 1024 + n]; }
        lt[i] = f2bf(v);
    }
}
__device__ __forceinline__ void phase_mod_final(const DArgs& a) {
    const float* part = (const float*)(a.wsp() + W_MODPART); float* mod = (float*)(a.wsp() + W_MOD);
    for (int i = blockIdx.x * NTHR + threadIdx.x; i < 9 * 2 * 6 * D; i += gridDim.x * NTHR) {
        const int n = i % (6 * D), l = (i / (6 * D)) & 1;
        float s = a.in(I_BADA)[l * 6 * D + n];
#pragma unroll
        for (int ks = 0; ks < KSPLIT; ++ks) s += part[(size_t)ks * 9 * 2 * 6 * D + i];
        mod[i] = s;
    }
}
__device__ __forceinline__ void zero_oacc(const DArgs& a) {
    f32x4* p = (f32x4*)(a.wsp() + W_OACC);
    for (int i = blockIdx.x * NTHR + threadIdx.x; i < TS * D / 4; i += gridDim.x * NTHR) p[i] = (f32x4){0.f, 0.f, 0.f, 0.f};
}
template <bool XIN_INPUT, bool HAS_O, bool HAS_H>
__device__ __forceinline__ void phase_rowwise(const DArgs& a, LAS unsigned char* lds, const float* g_o, int l_gt, int gt_which, const float* g_h, int l_h, int sc_which, int sh_which, int nsl = 0) {
    const int wave = threadIdx.x >> 6, lane = threadIdx.x & 63, gw = blockIdx.x * NWAVE + wave, ngw = gridDim.x * NWAVE;
    const float* mod = (const float*)(a.wsp() + W_MOD);
    float* X = a.outp() + O_Y; const bf16_t* o = (const bf16_t*)(a.wsp() + W_O); bf16_t* hA = (bf16_t*)(a.wsp() + W_HA); const float* oacc = (const float*)(a.wsp() + W_OACC);
    {
        f32x4 A1[HAS_O ? 8 : 1], A2[HAS_H ? 8 : 1], A3[HAS_H ? 8 : 1];
#pragma unroll
        for (int j = 0; j < 8; ++j) { const int c = 4 * (lane + 64 * j);
            if constexpr (HAS_O) A1[j] = *(const f32x4*)(mod + (size_t)l_gt * 6 * D + gt_which * D + c) * *(const f32x4*)(g_o + c);
            if constexpr (HAS_H) { A2[j] = *(const f32x4*)(g_h + c) * (*(const f32x4*)(mod + (size_t)l_h * 6 * D + sc_which * D + c) + 1.f); A3[j] = *(const f32x4*)(mod + (size_t)l_h * 6 * D + sh_which * D + c); } }
        for (int row = gw; row < TP; row += ngw) {
            const float* xin = XIN_INPUT ? a.in(I_XP) + (size_t)row * D : X + (size_t)row * D;
            f32x4 x[8];
#pragma unroll
            for (int j = 0; j < 8; ++j) x[j] = *(const f32x4*)(xin + 4 * (lane + 64 * j));
            if constexpr (HAS_O) {
                f32x4 ov[8]; float ss = 0.f;
#pragma unroll
                for (int j = 0; j < 8; ++j) { const u32x2 w = *(const u32x2*)(o + (size_t)row * D + 4 * (lane + 64 * j)); ov[j] = (f32x4){bflo(w.x), bfhi(w.x), bflo(w.y), bfhi(w.y)};
                    ss += (ov[j].x * ov[j].x + ov[j].y * ov[j].y) + (ov[j].z * ov[j].z + ov[j].w * ov[j].w); }
                const float rstd = rsqrtf(wave_sum(ss) * (1.f / D) + 1e-6f);
#pragma unroll
                for (int j = 0; j < 8; ++j) { x[j] += A1[j] * (ov[j] * rstd); *(f32x4*)(X + (size_t)row * D + 4 * (lane + 64 * j)) = x[j]; }
            }
            if constexpr (HAS_H) {
                float ss = 0.f;
#pragma unroll
                for (int j = 0; j < 8; ++j) ss += (x[j].x * x[j].x + x[j].y * x[j].y) + (x[j].z * x[j].z + x[j].w * x[j].w);
                const float rstd = rsqrtf(wave_sum(ss) * (1.f / D) + 1e-6f);
#pragma unroll
                for (int j = 0; j < 8; ++j) { const f32x4 h = x[j] * rstd * A2[j] + A3[j]; u32x2 w; w.x = pk2(h.x, h.y); w.y = pk2(h.z, h.w);
                    *(u32x2*)(hA + (size_t)row * D + 4 * (lane + 64 * j)) = w; }
            }
        }
    }
    LAS float* red = (LAS float*)lds;
    for (int r = blockIdx.x; r < TS; r += gridDim.x) {
        const int row = TP + r, e = entry_of(row), c = wave * 256 + lane * 4;
        const float* xin = XIN_INPUT ? a.in(I_XS) + (size_t)r * D : X + (size_t)row * D;
        f32x4 x = *(const f32x4*)(xin + c);
        if constexpr (HAS_O) {
            f32x4 ov = (f32x4){0.f, 0.f, 0.f, 0.f};
#pragma unroll 8
            for (int sl = 0; sl < nsl; ++sl) ov += *(const f32x4*)(oacc + ((size_t)sl * TS + r) * D + c);
            const float ss = wave_sum((ov.x * ov.x + ov.y * ov.y) + (ov.z * ov.z + ov.w * ov.w));
            if (lane == 0) red[wave] = ss;
            __syncthreads();
            float tot = 0.f;
#pragma unroll
            for (int w = 0; w < 8; ++w) tot += red[w];
            const float rstd = rsqrtf(tot * (1.f / D) + 1e-6f);
            const f32x4 g = *(const f32x4*)(mod + (size_t)(e * 2 + l_gt) * 6 * D + gt_which * D + c), go = *(const f32x4*)(g_o + c);
            x += g * (ov * rstd * go); *(f32x4*)(X + (size_t)row * D + c) = x;
        }
        if constexpr (HAS_H) {
            const float ss = wave_sum((x.x * x.x + x.y * x.y) + (x.z * x.z + x.w * x.w));
            if (lane == 0) red[8 + wave] = ss;
            __syncthreads();
            float tot = 0.f;
#pragma unroll
            for (int w = 0; w < 8; ++w) tot += red[8 + w];
            const float rstd = rsqrtf(tot * (1.f / D) + 1e-6f);
            const float* mb = mod + (size_t)(e * 2 + l_h) * 6 * D;
            const f32x4 g = *(const f32x4*)(g_h + c), s1 = *(const f32x4*)(mb + sc_which * D + c), s0 = *(const f32x4*)(mb + sh_which * D + c);
            const f32x4 h = x * rstd * g * (s1 + 1.f) + s0; u32x2 w; w.x = pk2(h.x, h.y); w.y = pk2(h.z, h.w);
            *(u32x2*)(hA + (size_t)row * D + c) = w;
        }
        __syncthreads();
    }
}
__device__ __forceinline__ void ld8bf(const bf16_t* p, float (&v)[8]) { const u32x4 w = *(const u32x4*)p; v[0] = bflo(w.x); v[1] = bfhi(w.x); v[2] = bflo(w.y); v[3] = bfhi(w.y); v[4] = bflo(w.z); v[5] = bfhi(w.z); v[6] = bflo(w.w); v[7] = bfhi(w.w); }
__device__ __forceinline__ void ld8f(const float* p, float (&v)[8]) { const f32x4 a = *(const f32x4*)p, b = *(const f32x4*)(p + 4); v[0] = a.x; v[1] = a.y; v[2] = a.z; v[3] = a.w; v[4] = b.x; v[5] = b.y; v[6] = b.z; v[7] = b.w; }
__device__ __forceinline__ void st8bf(bf16_t* p, const float (&v)[8]) { u32x4 w; w.x = pk2(v[0], v[1]); w.y = pk2(v[2], v[3]); w.z = pk2(v[4], v[5]); w.w = pk2(v[6], v[7]); *(u32x4*)p = w; }
template <int WIN> __device__ __forceinline__ void pool_sum(const bf16_t* p, float (&s)[8], float (&u)[8]) {
    u32x4 w[WIN];
#pragma unroll
    for (int sf = 0; sf < WIN; ++sf) w[sf] = *(const u32x4*)(p - (size_t)sf * DIN0);
    u[0] = bflo(w[0].x); u[1] = bfhi(w[0].x); u[2] = bflo(w[0].y); u[3] = bfhi(w[0].y); u[4] = bflo(w[0].z); u[5] = bfhi(w[0].z); u[6] = bflo(w[0].w); u[7] = bfhi(w[0].w);
#pragma unroll
    for (int i = 0; i < 8; ++i) s[i] = u[i];
#pragma unroll
    for (int sf = 1; sf < WIN; ++sf) { s[0] += bflo(w[sf].x); s[1] += bfhi(w[sf].x); s[2] += bflo(w[sf].y); s[3] += bfhi(w[sf].y); s[4] += bflo(w[sf].z); s[5] += bfhi(w[sf].z); s[6] += bflo(w[sf].w); s[7] += bfhi(w[sf].w); }
}
__device__ __forceinline__ void phase_prep(const DArgs& a) {
    const bf16_t* P = (const bf16_t*)(a.wsp() + W_P); bf16_t* AL = (bf16_t*)(a.wsp() + W_AL);
    const int gt = blockIdx.x * NTHR + threadIdx.x, ngt = gridDim.x * NTHR;
    for (int idx = gt; idx < TA * 160; idx += ngt) {
        const int row = idx / 160, it = idx % 160; const bool prompt = row < TP; const int t = prompt ? row : ((row - TP) & 31), b = prompt ? 0 : ((row - TP) >> 5);
        if (it < 128) {
            const int c0 = it * 8, gi = c0 >> 8, win = 2 << gi;
            float s[8], u[8], v[8];
            if (t >= win - 1) {
                const bf16_t* p = P + (size_t)row * DIN0 + c0;
                if (gi == 0) pool_sum<2>(p, s, u); else if (gi == 1) pool_sum<4>(p, s, u); else if (gi == 2) pool_sum<8>(p, s, u); else pool_sum<16>(p, s, u);
                const float inv = 1.f / (float)win;
#pragma unroll
                for (int i = 0; i < 8; ++i) s[i] = s[i] * inv - u[i];
            } else {
#pragma unroll
                for (int i = 0; i < 8; ++i) s[i] = 0.f;
                for (int sf = 0; sf < win; ++sf) { const int tt = t - sf;
                    if (tt >= 0) { ld8bf(P + (size_t)(row - sf) * DIN0 + c0, v);
#pragma unroll
                        for (int i = 0; i < 8; ++i) s[i] += v[i]; }
                    else if (!prompt) { ld8f(a.in(I_SPOOL) + ((size_t)b * 15 + (15 + tt)) * DPOOL + c0, v);
#pragma unroll
                        for (int i = 0; i < 8; ++i) s[i] += v[i]; } }
                const float cnt = prompt ? (float)min(win, t + 1) : (float)win, inv = 1.f / cnt;
                ld8bf(P + (size_t)row * DIN0 + c0, u);
#pragma unroll
                for (int i = 0; i < 8; ++i) s[i] = s[i] * inv - u[i];
            }
            st8bf(AL + (size_t)row * 1280 + c0, s);
        } else {
            const int q0 = (it - 128) * 8, e0 = 3072 + q0;
            float z[8], zp[8], mu[8];
            ld8bf(P + (size_t)row * DIN0 + DPOOL + e0, z);
            if (t > 0) ld8bf(P + (size_t)(row - 1) * DIN0 + DPOOL + e0, zp);
            else if (!prompt) ld8f(a.in(I_SSHIFT) + (size_t)b * DSHIFT + e0, zp);
            else {
#pragma unroll
                for (int i = 0; i < 8; ++i) zp[i] = 0.f; }
            ld8f(a.in(I_MU) + e0, mu);
#pragma unroll
            for (int i = 0; i < 8; ++i) { const float zs = z[i] + (zp[i] - z[i]) * mu[i];
                z[i] = q0 < 64 ? 1.f - 2.f / (1.f + __expf(2.f * zs)) : (q0 < 128 ? zs : sigmoidf_(zs)); }
            st8bf(AL + (size_t)row * 1280 + 1024 + q0, z);
        }
    }
    for (int i = gt; i < 15 * DPOOL; i += ngt) a.outp()[O_POOLP + i] = bf2f(P[(size_t)(TP - 15 + i / DPOOL) * DIN0 + (i % DPOOL)]);
    for (int i = gt; i < 8 * 15 * DPOOL; i += ngt) { const int b = i / (15 * DPOOL), r = (i / DPOOL) % 15, c = i % DPOOL; a.outp()[O_POOLS + i] = bf2f(P[(size_t)(TP + b * 32 + 17 + r) * DIN0 + c]); }
    for (int i = gt; i < DSHIFT; i += ngt) a.outp()[O_SHIFTP + i] = bf2f(P[(size_t)(TP - 1) * DIN0 + DPOOL + i]);
    for (int i = gt; i < 8 * DSHIFT; i += ngt) { const int b = i / DSHIFT, e = i % DSHIFT; a.outp()[O_SHIFTS + i] = bf2f(P[(size_t)(TP + b * 32 + 31) * DIN0 + DPOOL + e]); }
}

struct ScanConst { float mu_r, mu_k, mu_v, w0, a0, kkc, kac, rk, lnw, lnb; };
struct ScanRaw { bf16_t zr, zk, zv; float lw, la, lg; };
template <bool NEEDG> __device__ __forceinline__ ScanRaw scan_load(const bf16_t* P, const float* L, int row, int c) {
    ScanRaw r; const bf16_t* p = P + (size_t)row * DIN0 + DPOOL + c; r.zr = p[0]; r.zk = p[1024]; r.zv = p[2048];
    const float* l = L + (size_t)row * 3072 + c; r.lw = l[0]; r.la = l[1024]; r.lg = NEEDG ? l[2048] : 0.f; return r;
}
template <int MODE>
__device__ __forceinline__ void scan_item(const DArgs& a, LAS float* W  , int row0, int nsteps, int h, int lane, bool first_is_start, const float* shift_prev  ,
                                          const float* S_init  , float* S_final  , float* Uout, float* Pout) {
    const bf16_t* P = (const bf16_t*)(a.wsp() + W_P); const float* L = (const float*)(a.wsp() + W_L); bf16_t* mix = (bf16_t*)(a.wsp() + W_MIX);
    const int c = h * 64 + lane, ib = lane >> 4, il = lane & 15;
    ScanConst k; k.mu_r = a.in(I_MU)[c]; k.mu_k = a.in(I_MU)[1024 + c]; k.mu_v = a.in(I_MU)[2048 + c]; k.w0 = a.in(I_W0)[c]; k.a0 = a.in(I_A0)[c];
    k.kkc = a.in(I_KK)[c]; k.kac = a.in(I_KA)[c]; k.rk = a.in(I_RK)[c]; k.lnw = a.in(I_LNW)[c]; k.lnb = a.in(I_LNB)[c];
    float zr_p, zk_p, zv_p;
    if (!first_is_start) { const bf16_t* p = P + (size_t)(row0 - 1) * DIN0 + DPOOL + c; zr_p = bf2f(p[0]); zk_p = bf2f(p[1024]); zv_p = bf2f(p[2048]); }
    else if (shift_prev) { zr_p = shift_prev[c]; zk_p = shift_prev[1024 + c]; zv_p = shift_prev[2048 + c]; }
    else { zr_p = 0.f; zk_p = 0.f; zv_p = 0.f; }
    f32x2 S[4][8];
    if constexpr (MODE == 1) {
#pragma unroll
        for (int q = 0; q < 4; ++q)
#pragma unroll
            for (int m = 0; m < 4; ++m) { const f32x4 v = *(const f32x4*)(S_init + (il + 16 * q) * 64 + 16 * ib + 4 * m); S[q][2 * m] = (f32x2){v.x, v.y}; S[q][2 * m + 1] = (f32x2){v.z, v.w}; }
    } else {
#pragma unroll
        for (int q = 0; q < 4; ++q)
#pragma unroll
            for (int p = 0; p < 8; ++p) S[q][p] = MODE == 2 ? (f32x2){(q == ib && 2 * p == il) ? 1.f : 0.f, (q == ib && 2 * p + 1 == il) ? 1.f : 0.f} : (f32x2){0.f, 0.f};
    }
#define LDV(dst_, vec_) { _Pragma("unroll") for (int m = 0; m < 4; ++m) { const f32x4 t_ = *(const LAS f32x4*)(W + (vec_) * 64 + 16 * ib + 4 * m); dst_[2 * m] = (f32x2){t_.x, t_.y}; dst_[2 * m + 1] = (f32x2){t_.z, t_.w}; } }
#define XSUM(x_) { const u32x2 s16_ = __builtin_amdgcn_permlane16_swap(__float_as_uint(x_), __float_as_uint(x_), false, false); x_ = __uint_as_float(s16_.x) + __uint_as_float(s16_.y); \
                   const u32x2 s32_ = __builtin_amdgcn_permlane32_swap(__float_as_uint(x_), __float_as_uint(x_), false, false); x_ = __uint_as_float(s32_.x) + __uint_as_float(s32_.y); }
    struct Prep { float an, dec, bn, kmod, r, v, lg, bin; };
    auto prep = [&](const ScanRaw& rw) -> Prep {
        Prep o; const float zr = bf2f(rw.zr), zk = bf2f(rw.zk), zv = bf2f(rw.zv);
        const float r = zr + (zr_p - zr) * k.mu_r, kx = zk + (zk_p - zk) * k.mu_k; o.v = zv + (zv_p - zv) * k.mu_v;
        zr_p = zr; zk_p = zk; zv_p = zv;
        o.dec = __expf(-0.60653066f * sigmoidf_(k.w0 + rw.lw));
        const float ai = sigmoidf_(k.a0 + rw.la);
        const float kkr = kx * k.kkc, ssq = wave_sum(kkr * kkr), kk = kkr * rsqrtf(fmaxf(ssq, 1e-24f));
        o.kmod = kx * (1.f + (ai - 1.f) * k.kac); o.an = -kk; o.bn = kk * ai; o.r = r; o.lg = rw.lg; o.bin = r * o.kmod * k.rk; return o; };
    auto post = [&](float y, float bin, float v, float lg, int row, bool doit) {
        const float mean = wave_sum(y) * (1.f / 64.f), dy = y - mean, var = wave_sum(dy * dy) * (1.f / 64.f);
        const float yn = dy * rsqrtf(var + 64e-5f) * k.lnw + k.lnb;
        const float bonus = wave_sum(bin) * v;
        if (doit) mix[(size_t)row * D + 1024 + c] = f2bf((yn + bonus) * lg); };
    ScanRaw raw1 = scan_load<MODE == 1>(P, L, row0 + (nsteps > 1 ? 1 : 0), c);
    Prep pv = prep(scan_load<MODE == 1>(P, L, row0, c));
    float yp = 0.f, binp = 0.f, vp = 0.f, lgp = 0.f;
    for (int t = 0; t < nsteps; ++t) {
        const int row = row0 + t;
        const ScanRaw raw2 = scan_load<MODE == 1>(P, L, row0 + (t + 2 < nsteps ? t + 2 : nsteps - 1), c);
        W[lane] = pv.an; W[64 + lane] = pv.dec; W[128 + lane] = pv.bn; if constexpr (MODE != 2) { W[192 + lane] = pv.kmod; W[320 + lane] = pv.v; } if constexpr (MODE == 1) W[256 + lane] = pv.r;
        const Prep pn = prep(raw1);
        constexpr int NS = 2, PW = 8 / NS;
        float sa[4];
#pragma unroll
        for (int q = 0; q < 4; ++q) sa[q] = 0.f;
#pragma unroll
        for (int hf = 0; hf < NS; ++hf) {
            f32x2 av[PW];
#pragma unroll
            for (int m = 0; m < PW / 2; ++m) { const f32x4 t0 = *(const LAS f32x4*)(W + 16 * ib + 2 * PW * hf + 4 * m); av[2 * m] = (f32x2){t0.x, t0.y}; av[2 * m + 1] = (f32x2){t0.z, t0.w}; }
#pragma unroll
            for (int q = 0; q < 4; ++q) {
                f32x2 d = S[q][PW * hf] * av[0];
#pragma unroll
                for (int p = 1; p < PW; ++p) d += S[q][PW * hf + p] * av[p];
                sa[q] += d.x + d.y;
            }
        }
#pragma unroll
        for (int q = 0; q < 4; ++q) { XSUM(sa[q]) }
        float vq[4];
#pragma unroll
        for (int q = 0; q < 4; ++q) vq[q] = MODE == 2 ? 0.f : W[320 + il + 16 * q];
#pragma unroll
        for (int hf = 0; hf < NS; ++hf) {
            f32x2 wv[PW], bv[PW], kv[PW];
#pragma unroll
            for (int m = 0; m < PW / 2; ++m) { const int o_ = 16 * ib + 2 * PW * hf + 4 * m; const f32x4 t0 = *(const LAS f32x4*)(W + 64 + o_), t1 = *(const LAS f32x4*)(W + 128 + o_), t2 = MODE == 2 ? t1 : *(const LAS f32x4*)(W + 192 + o_);
                wv[2 * m] = (f32x2){t0.x, t0.y}; wv[2 * m + 1] = (f32x2){t0.z, t0.w}; bv[2 * m] = (f32x2){t1.x, t1.y}; bv[2 * m + 1] = (f32x2){t1.z, t1.w}; kv[2 * m] = (f32x2){t2.x, t2.y}; kv[2 * m + 1] = (f32x2){t2.z, t2.w}; }
#pragma unroll
            for (int q = 0; q < 4; ++q) {
                const f32x2 sa2 = (f32x2){sa[q], sa[q]}, v2 = (f32x2){vq[q], vq[q]};
#pragma unroll
                for (int p = 0; p < PW; ++p) { if constexpr (MODE == 2) S[q][PW * hf + p] = S[q][PW * hf + p] * wv[p] + sa2 * bv[p]; else S[q][PW * hf + p] = S[q][PW * hf + p] * wv[p] + (sa2 * bv[p] + v2 * kv[p]); }
            }
        }
        if constexpr (MODE == 1) {
            f32x2 rv[8];
            LDV(rv, 4)
            float yq[4];
#pragma unroll
            for (int q = 0; q < 4; ++q) { f32x2 d = S[q][0] * rv[0];
#pragma unroll
                for (int p = 1; p < 8; ++p) d += S[q][p] * rv[p];
                yq[q] = d.x + d.y; }
            const u32x2 s02 = __builtin_amdgcn_permlane32_swap(__float_as_uint(yq[0]), __float_as_uint(yq[2]), false, false);
            const u32x2 s13 = __builtin_amdgcn_permlane32_swap(__float_as_uint(yq[1]), __float_as_uint(yq[3]), false, false);
            const float r02 = __uint_as_float(s02.x) + __uint_as_float(s02.y), r13 = __uint_as_float(s13.x) + __uint_as_float(s13.y);
            const u32x2 sy = __builtin_amdgcn_permlane16_swap(__float_as_uint(r02), __float_as_uint(r13), false, false);
            const float y = __uint_as_float(sy.x) + __uint_as_float(sy.y);
            post(yp, binp, vp, lgp, row - 1, t > 0);
            yp = y; binp = pv.bin; vp = pv.v; lgp = pv.lg;
        }
        pv = pn; raw1 = raw2;
    }
    if constexpr (MODE == 1) post(yp, binp, vp, lgp, row0 + nsteps - 1, true);
#undef LDV
#undef XSUM
    if constexpr (MODE == 1) {
        if (S_final) {
#pragma unroll
            for (int q = 0; q < 4; ++q)
#pragma unroll
                for (int m = 0; m < 4; ++m) *(f32x4*)(S_final + (il + 16 * q) * 64 + 16 * ib + 4 * m) = (f32x4){S[q][2 * m].x, S[q][2 * m].y, S[q][2 * m + 1].x, S[q][2 * m + 1].y};
        }
    } else {
        float* dst = MODE == 0 ? Uout : Pout;
#pragma unroll
        for (int q = 0; q < 4; ++q)
#pragma unroll
            for (int m = 0; m < 4; ++m) *(f32x4*)(dst + (il + 16 * q) * 64 + 16 * ib + 4 * m) = (f32x4){S[q][2 * m].x, S[q][2 * m].y, S[q][2 * m + 1].x, S[q][2 * m + 1].y};
    }
}
__device__ __forceinline__ void phase_scan_a(const DArgs& a, LAS unsigned char* lds) {
    const int wave = threadIdx.x >> 6, lane = threadIdx.x & 63, gw = blockIdx.x * NWAVE + wave, ngw = gridDim.x * NWAVE;
    LAS float* W = (LAS float*)(lds + 8192 + wave * 2048);
    for (int it = gw; it < NCHK * 16; it += ngw) { const int ch = it >> 4, h = it & 15;
        scan_item<0>(a, W, ch * CHK, CHK, h, lane, ch == 0, nullptr, nullptr, nullptr, (float*)(a.wsp() + W_UC) + (size_t)it * 4096, nullptr);
        scan_item<2>(a, W, ch * CHK, CHK, h, lane, ch == 0, nullptr, nullptr, nullptr, nullptr, (float*)(a.wsp() + W_PC) + (size_t)it * 4096); }
}
__device__ __forceinline__ void phase_scan_c(const DArgs& a, LAS unsigned char* lds) {
    const int wave = threadIdx.x >> 6, lane = threadIdx.x & 63, gw = blockIdx.x * NWAVE + wave, ngw = gridDim.x * NWAVE;
    for (int it = gw; it < NCHK * 16; it += ngw) { const int ch = it >> 4, h = it & 15;
        scan_item<1>(a, (LAS float*)(lds + 8192 + wave * 2048), ch * CHK, CHK, h, lane, ch == 0, nullptr, (const float*)(a.wsp() + W_SST) + (size_t)it * 4096, nullptr, nullptr, nullptr); }
}
__device__ __forceinline__ void phase_scan_b(const DArgs& a, LAS unsigned char* lds) {
    const int wave = threadIdx.x >> 6, lane = threadIdx.x & 63;
    if (blockIdx.x < 64) {
        const int h = blockIdx.x >> 2, rg = blockIdx.x & 3, fr = lane & 15, g = lane >> 4;
        LAS float* Sb = (LAS float*)lds;
        const float* Pc = (const float*)(a.wsp() + W_PC); const float* Uc = (const float*)(a.wsp() + W_UC); float* Sst = (float*)(a.wsp() + W_SST);
        for (int i = threadIdx.x; i < 16 * 68; i += NTHR) Sb[i] = 0.f;
        if (wave < 4) {
#pragma unroll
            for (int r = 0; r < 4; ++r) Sst[(size_t)h * 4096 + (rg * 16 + 4 * g + r) * 64 + 16 * wave + fr] = 0.f;
        }
        float bq[16], uq[4];
        if (wave < 4) { const float* pc = Pc + (size_t)h * 4096; const float* uc = Uc + (size_t)h * 4096;
#pragma unroll
            for (int ks = 0; ks < 16; ++ks) bq[ks] = pc[(16 * g + ks) * 64 + 16 * wave + fr];
#pragma unroll
            for (int r = 0; r < 4; ++r) uq[r] = uc[(rg * 16 + 4 * g + r) * 64 + 16 * wave + fr]; }
        __syncthreads();
        for (int ch = 0; ch < NCHK; ++ch) {
            f32x4 acc0, acc1 = (f32x4){0.f, 0.f, 0.f, 0.f};
            if (wave < 4) {
                float bn[16], un[4];
                const int chn = ch + 1 < NCHK ? ch + 1 : ch;
                const float* pc = Pc + ((size_t)chn * 16 + h) * 4096; const float* uc = Uc + ((size_t)chn * 16 + h) * 4096;
#pragma unroll
                for (int ks = 0; ks < 16; ++ks) bn[ks] = pc[(16 * g + ks) * 64 + 16 * wave + fr];
#pragma unroll
                for (int r = 0; r < 4; ++r) un[r] = uc[(rg * 16 + 4 * g + r) * 64 + 16 * wave + fr];
                float aq[16];
#pragma unroll
                for (int q = 0; q < 4; ++q) { const f32x4 v = *(const LAS f32x4*)(Sb + fr * 68 + 16 * g + 4 * q); aq[4 * q] = v.x; aq[4 * q + 1] = v.y; aq[4 * q + 2] = v.z; aq[4 * q + 3] = v.w; }
                acc0 = (f32x4){uq[0], uq[1], uq[2], uq[3]};
#pragma unroll
                for (int ks = 0; ks < 16; ks += 2) { acc0 = __builtin_amdgcn_mfma_f32_16x16x4f32(aq[ks], bq[ks], acc0, 0, 0, 0); acc1 = __builtin_amdgcn_mfma_f32_16x16x4f32(aq[ks + 1], bq[ks + 1], acc1, 0, 0, 0); }
                acc0 += acc1;
#pragma unroll
                for (int ks = 0; ks < 16; ++ks) bq[ks] = bn[ks];
#pragma unroll
                for (int r = 0; r < 4; ++r) uq[r] = un[r];
            }
            __syncthreads();
            if (wave < 4) {
                float* dst = ch + 1 < NCHK ? Sst + ((size_t)(ch + 1) * 16 + h) * 4096 : a.outp() + O_WKVP + (size_t)h * 4096;
#pragma unroll
                for (int r = 0; r < 4; ++r) { Sb[(4 * g + r) * 68 + 16 * wave + fr] = acc0[r]; dst[(rg * 16 + 4 * g + r) * 64 + 16 * wave + fr] = acc0[r]; }
            }
            __syncthreads();
        }
    } else {
        const int it = (blockIdx.x - 64) * NWAVE + wave;
        if (it < 128) { const int b = it >> 4, h = it & 15;
            scan_item<1>(a, (LAS float*)(lds + 8192 + wave * 2048), TP + b * 32, 32, h, lane, true, a.in(I_SSHIFT) + (size_t)b * DSHIFT, a.in(I_SWKV) + ((size_t)b * 16 + h) * 4096,
                         a.outp() + O_WKVS + ((size_t)b * 16 + h) * 4096, nullptr, nullptr); }
    }
}

__device__ __forceinline__ void phase_attn_prep(const DArgs& a, LAS unsigned char* lds) {
    const int wave = threadIdx.x >> 6, lane = threadIdx.x & 63, gw = blockIdx.x * NWAVE + wave, ngw = gridDim.x * NWAVE;
    const int gt = blockIdx.x * NTHR + threadIdx.x, ngt = gridDim.x * NTHR;
    const bf16_t* qk = (const bf16_t*)(a.wsp() + W_QK); const bf16_t* vT = (const bf16_t*)(a.wsp() + W_VT);
    bf16_t* Ks = (bf16_t*)(a.wsp() + W_KS); bf16_t* VsT = (bf16_t*)(a.wsp() + W_VST);
    for (int i = gt; i < 8 * 576 * 256; i += ngt) {
        const int c8 = i & 255, kk = (i >> 8) % 576, b = i / (576 * 256);
        u32x4 w = (u32x4){0u, 0u, 0u, 0u};
        if (kk < 512) { float v[8]; ld8f(a.in(I_CK) + ((size_t)b * 512 + kk) * D + c8 * 8, v); w.x = pk2(v[0], v[1]); w.y = pk2(v[2], v[3]); w.z = pk2(v[4], v[5]); w.w = pk2(v[6], v[7]); }
        else if (kk < 544) w = *(const u32x4*)(qk + (size_t)(TP + b * 32 + kk - 512) * 4096 + 2048 + c8 * 8);
        *(u32x4*)(Ks + ((size_t)b * 576 + kk) * D + c8 * 8) = w;
    }
    LAS float* scr = (LAS float*)(lds + wave * 8448);
    for (int it = gw; it < 8 * 512; it += ngw) { const int b = it >> 9, r = it & 511, kb = r >> 6, nb = r & 63;
        transpose_item(a.in(I_CV) + (size_t)b * 512 * D, D, VsT + (size_t)b * D * 576, 576, scr, kb * 64, nb * 32, lane); }
    for (int i = gt; i < 8 * D * 8; i += ngt) {
        const int g8 = i & 7, c = (i >> 3) & (D - 1), b = i >> 14;
        u32x4 w = (u32x4){0u, 0u, 0u, 0u};
        if (g8 < 4) w = *(const u32x4*)(vT + (size_t)c * TA + TP + b * 32 + g8 * 8);
        *(u32x4*)(VsT + ((size_t)b * D + c) * 576 + 512 + g8 * 8) = w;
    }
    for (int i = gt; i < 512 * D; i += ngt) { const int r = i >> 11, c = i & (D - 1);
        a.outp()[O_KP + i] = bf2f(qk[(size_t)(TP - 512 + r) * 4096 + 2048 + c]); a.outp()[O_VP + i] = bf2f(vT[(size_t)c * TA + TP - 512 + r]); }
    for (int i = gt; i < TS * D; i += ngt) { const int r = i >> 11, c = i & (D - 1);
        a.outp()[O_KS + i] = bf2f(qk[(size_t)(TP + r) * 4096 + 2048 + c]); a.outp()[O_VS + i] = bf2f(vT[(size_t)c * TA + TP + r]); }
}
constexpr int KT_LD = 272, VT_LD = 144;
constexpr int A_K = 0, A_V = 64 * KT_LD, A_B = A_V + 128 * VT_LD;
__device__ __forceinline__ void phase_attn(const DArgs& a, LAS unsigned char* lds) {
    const int tid = threadIdx.x, wave = tid >> 6, lane = tid & 63, fr = lane & 15, g = lane >> 4;
    const bf16_t* qk = (const bf16_t*)(a.wsp() + W_QK); const bf16_t* vT = (const bf16_t*)(a.wsp() + W_VT);
    const bf16_t* Ks = (const bf16_t*)(a.wsp() + W_KS); const bf16_t* VsT = (const bf16_t*)(a.wsp() + W_VST);
    const float* relb = a.in(I_RELB);
    bf16_t* oatt = (bf16_t*)(a.wsp() + W_MIX);
    LAS float* biasT = (LAS float*)(lds + A_B);
    const float scale = 0.08838834764831845f;
    constexpr int NITEMS = 2048 + 128;
    struct Item { int h, qrow, qpos, tile_lo, tile_hi, qc, nkeys, ldk, ldv, kpos_base; const bf16_t* Kb; const bf16_t* Vb; bool wact, prompt; };
    auto setup = [&](int it) -> Item { Item I; I.prompt = it < 2048; I.qc = 0;
        if (I.prompt) { const int pi = it >> 4; I.h = it & 15; I.qc = 2 * pi + (wave >> 2); I.qrow = I.qc * 64 + (wave & 3) * 16 + fr; I.qpos = I.qrow;
            I.tile_lo = 2 * pi - 8 < 0 ? 0 : 2 * pi - 8; I.tile_hi = 2 * pi + 1; I.nkeys = 1 << 30; I.ldk = 4096; I.ldv = TA; I.kpos_base = 0;
            I.Kb = qk + 2048 + I.h * 128; I.Vb = vT + (size_t)(I.h * 128) * TA; I.wact = true; }
        else { const int s_ = it - 2048, b = s_ >> 4; I.h = s_ & 15; const int w2 = wave & 1; I.qrow = TP + b * 32 + w2 * 16 + fr; I.qpos = 2048 + w2 * 16 + fr;
            I.tile_lo = 0; I.tile_hi = 8; I.nkeys = 544; I.ldk = D; I.ldv = 576; I.kpos_base = 1536;
            I.Kb = Ks + (size_t)b * 576 * D + I.h * 128; I.Vb = VsT + ((size_t)b * D + I.h * 128) * 576; I.wact = wave < 2; }
        return I; };
    u32x4 kreg[2], vreg[2];
    const int kr = tid >> 4, kc = tid & 15, vr = tid >> 3, vc = tid & 7;
#define ATT_LOAD(I_, tile) do { _Pragma("unroll") for (int p_ = 0; p_ < 2; ++p_) { \
        kreg[p_] = *(const u32x4*)((I_).Kb + (size_t)((tile) * 64 + kr + 32 * p_) * (I_).ldk + kc * 8); \
        vreg[p_] = *(const u32x4*)((I_).Vb + (size_t)(vr + 64 * p_) * (I_).ldv + (tile) * 64 + vc * 8); } } while (0)
#define ATT_STORE() do { _Pragma("unroll") for (int p_ = 0; p_ < 2; ++p_) { \
        *(LAS u32x4*)(lds + A_K + (kr + 32 * p_) * KT_LD + kc * 16) = kreg[p_]; \
        *(LAS u32x4*)(lds + A_V + (vr + 64 * p_) * VT_LD + vc * 16) = vreg[p_]; } } while (0)
#define ATT_LOADQ(dst_, I_) do { _Pragma("unroll") for (int ks = 0; ks < 4; ++ks) dst_[ks] = *(const bf16x8*)(qk + (size_t)(I_).qrow * 4096 + (I_).h * 128 + 32 * ks + 8 * g); } while (0)
    if ((int)blockIdx.x >= NITEMS) return;
    Item cur = setup(blockIdx.x);
    bf16x8 qf[4], qfn[4];
    float biasn = tid < 257 ? relb[cur.h * 257 + tid] : 0.f;
    ATT_LOADQ(qf, cur);
    ATT_LOAD(cur, cur.tile_lo);
    for (int it = blockIdx.x; it < NITEMS; it += gridDim.x) {
        const bool has_next = it + (int)gridDim.x < NITEMS;
        const Item nxt = setup(has_next ? it + (int)gridDim.x : it);
        f32x4 oacc[8];
#pragma unroll
        for (int n = 0; n < 8; ++n) oacc[n] = (f32x4){0.f, 0.f, 0.f, 0.f};
        float mrun = -1e30f, lrun = 0.f;
        __syncthreads();
        ATT_STORE();
        if (tid < 257) biasT[tid] = biasn;
        __syncthreads();
        for (int tile = cur.tile_lo; tile <= cur.tile_hi; ++tile) {
            if (tile < cur.tile_hi) ATT_LOAD(cur, tile + 1);
            else if (has_next) { ATT_LOAD(nxt, nxt.tile_lo); ATT_LOADQ(qfn, nxt); biasn = tid < 257 ? relb[nxt.h * 257 + tid] : 0.f; }
            const bool act = cur.wact && (!cur.prompt || (tile >= cur.qc - 8 && tile <= cur.qc));
            if (act) {
                f32x4 sacc[4];
#pragma unroll
                for (int kt = 0; kt < 4; ++kt) { sacc[kt] = (f32x4){0.f, 0.f, 0.f, 0.f};
#pragma unroll
                    for (int ks = 0; ks < 4; ++ks) { const bf16x8 kf = *(const LAS bf16x8*)(lds + A_K + (16 * kt + fr) * KT_LD + (32 * ks + 8 * g) * 2);
                        sacc[kt] = __builtin_amdgcn_mfma_f32_16x16x32_bf16(kf, qf[ks], sacc[kt], 0, 0, 0); } }
                const int kpos0 = cur.kpos_base + tile * 64, kidx0 = tile * 64;
                float tmax = -1e30f;
#pragma unroll
                for (int kt = 0; kt < 4; ++kt)
#pragma unroll
                    for (int r = 0; r < 4; ++r) { const int key = 16 * kt + 4 * g + r; float bias;
                        { int rel = cur.qpos - (kpos0 + key); rel = rel < -128 ? -128 : (rel > 128 ? 128 : rel); bias = biasT[rel + 128]; }
                        float s_ = sacc[kt][r] * scale + bias; if (kidx0 + key >= cur.nkeys) s_ = -1e30f; sacc[kt][r] = s_; tmax = fmaxf(tmax, s_); }
                tmax = fmaxf(tmax, __shfl_xor(tmax, 16)); tmax = fmaxf(tmax, __shfl_xor(tmax, 32));
                const float mnew = fmaxf(mrun, tmax), alpha = __expf(mrun - mnew); mrun = mnew;
                float psum = 0.f;
#pragma unroll
                for (int kt = 0; kt < 4; ++kt)
#pragma unroll
                    for (int r = 0; r < 4; ++r) { const float p_ = __expf(sacc[kt][r] - mnew); sacc[kt][r] = p_; psum += p_; }
                lrun = lrun * alpha + psum;
#pragma unroll
                for (int n = 0; n < 8; ++n) oacc[n] = oacc[n] * alpha;
#pragma unroll
                for (int j = 0; j < 2; ++j) {
                    u32x4 pw; pw.x = pk2(sacc[2 * j][0], sacc[2 * j][1]); pw.y = pk2(sacc[2 * j][2], sacc[2 * j][3]); pw.z = pk2(sacc[2 * j + 1][0], sacc[2 * j + 1][1]); pw.w = pk2(sacc[2 * j + 1][2], sacc[2 * j + 1][3]);
                    const bf16x8 pf = __builtin_bit_cast(bf16x8, pw);
#pragma unroll
                    for (int n = 0; n < 8; ++n) {
                        const u32x2 v0 = *(const LAS u32x2*)(lds + A_V + (16 * n + fr) * VT_LD + (32 * j + 4 * g) * 2);
                        const u32x2 v1 = *(const LAS u32x2*)(lds + A_V + (16 * n + fr) * VT_LD + (32 * j + 16 + 4 * g) * 2);
                        const bf16x8 vf = __builtin_bit_cast(bf16x8, (u32x4){v0.x, v0.y, v1.x, v1.y});
                        oacc[n] = __builtin_amdgcn_mfma_f32_16x16x32_bf16(vf, pf, oacc[n], 0, 0, 0);
                    }
                }
            }
            if (tile < cur.tile_hi) { __syncthreads(); ATT_STORE(); __syncthreads(); }
        }
        if (cur.wact) {
            float l = lrun; l += __shfl_xor(l, 16); l += __shfl_xor(l, 32);
            const float inv = 1.f / l;
#pragma unroll
            for (int n = 0; n < 8; ++n) { u32x2 w; w.x = pk2(oacc[n][0] * inv, oacc[n][1] * inv); w.y = pk2(oacc[n][2] * inv, oacc[n][3] * inv);
                *(u32x2*)(oatt + (size_t)cur.qrow * D + cur.h * 128 + 16 * n + 4 * g) = w; }
        }
        cur = nxt;
#pragma unroll
        for (int ks = 0; ks < 4; ++ks) qf[ks] = qfn[ks];
    }
    __syncthreads();
#undef ATT_LOAD
#undef ATT_STORE
#undef ATT_LOADQ
}


#define XB_TMO      128
#define XB_XCNT(j)  (256  + 64 * (j))
#define XB_XSUB(j)  (1280 + 64 * (j))
#define XB_XGEN(j)  (2304 + 64 * (j))
#define XB_TOP      3328
#define XB_TOPGEN   3392
#define XCD_BAR_WORDS 3456
#define XB_SPIN_CAP (1u << 18)
__device__ __forceinline__ unsigned xb_ld(unsigned* p)              { return __hip_atomic_load(p, __ATOMIC_RELAXED, __HIP_MEMORY_SCOPE_AGENT); }
__device__ __forceinline__ unsigned xb_add(unsigned* p, unsigned v) { return __hip_atomic_fetch_add(p, v, __ATOMIC_RELAXED, __HIP_MEMORY_SCOPE_AGENT); }
__device__ __forceinline__ unsigned xb_xcc_id() { return (unsigned)__builtin_amdgcn_s_getreg((3 << 11) | 20) & 0xFu; }
#define XB_SPIN(cond, bar) do { unsigned _sp = 0; while (cond) { __builtin_amdgcn_s_sleep(1); \
    if ((++_sp & 255u) == 0u) { if (xb_ld(&(bar)[XB_TMO])) break; if (_sp > XB_SPIN_CAP) { atomicAdd(&(bar)[XB_TMO], 1u); break; } } } } while (0)
struct XcdBarrier { unsigned* bar; unsigned x; volatile LAS unsigned* st; };
__device__ __forceinline__ XcdBarrier xcd_barrier_post(unsigned* bar, volatile LAS unsigned* st) {
    XcdBarrier b; b.bar = bar; b.x = xb_xcc_id(); b.st = st;
    if (threadIdx.x == 0) (void)xb_add(&bar[XB_XCNT(b.x)], 1u);
    return b;
}
__device__ __forceinline__ void xcd_barrier_complete(unsigned* bar, unsigned x, unsigned& nloc, unsigned& nx) {
    const unsigned G = gridDim.x * gridDim.y * gridDim.z;
    unsigned sum, cnt, mine, sp = 0u;
    for (;;) {
        sum = 0u; cnt = 0u; mine = 0u;
#pragma unroll
        for (unsigned j = 0; j < 16; ++j) { const unsigned c = xb_ld(&bar[XB_XCNT(j)]); sum += c; cnt += (c > 0u) ? 1u : 0u; mine = (j == x) ? c : mine; }
        if (sum == G) break;
        __builtin_amdgcn_s_sleep(1);
        if ((++sp & 255u) == 0u) { if (xb_ld(&bar[XB_TMO])) break; if (sp > XB_SPIN_CAP) { atomicAdd(&bar[XB_TMO], 1u); break; } }
    }
    nloc = mine > 0u ? mine : 1u; nx = cnt > 0u ? cnt : 1u;
}
__device__ __forceinline__ void xcd_barrier(const XcdBarrier& b) {
    asm volatile("s_waitcnt vmcnt(0)" ::: "memory");
    __syncthreads();
    if (threadIdx.x == 0) {
        unsigned* bar = b.bar;
        __builtin_amdgcn_s_waitcnt(0);
        unsigned nloc = b.st[0], nx = b.st[1];
        if (nloc == 0u) { xcd_barrier_complete(bar, b.x, nloc, nx); b.st[0] = nloc; b.st[1] = nx; }
        const unsigned old = xb_add(&bar[XB_XSUB(b.x)], 1u);
        const unsigned gen = old / nloc;
        if (old + 1u == (gen + 1u) * nloc) {
            __builtin_amdgcn_fence(__ATOMIC_RELEASE, "agent");
            asm volatile("s_waitcnt vmcnt(0)" ::: "memory");
            const unsigned og = xb_add(&bar[XB_TOP], 1u);
            const unsigned tg = og / nx;
            if (og + 1u == (tg + 1u) * nx) xb_add(&bar[XB_TOPGEN], 1u);
            else XB_SPIN(xb_ld(&bar[XB_TOPGEN]) == tg, bar);
            __builtin_amdgcn_fence(__ATOMIC_ACQUIRE, "agent");
            xb_add(&bar[XB_XGEN(b.x)], 1u);
            asm volatile("s_waitcnt vmcnt(0)" ::: "memory");
        } else {
            XB_SPIN(xb_ld(&bar[XB_XGEN(b.x)]) == gen, bar);
            __builtin_amdgcn_fence(__ATOMIC_ACQUIRE, "agent");
            asm volatile("s_waitcnt vmcnt(0)" ::: "memory");
        }
    }
    __syncthreads();
}

__global__ __launch_bounds__(512, 2) void mega(Args aa) {
    extern __shared__ __attribute__((aligned(16))) unsigned char shm[];
    LAS unsigned char* lds = (LAS unsigned char*)shm;
    cg::grid_group grid = cg::this_grid();
    {
        LAS unsigned long long* tabw = (LAS unsigned long long*)(lds + 131072);
        if (threadIdx.x == 0) {
#pragma unroll
            for (int i = 0; i < 32; ++i) tabw[i] = (unsigned long long)aa.in[i];
            tabw[32] = (unsigned long long)aa.out; tabw[33] = (unsigned long long)aa.ws;
        }
        __syncthreads();
    }
    DArgs a; a.tab = (LAS const unsigned long long*)(lds + 131072); a.ph_lo = aa.ph_lo; a.ph_hi = aa.ph_hi;
    volatile LAS unsigned* xb_st = (volatile LAS unsigned*)(lds + 131072 + 448);
    if (threadIdx.x == 0) { xb_st[0] = 0u; xb_st[1] = 0u; }
    __syncthreads();
    const XcdBarrier xb = xcd_barrier_post((unsigned*)(__attribute__((address_space(1))) unsigned*)(a.wsp() + W_BAR), xb_st);
#define gn a.in(I_GNORM)
#define ws a.wsp()
    const int nM = TA / 256;
#ifndef PHMASK
#define PHMASK 0x3fffff
#endif
#ifndef DUPMASK
#define DUPMASK 0
#endif
#define PH(p) if (((PHMASK >> (p)) & 1) && a.ph_lo <= (p) && (p) < a.ph_hi) for (int rep_ = 0; rep_ < (((DUPMASK >> (p)) & 1) ? 2 : 1); ++rep_, (((DUPMASK >> (p)) & 1) && rep_ < 2 ? grid.sync() : (void)0))
#define SYNC(p) if (a.ph_lo <= (p) && (p) + 1 < a.ph_hi) xcd_barrier(xb);
    if (a.ph_lo < 0) grid.sync();
    PH(0) { phase_mod_partial(a, lds); phase_convert(a, lds); }
    SYNC(0)
    PH(1) { phase_mod_final(a); }
    SYNC(1)
    PH(2) { phase_rowwise<true, false, true>(a, lds, nullptr, 0, 0, gn + 0 * D, 0, 1, 0); }
    SYNC(2)
    PH(3) { pg8::EpiBf16<0> E{(bf16_t*)(ws + W_P), DIN0, nullptr};
        run_gemm(lds, D, D, D, ws + W_HA, ws + W_IN0T, nM, DIN0 / 256, 0, nullptr, nullptr, 0, 0, E);
        const int c0 = (nM * (DIN0 / 256)) % (int)gridDim.x; convert_sub(a, lds, CV_OUT0, c0); convert_sub(a, lds, CV_FF1_0, c0); }
    SYNC(3)
    PH(4) { phase_prep(a); }
    SYNC(4)
    PH(5) { pg8::Epi2<pg8::EpiBf16<0>, pg8::EpiF32> E{{(bf16_t*)(ws + W_MIX), D, nullptr}, {(float*)(ws + W_L), 3072}};
        run_gemm(lds, 256, 1280, 256, ws + W_AL, ws + W_POOLT, nM, 4, 512, ws + W_AL + 2048, ws + W_LORAT, nM, 12, E); }
    SYNC(5)
    PH(6) { phase_scan_a(a, lds); }
    SYNC(6)
    PH(7) { phase_scan_b(a, lds); }
    SYNC(7)
    PH(8) { phase_scan_c(a, lds); }
    SYNC(8)
    PH(9) { pg8::Epi2<pg8::EpiBf16<0>, pg8::EpiPartF32> E{{(bf16_t*)(ws + W_O), D, nullptr}, {(float*)(ws + W_OACC), D}};
        run_gemm(lds, D, D, D, ws + W_MIX, ws + W_OUT0T, 64, 8, 0, ws + W_MIX, ws + W_OUT0T, 0, 8, E, 8, 64); }
    SYNC(9)
    PH(10) { phase_rowwise<true, true, true>(a, lds, gn + 1 * D, 0, 2, gn + 2 * D, 0, 4, 3, 8); }
    SYNC(10)
    PH(11) { pg8::EpiBf16<1> E{(bf16_t*)(ws + W_F1), DFF, nullptr};
        run_gemm(lds, D, D, D, ws + W_HA, ws + W_FF1T, nM, DFF / 256, 0, nullptr, nullptr, 0, 0, E);
        const int c0 = (nM * (DFF / 256)) % (int)gridDim.x; convert_sub(a, lds, CV_FF2_0, c0); convert_sub(a, lds, CV_QKV, c0); }
    SYNC(11)
    PH(12) { pg8::Epi2<pg8::EpiBf16<0>, pg8::EpiPartF32> E{{(bf16_t*)(ws + W_O), D, nullptr}, {(float*)(ws + W_OACC), D}};
        run_gemm(lds, DFF, DFF, DFF, ws + W_F1, ws + W_FF2T, 64, 8, 0, ws + W_F1, ws + W_FF2T, 0, 8, E, 32, 64); }
    SYNC(12)
    PH(13) { phase_rowwise<false, true, true>(a, lds, gn + 3 * D, 0, 5, gn + 4 * D, 1, 1, 0, 32); }
    SYNC(13)
    PH(14) { pg8::Epi2<pg8::EpiBf16<0>, pg8::EpiBf16<0>> E{{(bf16_t*)(ws + W_QK), 4096, nullptr}, {(bf16_t*)(ws + W_VT), TA, nullptr}};
        run_gemm(lds, D, D, D, ws + W_HA, ws + W_QKVT, nM, 16, 0, ws + W_QKVT + (size_t)4096 * D * 2, ws + W_HA, 8, nM, E);
        const int c0 = (nM * 24) % (int)gridDim.x; convert_sub(a, lds, CV_OUT1, c0); convert_sub(a, lds, CV_FF1_1, c0); }
    SYNC(14)
    PH(15) { phase_attn_prep(a, lds); }
    SYNC(15)
    PH(16) { phase_attn(a, lds); }
    SYNC(16)
    PH(17) { pg8::Epi2<pg8::EpiBf16<0>, pg8::EpiPartF32> E{{(bf16_t*)(ws + W_O), D, nullptr}, {(float*)(ws + W_OACC), D}};
        run_gemm(lds, D, D, D, ws + W_MIX, ws + W_OUT1T, 64, 8, 0, ws + W_MIX, ws + W_OUT1T, 0, 8, E, 8, 64); }
    SYNC(17)
    PH(18) { phase_rowwise<false, true, true>(a, lds, gn + 5 * D, 1, 2, gn + 6 * D, 1, 4, 3, 8); }
    SYNC(18)
    PH(19) { pg8::EpiBf16<1> E{(bf16_t*)(ws + W_F1), DFF, nullptr};
        run_gemm(lds, D, D, D, ws + W_HA, ws + W_FF1T, nM, DFF / 256, 0, nullptr, nullptr, 0, 0, E);
        const int c0 = (nM * (DFF / 256)) % (int)gridDim.x; convert_sub(a, lds, CV_FF2_1, c0); }
    SYNC(19)
    PH(20) { pg8::Epi2<pg8::EpiBf16<0>, pg8::EpiPartF32> E{{(bf16_t*)(ws + W_O), D, nullptr}, {(float*)(ws + W_OACC), D}};
        run_gemm(lds, DFF, DFF, DFF, ws + W_F1, ws + W_FF2T, 64, 8, 0, ws + W_F1, ws + W_FF2T, 0, 8, E, 32, 64); }
    SYNC(20)
    PH(21) { phase_rowwise<false, true, false>(a, lds, gn + 7 * D, 1, 5, nullptr, 0, 0, 0, 32); }
#undef PH
#undef SYNC
#undef gn
#undef ws
}

constexpr int NPHASE = 22;
#ifndef MK_MULTI
#define MK_MULTI 0
#endif
extern "C" void kernel_launch(void* const* d_in, const int* in_sizes, int n_in, void* d_out, int out_size, void* d_ws, size_t ws_size, hipStream_t stream) {
    static int grid = 0;
    constexpr int LDS_BYTES = 131072 + 512;
    if (grid == 0) {
        if (n_in != 32 || ws_size < WS_TOTAL) { fprintf(stderr, "kernel_launch: unexpected n_in %d / ws %zu (need %zu)\n", n_in, ws_size, (size_t)WS_TOTAL); grid = -1; return; }
        int dev = 0, cus = 0, per_cu = 0;
        hipGetDevice(&dev); hipDeviceGetAttribute(&cus, hipDeviceAttributeMultiprocessorCount, dev);
        if (hipFuncSetAttribute((const void*)mega, hipFuncAttributeMaxDynamicSharedMemorySize, LDS_BYTES) != hipSuccess) { fprintf(stderr, "kernel_launch: hipFuncSetAttribute failed\n"); grid = -1; return; }
        hipOccupancyMaxActiveBlocksPerMultiprocessor(&per_cu, (const void*)mega, NTHR, LDS_BYTES);
        if (per_cu < 1) { fprintf(stderr, "kernel_launch: occupancy query says %d blocks per CU\n", per_cu); per_cu = 1; }
        (void)hipGetLastError();
        grid = cus;
    }
    if (grid < 0) return;
    Args a{};
    for (int i = 0; i < 32; ++i) a.in[i] = (const float*)d_in[i];
    a.out = (float*)d_out; a.ws = (unsigned char*)d_ws;
#if MK_MULTI
    for (int p = 0; p < NPHASE; ++p) { a.ph_lo = p; a.ph_hi = p + 1; hipLaunchKernelGGL(mega, dim3(grid), dim3(NTHR), LDS_BYTES, stream, a); }
#else
    a.ph_lo = 0; a.ph_hi = NPHASE;
    if (hipMemsetAsync((char*)d_ws + W_BAR, 0, XCD_BAR_WORDS * 4, stream) != hipSuccess) { fprintf(stderr, "kernel_launch: memset of barrier words failed\n"); return; }
    void* args[] = {&a};
    hipError_t e = hipLaunchCooperativeKernel((const void*)mega, dim3(grid), dim3(NTHR), args, LDS_BYTES, stream);
    if (e != hipSuccess) fprintf(stderr, "kernel_launch: cooperative launch failed: %s (grid %d)\n", hipGetErrorString(e), grid);
#endif
}
```
